# Optimizing an MI355X kernel written in HIP

```python
import math
import jax, jax.numpy as jnp
from jax import lax
import numpy as np


D_MODEL = 1024
BATCH = 8
SEQ = 8192
DEPTH = 2

D_MIX = D_MODEL
HEAD_DIM = 64
RWKV_WIDTH = 3 * D_MIX // 8
RWKV_HEADS = RWKV_WIDTH // HEAD_DIM
DECAY_LORA = 64
ICLR_LORA = 64
GATE_LORA = 128
ATTN_WIDTH = 3 * D_MIX // 8
ATTN_HEADS = ATTN_WIDTH // HEAD_DIM
DILATED_PATTERNS = ((128, 1), (512, 4), (2048, 16))
S5_WIDTH = D_MIX - RWKV_WIDTH - ATTN_WIDTH
S5_GROUP = 16
S5_GROUPS = S5_WIDTH // S5_GROUP
S5_STATE = 64
RWKV_IN = 3 * RWKV_WIDTH + DECAY_LORA + ICLR_LORA + GATE_LORA
ATTN_IN = 3 * ATTN_WIDTH
IN_WIDTH = RWKV_IN + ATTN_IN + S5_WIDTH
D_FF = ((8 * D_MODEL // 3 + 255) // 256) * 256
FFN_RESIDUAL = 0.5
N_DIR = 2
NORM_EPS = 1e-6
LNX_EPS = 64e-5
L2_EPS = 1e-12
NEG_INF = -1e30

kernel_name = 'hymba_rwkv7_dilated_alibi_s5_macaron'


def _rms_norm(x, g):
    xf = x.astype(jnp.float32)
    y = xf * lax.rsqrt(jnp.mean(xf * xf, axis=-1, keepdims=True) + NORM_EPS)
    return (y * g.astype(jnp.float32)).astype(x.dtype)


def _swiglu(x, w_gate, w_up, w_down):
    return (jax.nn.silu(x @ w_gate) * (x @ w_up)) @ w_down


def _shift_prev(z):
    return jnp.pad(z, ((0, 0), (1, 0), (0, 0)))[:, :-1]


def _shift_next(z):
    return jnp.pad(z, ((0, 0), (0, 1), (0, 0)))[:, 1:]


def _alibi_slopes(n):
    def pow2(m):
        start = 2.0 ** (-8.0 / m)
        return [start ** (i + 1) for i in range(m)]
    if n & (n - 1) == 0:
        return pow2(n)
    c = 2 ** int(math.floor(math.log2(n)))
    return pow2(c) + _alibi_slopes(2 * c)[0::2][:n - c]


def _wkv7_scan(r, w, k, v, kkn, kka, reverse):
    bsz, _, nh, n = r.shape

    def step(state, inp):
        r_t, w_t, k_t, v_t, kkn_t, kka_t = inp
        sa = jnp.einsum('bhvk,bhk->bhv', state, kkn_t)
        state = (state * w_t[:, :, None, :] + sa[..., None] * kka_t[:, :, None, :]
                 + v_t[..., None] * k_t[:, :, None, :])
        return state, jnp.einsum('bhvk,bhk->bhv', state, r_t)

    xs = tuple(jnp.moveaxis(t, 1, 0) for t in (r, w, k, v, kkn, kka))
    state0 = jnp.zeros((bsz, nh, n, n), jnp.float32)
    _, y = lax.scan(step, state0, xs, reverse=reverse)
    return jnp.moveaxis(y, 0, 1)


def _rwkv7_time_mix(z, mu_prev, mu_next, w0, w2, a0, a2, g2, k_k, k_a, r_k, lnx_w, lnx_b):
    dtype = z.dtype
    z = z.astype(jnp.float32)
    bsz, seq, _ = z.shape
    z = z + mu_prev * (_shift_prev(z) - z) + mu_next * (_shift_next(z) - z)
    W = RWKV_WIDTH
    r, k, v, zw, za, zg = jnp.split(
        z, [W, 2 * W, 3 * W, 3 * W + DECAY_LORA, 3 * W + DECAY_LORA + ICLR_LORA], axis=-1)
    heads = lambda t: t.reshape(bsz, seq, RWKV_HEADS, HEAD_DIM)
    kk = heads(k * k_k)
    kk = kk * lax.rsqrt(jnp.sum(kk * kk, axis=-1, keepdims=True) + L2_EPS)
    rh, kh, vh = heads(r), heads(k), heads(v)
    k_a_h = k_a.reshape(RWKV_HEADS, HEAD_DIM)
    tw = jnp.tanh(zw)
    ys, bonus = [], []
    for d in range(N_DIR):
        log_w = -jax.nn.softplus(-(w0[d] + tw @ w2[d])) - 0.5
        decay = heads(jnp.exp(-jnp.exp(log_w)))
        a = heads(jax.nn.sigmoid(a0[d] + za @ a2[d]))
        kd = kh * (1.0 + (a - 1.0) * k_a_h)
        ys.append(_wkv7_scan(rh, decay, kd, vh, -kk, kk * a, reverse=(d == 1)))
        bonus.append(jnp.sum(rh * kd * r_k, axis=-1, keepdims=True) * vh)
    y = ys[0] + ys[1]
    mean = jnp.mean(y, axis=-1, keepdims=True)
    var = jnp.mean(jnp.square(y - mean), axis=-1, keepdims=True)
    y = (y - mean) * lax.rsqrt(var + LNX_EPS)
    y = y.reshape(bsz, seq, W) * lnx_w + lnx_b + (bonus[0] + bonus[1]).reshape(bsz, seq, W)
    g = jax.nn.sigmoid(zg) @ g2
    return (y * g).astype(dtype)


def _dilated_band_attention(q, k, v, slopes, dilation, half):
    bsz, seq, nh, dh = q.shape
    n = seq // dilation
    nb = -(-n // half)
    npad = nb * half
    scale = dh ** -0.5

    def to_sub(t):
        t = t.reshape(bsz, n, dilation, nh, dh).transpose(0, 2, 3, 1, 4)
        return jnp.pad(t, ((0, 0), (0, 0), (0, 0), (0, npad - n), (0, 0)))

    def windows(t):
        tp = jnp.pad(to_sub(t), ((0, 0), (0, 0), (0, 0), (half, half), (0, 0)))
        tp = tp.reshape(bsz, dilation, nh, nb + 2, half, dh)
        return jnp.concatenate([tp[:, :, :, :-2], tp[:, :, :, 1:-1], tp[:, :, :, 2:]], axis=4)

    qb = to_sub(q).reshape(bsz, dilation, nh, nb, half, dh)
    kw, vw = windows(k), windows(v)
    s = jnp.einsum('brhiqc,brhikc->brhiqk', qb, kw).astype(jnp.float32) * scale
    rel = jnp.arange(3 * half)[None, :] - half - jnp.arange(half)[:, None]
    kidx = (jnp.arange(nb)[:, None] - 1) * half + jnp.arange(3 * half)[None, :]
    valid = (jnp.abs(rel) <= half)[None] & ((kidx >= 0) & (kidx < n))[:, None, :]
    bias = -slopes[:, None, None] * (jnp.abs(rel) * dilation).astype(jnp.float32)[None]
    logits = jnp.where(valid, s + bias[None, None, :, None], NEG_INF)
    lse = jax.nn.logsumexp(logits, axis=-1)
    p = jnp.exp(logits - lse[..., None])
    o = jnp.einsum('brhiqk,brhikc->brhiqc', p, vw.astype(jnp.float32))
    o = o.reshape(bsz, dilation, nh, npad, dh)[:, :, :, :n].transpose(0, 3, 1, 2, 4)
    lse = lse.reshape(bsz, dilation, nh, npad)[:, :, :, :n].transpose(0, 3, 1, 2)
    return o.reshape(bsz, seq, nh, dh), lse.reshape(bsz, seq, nh)


def _dilated_attention(q, k, v):
    slopes = jnp.asarray(_alibi_slopes(q.shape[2]), jnp.float32)
    outs, lses = [], []
    for window, dilation in DILATED_PATTERNS:
        o, l = _dilated_band_attention(q, k, v, slopes, dilation, window // (2 * dilation))
        outs.append(o)
        lses.append(l)
    wts = jax.nn.softmax(jnp.stack(lses, axis=0), axis=0)
    out = jnp.sum(wts[..., None] * jnp.stack(outs, axis=0), axis=0)
    return out.astype(q.dtype)


def _ssm_combine(left, right):
    a_l, b_l = left
    a_r, b_r = right
    return a_r * a_l, a_r * b_l + b_r


def _s5_mix(u, a_re, a_im, log_step, b_re, b_im, c_re, c_im, d_skip, glu_w, glu_b):
    dtype = u.dtype
    bsz, seq, _ = u.shape
    f32 = jnp.float32
    uf = u.astype(f32).reshape(bsz, seq, S5_GROUPS, S5_GROUP)
    lam = lax.complex(a_re.astype(f32), a_im.astype(f32))
    step = jnp.exp(log_step.astype(f32))[..., None]
    lam_bar = jnp.exp(lam * step)
    zoh = (lam_bar - 1.0) / lam
    bu = jnp.einsum('bsgc,gpc->bsgp', uf.astype(jnp.complex64),
                    lax.complex(b_re.astype(f32), b_im.astype(f32)))
    y = d_skip.astype(f32).reshape(S5_GROUPS, S5_GROUP) * uf
    for d in range(N_DIR):
        a_el = jnp.broadcast_to(lam_bar[d], (1, seq, S5_GROUPS, S5_STATE))
        _, hs = lax.associative_scan(_ssm_combine, (a_el, zoh[d] * bu), axis=1, reverse=(d == 1))
        c = lax.complex(c_re[d].astype(f32), c_im[d].astype(f32))
        y = y + jnp.einsum('bsgp,gcp->bsgc', hs, c).real
    y = jax.nn.gelu(y.reshape(bsz, seq, S5_WIDTH))
    zg = y @ glu_w.astype(f32) + glu_b.astype(f32)
    out = zg[..., :S5_WIDTH] * jax.nn.sigmoid(zg[..., S5_WIDTH:])
    return out.astype(dtype)


def setup_inputs(seed: int = 0) -> dict:
    key = jax.random.key(seed)
    keys = iter(jax.random.split(key, 48))
    f32 = jnp.float32
    L = DEPTH
    nrm = lambda shape, s: s * jax.random.normal(next(keys), shape, f32)
    gain = lambda shape: 1.0 + nrm(shape, 0.02)
    W, G, P = RWKV_WIDTH, S5_GROUPS, S5_STATE
    inp = {}
    inp['x'] = nrm((BATCH, SEQ, D_MODEL), 1.0)
    inp['ffn1_norm_g'] = gain((L, D_MODEL))
    inp['ffn1_w_gate'] = nrm((L, D_MODEL, D_FF), D_MODEL ** -0.5)
    inp['ffn1_w_up'] = nrm((L, D_MODEL, D_FF), D_MODEL ** -0.5)
    inp['ffn1_w_down'] = nrm((L, D_FF, D_MODEL), D_FF ** -0.5)
    inp['mix_norm_g'] = gain((L, D_MODEL))
    inp['w_in'] = nrm((L, D_MODEL, IN_WIDTH), D_MODEL ** -0.5)
    inp['w_out'] = nrm((L, D_MIX, D_MODEL), D_MIX ** -0.5)
    inp['rwkv_mu_prev'] = jax.random.uniform(next(keys), (L, RWKV_IN), f32, 0.0, 0.5)
    inp['rwkv_mu_next'] = jax.random.uniform(next(keys), (L, RWKV_IN), f32, 0.0, 0.5)
    inp['rwkv_decay_w0'] = jnp.linspace(-6.0, -1.0, W, dtype=f32) + nrm((L, N_DIR, W), 0.1)
    inp['rwkv_decay_w2'] = nrm((L, N_DIR, DECAY_LORA, W), 0.1 * DECAY_LORA ** -0.5)
    inp['rwkv_iclr_a0'] = nrm((L, N_DIR, W), 0.1)
    inp['rwkv_iclr_a2'] = nrm((L, N_DIR, ICLR_LORA, W), 0.5 * ICLR_LORA ** -0.5)
    inp['rwkv_gate_w2'] = nrm((L, GATE_LORA, W), GATE_LORA ** -0.5)
    inp['rwkv_k_k'] = 0.85 + nrm((L, W), 0.02)
    inp['rwkv_k_a'] = gain((L, W))
    inp['rwkv_r_k'] = nrm((L, RWKV_HEADS, HEAD_DIM), 0.1)
    inp['rwkv_lnx_w'] = gain((L, W))
    inp['rwkv_lnx_b'] = nrm((L, W), 0.02)
    inp['s5_a_re'] = -0.5 + nrm((L, N_DIR, G, P), 0.01)
    inp['s5_a_im'] = math.pi * jnp.arange(P, dtype=f32) + nrm((L, N_DIR, G, P), 0.01)
    inp['s5_log_step'] = jax.random.uniform(next(keys), (L, N_DIR, G), f32, math.log(1e-3), math.log(1e-1))
    inp['s5_b_re'] = nrm((L, G, P, S5_GROUP), (2.0 * S5_GROUP) ** -0.5)
    inp['s5_b_im'] = nrm((L, G, P, S5_GROUP), (2.0 * S5_GROUP) ** -0.5)
    inp['s5_c_re'] = nrm((L, N_DIR, G, S5_GROUP, P), (2.0 * P) ** -0.5)
    inp['s5_c_im'] = nrm((L, N_DIR, G, S5_GROUP, P), (2.0 * P) ** -0.5)
    inp['s5_d'] = nrm((L, S5_WIDTH), 1.0)
    inp['s5_glu_w'] = nrm((L, S5_WIDTH, 2 * S5_WIDTH), S5_WIDTH ** -0.5)
    inp['s5_glu_b'] = nrm((L, 2 * S5_WIDTH), 0.02)
    inp['ffn2_norm_g'] = gain((L, D_MODEL))
    inp['ffn2_w_gate'] = nrm((L, D_MODEL, D_FF), D_MODEL ** -0.5)
    inp['ffn2_w_up'] = nrm((L, D_MODEL, D_FF), D_MODEL ** -0.5)
    inp['ffn2_w_down'] = nrm((L, D_FF, D_MODEL), D_FF ** -0.5)
    inp['final_norm_g'] = gain((D_MODEL,))
    return inp


def reference(x, ffn1_norm_g, ffn1_w_gate, ffn1_w_up, ffn1_w_down, mix_norm_g, w_in, w_out,
              rwkv_mu_prev, rwkv_mu_next, rwkv_decay_w0, rwkv_decay_w2, rwkv_iclr_a0, rwkv_iclr_a2,
              rwkv_gate_w2, rwkv_k_k, rwkv_k_a, rwkv_r_k, rwkv_lnx_w, rwkv_lnx_b,
              s5_a_re, s5_a_im, s5_log_step, s5_b_re, s5_b_im, s5_c_re, s5_c_im, s5_d,
              s5_glu_w, s5_glu_b, ffn2_norm_g, ffn2_w_gate, ffn2_w_up, ffn2_w_down, final_norm_g):
    bsz, seq, _ = x.shape
    h = x
    for l in range(DEPTH):
        h = h + FFN_RESIDUAL * _swiglu(_rms_norm(h, ffn1_norm_g[l]), ffn1_w_gate[l], ffn1_w_up[l], ffn1_w_down[l])
        z = _rms_norm(h, mix_norm_g[l]) @ w_in[l]
        z_rwkv, z_attn, z_s5 = jnp.split(z, [RWKV_IN, RWKV_IN + ATTN_IN], axis=-1)
        o_rwkv = _rwkv7_time_mix(z_rwkv, rwkv_mu_prev[l], rwkv_mu_next[l], rwkv_decay_w0[l],
                                 rwkv_decay_w2[l], rwkv_iclr_a0[l], rwkv_iclr_a2[l], rwkv_gate_w2[l],
                                 rwkv_k_k[l], rwkv_k_a[l], rwkv_r_k[l], rwkv_lnx_w[l], rwkv_lnx_b[l])
        q, k, v = (t.reshape(bsz, seq, ATTN_HEADS, HEAD_DIM) for t in jnp.split(z_attn, 3, axis=-1))
        o_attn = _dilated_attention(q, k, v).reshape(bsz, seq, ATTN_WIDTH)
        o_s5 = _s5_mix(z_s5, s5_a_re[l], s5_a_im[l], s5_log_step[l], s5_b_re[l], s5_b_im[l],
                       s5_c_re[l], s5_c_im[l], s5_d[l], s5_glu_w[l], s5_glu_b[l])
        h = h + jnp.concatenate([o_rwkv, o_attn, o_s5], axis=-1) @ w_out[l]
        h = h + FFN_RESIDUAL * _swiglu(_rms_norm(h, ffn2_norm_g[l]), ffn2_w_gate[l], ffn2_w_up[l], ffn2_w_down[l])
    return _rms_norm(h, final_norm_g)
```

```cpp
#include <hip/hip_cooperative_groups.h>
#include <cstdio>
#include <hip/hip_runtime.h>
__device__ __forceinline__ int tid_from(int wv) { unsigned m = ~0u; asm volatile("" : "+s"(m), "+s"(wv)); return wv * 64 + (int)__builtin_amdgcn_mbcnt_hi(m, __builtin_amdgcn_mbcnt_lo(m, 0u)); }
#define TIDX (tid_from(p.wv))
__device__ __forceinline__ int bid_() { int b = blockIdx.x; asm volatile("" : "+s"(b)); return b; }
__device__ __forceinline__ int gdim_() { int b = gridDim.x; asm volatile("" : "+s"(b)); return b; }
#define BIDX (bid_())
#define GDIM (gdim_())
#include <hip/hip_runtime.h>
namespace pg8 {
#define PG8_LAS __attribute__((address_space(3)))
typedef unsigned short bf16_t;
typedef short bf16x8 __attribute__((ext_vector_type(8)));
typedef float f32x4 __attribute__((ext_vector_type(4)));
typedef unsigned u32x4 __attribute__((ext_vector_type(4)));
constexpr int BM = 256, BK = 64, HALF = 128, HTB = HALF * BK * 2  , STAGE_BYTES = 8 * HTB, NXCD = 8, WGM = 8;

__host__ __device__ __forceinline__ int lds_byte(int r, int c) { const int st = (r >> 4) * 2 + (c >> 5), rr = r & 15, cc = c & 31, ob = rr * 64 + cc * 2; return st * 1024 + (ob ^ (((ob >> 9) & 1) << 5)); }
__host__ __device__ __forceinline__ void stage_rc(int b, int& R, int& C) { const int st = b / 1024, sb = b % 1024, swz = sb ^ (((sb >> 9) & 1) << 5); R = (st >> 1) * 16 + swz / 64; C = (st & 1) * 32 + (swz % 64) / 2; }
__host__ __device__ __forceinline__ int perm32(int rho) { const int n = rho >> 4, i = rho & 15; return 8 * (i >> 2) + 4 * n + (i & 3); }

struct Unit { int pm, pn; };
struct Gemm { const bf16_t* A; const bf16_t* Bt; int M, N, K; };

struct StaticOrder {
    int nM, nN, nwg, G, c;
    __host__ __device__ void init(int M, int N, int G_, int c_) { nM = M / BM; nN = N / BM; nwg = nM * nN; G = G_; c = c_; }
    __host__ __device__ bool next(int i, Unit& u) const {
        const long L = (long)i * G + c; if (L >= nwg) return false;
        int wgid = (int)L; { const int q = nwg / NXCD, r = nwg % NXCD, xcd = wgid % NXCD, off = wgid / NXCD; wgid = (xcd < r ? xcd * (q + 1) : r * (q + 1) + (xcd - r) * q) + off; }
        const int nig = WGM * nN, gid = wgid / nig, fm = gid * WGM, gsz = (nM - fm) < WGM ? (nM - fm) : WGM;
        u.pm = fm + ((wgid % nig) % gsz); u.pn = (wgid % nig) / gsz; return true;
    }
    __device__ __forceinline__ void a_ready(const Unit&) const {}
    __device__ __forceinline__ void done(const Unit&) const {}
};
__device__ __forceinline__ unsigned cvt_pk_bf16(float lo, float hi) { unsigned r; asm volatile("v_cvt_pk_bf16_f32 %0, %1, %2" : "=v"(r) : "v"(lo), "v"(hi)); return r; }
template <class Epi, class Sched, bool STAMP = false>
__device__ __forceinline__ void gemm_phase(PG8_LAS unsigned char* lds, const Gemm g, const Sched& S, const Epi& E, unsigned long long* stamps, const int tid_in) {
    const int tid = tid_in, wid = __builtin_amdgcn_readfirstlane(tid >> 6), lane = tid & 63, wr = wid >> 2, wc = wid & 3, fr = lane & 15, fq = lane >> 4;
    const int K = g.K, nt = K / BK;
    int ts_lo = 0, ts_hi = 0, nts = 0; const unsigned long long rt_entry = STAMP ? (unsigned long long)wall_clock64() : 0ull;
#define PG8_STAMP() do { if (STAMP && wid == 0 && nts < 64) { const unsigned long long _c = (unsigned long long)clock64(); \
        ts_lo = (lane == nts) ? (int)(unsigned)_c : ts_lo; ts_hi = (lane == nts) ? (int)(unsigned)(_c >> 32) : ts_hi; ++nts; } } while (0)
    PG8_STAMP();
    unsigned voffA[2], voffB[2];
#pragma unroll
    for (int i = 0; i < 2; ++i) { int R, C; stage_rc(tid * 16 + i * 8192, R, C); const int Rb = Epi::PERM ? ((R & ~31) + perm32(R & 31)) : R;
        voffA[i] = (unsigned)(R * K + C) * 2u; voffB[i] = (unsigned)(Rb * K + C) * 2u; }
    const size_t kstep = (size_t)(BK * 2);
    const size_t hstep = (size_t)HALF * K * 2;
    const size_t tstep = 2 * hstep;
    const unsigned ldsw = (unsigned)wid * 1024u;
    const int aoff = lds_byte(wr * 64 + fr, fq * 8), boff = lds_byte(wc * 32 + fr, fq * 8);
#define PG8_SA(b, h) (((b) * 2 + (h)) * HTB)
#define PG8_SB(b, h) ((4 + (b) * 2 + (h)) * HTB)
#define PG8_STAGE(bufoff, gbase, voff) do { _Pragma("unroll") for (int _i = 0; _i < 2; ++_i) \
        __builtin_amdgcn_global_load_lds((const unsigned*)((const char*)(gbase) + (voff)[_i]), (PG8_LAS unsigned*)(lds + (bufoff) + ldsw + _i * 8192), 16, 0, 0); } while (0)
#define PG8_LDA(dst, b, h) do { _Pragma("unroll") for (int m = 0; m < 4; ++m) _Pragma("unroll") for (int k = 0; k < 2; ++k) dst[m][k] = *(const PG8_LAS bf16x8*)(lds + PG8_SA(b, h) + aoff + m * 2048 + k * 1024); } while (0)
#define PG8_LDB(dst, b, h) do { _Pragma("unroll") for (int n = 0; n < 2; ++n) _Pragma("unroll") for (int k = 0; k < 2; ++k) dst[n][k] = *(const PG8_LAS bf16x8*)(lds + PG8_SB(b, h) + boff + n * 2048 + k * 1024); } while (0)
#define PG8_MMA(ai, bj, At, Bt) do { __builtin_amdgcn_s_setprio(1); _Pragma("unroll") for (int m = 0; m < 4; ++m) _Pragma("unroll") for (int n = 0; n < 2; ++n) _Pragma("unroll") for (int k = 0; k < 2; ++k) \
        acc[ai][bj][m][n] = __builtin_amdgcn_mfma_f32_16x16x32_bf16(Bt[n][k], At[m][k], acc[ai][bj][m][n], 0, 0, 0); __builtin_amdgcn_s_setprio(0); } while (0)
#define PG8_WAIT_V(n) asm volatile("s_waitcnt vmcnt(" #n ")" ::: "memory")
#define PG8_WAIT_L(n) asm volatile("s_waitcnt lgkmcnt(" #n ")" ::: "memory")
#define PG8_BAR __builtin_amdgcn_s_barrier()
#define PG8_SCHED __builtin_amdgcn_sched_barrier(0)
    Unit cur, nxt; int ui = 0;
    if (!S.next(0, cur)) return;
    f32x4 acc[2][2][4][2];
#pragma unroll
    for (int a = 0; a < 2; ++a)
#pragma unroll
        for (int b = 0; b < 2; ++b)
#pragma unroll
            for (int m = 0; m < 4; ++m)
#pragma unroll
                for (int n = 0; n < 2; ++n) acc[a][b][m][n] = (f32x4){0.f, 0.f, 0.f, 0.f};
    bf16x8 At[4][2], B0[2][2], B1[2][2];
    const char* cA = (const char*)g.A + (size_t)cur.pm * tstep; const char* cB = (const char*)g.Bt + (size_t)cur.pn * tstep;
    S.a_ready(cur);
    PG8_STAGE(PG8_SB(0, 0), cB, voffB); PG8_STAGE(PG8_SA(0, 0), cA, voffA); PG8_STAGE(PG8_SB(0, 1), cB + hstep, voffB); PG8_STAGE(PG8_SA(0, 1), cA + hstep, voffA);
    if (wr == 1) PG8_BAR;
    PG8_WAIT_V(4); PG8_BAR;
    PG8_STAGE(PG8_SB(1, 0), cB + kstep, voffB); PG8_STAGE(PG8_SA(1, 0), cA + kstep, voffA); PG8_STAGE(PG8_SB(1, 1), cB + hstep + kstep, voffB);
    PG8_WAIT_V(6); PG8_BAR;
    PG8_STAMP();
    for (;;) {
        const bool has_next = S.next(ui + 1, nxt);
        const char* nA = has_next ? (const char*)g.A + (size_t)nxt.pm * tstep : cA; const char* nB = has_next ? (const char*)g.Bt + (size_t)nxt.pn * tstep : cB;
        for (int t = 0; t < nt; t += 2) {
            const bool last = (t == nt - 2);
            const char* a1 = cA + (size_t)(t + 1) * kstep;
            const char* a2 = last ? nA : cA + (size_t)(t + 2) * kstep; const char* b2 = last ? nB : cB + (size_t)(t + 2) * kstep;
            const char* a3 = a2 + kstep; const char* b3 = b2 + kstep;
            if (last && has_next) S.a_ready(nxt);
            PG8_LDB(B0, 0, 0); PG8_SCHED; PG8_LDA(At, 0, 0); PG8_STAGE(PG8_SA(1, 1), a1 + hstep, voffA);
            PG8_WAIT_L(8); PG8_BAR; PG8_WAIT_L(0); PG8_MMA(0, 0, At, B0); PG8_BAR; PG8_SCHED;
            PG8_LDB(B1, 0, 1); PG8_STAGE(PG8_SB(0, 0), b2, voffB);
            PG8_BAR; PG8_WAIT_L(0); PG8_MMA(0, 1, At, B1); PG8_BAR;
            PG8_LDA(At, 0, 1); PG8_STAGE(PG8_SA(0, 0), a2, voffA);
            PG8_BAR; PG8_WAIT_L(0); PG8_MMA(1, 0, At, B0); PG8_BAR; PG8_SCHED;
            PG8_STAGE(PG8_SB(0, 1), b2 + hstep, voffB);
            PG8_WAIT_V(6); PG8_BAR; PG8_MMA(1, 1, At, B1); PG8_BAR;
            PG8_LDB(B0, 1, 0); PG8_SCHED; PG8_LDA(At, 1, 0); PG8_STAGE(PG8_SA(0, 1), a2 + hstep, voffA);
            PG8_WAIT_L(8); PG8_BAR; PG8_WAIT_L(0); PG8_MMA(0, 0, At, B0); PG8_BAR; PG8_SCHED;
            PG8_LDB(B1, 1, 1); PG8_STAGE(PG8_SB(1, 0), b3, voffB);
            PG8_BAR; PG8_WAIT_L(0); PG8_MMA(0, 1, At, B1); PG8_BAR;
            PG8_LDA(At, 1, 1); PG8_STAGE(PG8_SA(1, 0), a3, voffA);
            PG8_BAR; PG8_WAIT_L(0); PG8_MMA(1, 0, At, B0); PG8_BAR; PG8_SCHED;
            PG8_STAGE(PG8_SB(1, 1), b3 + hstep, voffB);
            PG8_WAIT_V(6); PG8_BAR; PG8_MMA(1, 1, At, B1); PG8_BAR;
        }
        PG8_STAMP();
        if constexpr (!Epi::AFTER_DRAIN) { E(acc, cur, wr, wc, fr, fq); S.done(cur); }
        PG8_STAMP();
        if (!has_next) break;
#pragma unroll
        for (int a = 0; a < 2; ++a)
#pragma unroll
            for (int b = 0; b < 2; ++b)
#pragma unroll
                for (int m = 0; m < 4; ++m)
#pragma unroll
                    for (int n = 0; n < 2; ++n) acc[a][b][m][n] = (f32x4){0.f, 0.f, 0.f, 0.f};
        cur = nxt; cA = nA; cB = nB; ++ui;
    }
    PG8_WAIT_V(0);
    if (wr == 0) PG8_BAR;
    PG8_BAR;
    if constexpr (Epi::AFTER_DRAIN) { E.fused(acc, cur, wr, wc, fr, fq, lds, wid, lane); S.done(cur); }
    PG8_STAMP();
    if (STAMP && wid == 0) { stamps[lane] = lane < nts ? (((unsigned long long)(unsigned)ts_hi << 32) | (unsigned)ts_lo) : 0ull;
        if (lane == 62) stamps[62] = rt_entry; if (lane == 63) stamps[63] = (unsigned long long)wall_clock64(); }
#undef PG8_STAMP
#undef PG8_SA
#undef PG8_SB
#undef PG8_STAGE
#undef PG8_LDA
#undef PG8_LDB
#undef PG8_MMA
#undef PG8_WAIT_V
#undef PG8_WAIT_L
#undef PG8_BAR
#undef PG8_SCHED
}
}

#include <cstdio>
#include <ctime>
#include <cstdlib>
#include <cstring>
#include <cmath>
#include <vector>
#include <algorithm>

namespace cg = cooperative_groups;
using pg8::bf16_t; using pg8::bf16x8; using pg8::f32x4;
typedef _Float16 f16_t;
typedef short bf16x4 __attribute__((ext_vector_type(4)));
typedef unsigned u32x4 __attribute__((ext_vector_type(4)));
typedef unsigned u32x2 __attribute__((ext_vector_type(2)));
#define LAS __attribute__((address_space(3)))

#ifndef EN_RWKV
#define EN_RWKV 1
#endif
#ifndef EN_ATTN
#define EN_ATTN 1
#endif
#ifndef EN_S5
#define EN_S5 1
#endif
#ifndef EN_FFN
#define EN_FFN 1
#endif

constexpr int MTOK = 65536, SEQ = 8192;
constexpr int LDS_BYTES = 131072 + 512;
constexpr size_t WL_GU1 = 0, WL_D1 = WL_GU1 + 11534336, WL_IN = WL_D1 + 5767168, WL_OUT = WL_IN + 5767168, WL_GU2 = WL_OUT + 2097152,
                 WL_D2 = WL_GU2 + 11534336, WL_GLU = WL_D2 + 5767168, WL_W2 = WL_GLU + 262144, WL_A2 = WL_W2 + 98304, WL_G2 = WL_A2 + 98304, WL_SIZE = WL_G2 + 98304;
constexpr size_t WS_WB = 0, WS_XN = WS_WB + 2 * WL_SIZE, WS_BIG = WS_XN + 134217728, WS_LAM = WS_BIG + 369098752, WS_AA = WS_LAM + 100663296,
                 WS_GG = WS_AA + 100663296, WS_YY = WS_GG + 50331648, WS_YPRE = WS_YY + 100663296, WS_LSE = WS_YPRE + 33554432, WS_CB = WS_LSE + 1572864,
                 WS_S5E = WS_CB + 3145728, WS_CTR = WS_S5E + 8388608, WS_END = WS_CTR + 256;

struct Params { const float* in[35]; float* out; unsigned char* ws; };
struct Ctx { LAS const unsigned long long* tab; int wv; };
template <class T> __device__ __forceinline__ T* ldsptr(LAS const unsigned long long* tab, int i) {
    unsigned a_; asm volatile("s_mov_b32 %0, 0x20040" : "=s"(a_)); a_ += (unsigned)i * 8u;
    const unsigned long long v = *(LAS const unsigned long long*)a_; const unsigned lo = __builtin_amdgcn_readfirstlane((unsigned)v), hi = __builtin_amdgcn_readfirstlane((unsigned)(v >> 32));
    unsigned long long r = ((unsigned long long)hi << 32) | lo; asm volatile("" : "+s"(r));
    return (T*)(__attribute__((address_space(1))) T*)r; }
#define PWS (ldsptr<unsigned char>(p.tab, 36))
#define POUT (ldsptr<float>(p.tab, 35))
#define PIN(i) (ldsptr<const float>(p.tab, i))

__device__ __forceinline__ float bf2f(unsigned short b) { return __uint_as_float(((unsigned)b) << 16); }
__device__ __forceinline__ unsigned pk2(float lo, float hi) { return pg8::cvt_pk_bf16(lo, hi); }
__device__ __forceinline__ float shx(float v, int o, int lane) { return __builtin_bit_cast(float, __builtin_amdgcn_ds_bpermute((lane ^ o) << 2, __builtin_bit_cast(int, v))); }
#define LAUNDER(x) asm volatile("" : "+v"(x))
__device__ __forceinline__ float dpp_ror_add(float x, const int ctrl_unused) { return x; }
#define DPP_ROR_ADD(x, N) ((x) + __builtin_bit_cast(float, __builtin_amdgcn_update_dpp(0, __builtin_bit_cast(int, (x)), 0x120 + (N), 0xf, 0xf, false)))
__device__ __forceinline__ float row16_sum(float x) {
    x = DPP_ROR_ADD(x, 8); x = DPP_ROR_ADD(x, 4); x = DPP_ROR_ADD(x, 2); x = DPP_ROR_ADD(x, 1); return x;
}
__device__ __forceinline__ float wave_sum(float v, int lane) {
    v = row16_sum(v); v += shx(v, 16, lane); v += shx(v, 32, lane); return v;
}
__device__ __forceinline__ float sigmoidf_(float x) { return __builtin_amdgcn_rcpf(1.f + __expf(-x)); }
__device__ __forceinline__ float tanhf_(float x) { const float e = __expf(2.f * x); return 1.f - 2.f * __builtin_amdgcn_rcpf(e + 1.f); }
__device__ __forceinline__ f32x4 mfma16(bf16x8 a, bf16x8 b, f32x4 c) { return __builtin_amdgcn_mfma_f32_16x16x32_bf16(a, b, c, 0, 0, 0); }

template <class F> __device__ __forceinline__ void prep_t(bf16_t* dst, int N, int K, F src, int gtid, int gthreads) {
    const int total = N * (K >> 3);
    for (int i = gtid; i < total; i += gthreads) {
        const int n = i % N, k0 = (i / N) << 3;
        const float v0 = src(n, k0), v1 = src(n, k0 + 1), v2 = src(n, k0 + 2), v3 = src(n, k0 + 3), v4 = src(n, k0 + 4), v5 = src(n, k0 + 5), v6 = src(n, k0 + 6), v7 = src(n, k0 + 7);
        uint4 o; o.x = pk2(v0, v1); o.y = pk2(v2, v3); o.z = pk2(v4, v5); o.w = pk2(v6, v7);
        *(uint4*)(dst + (size_t)n * K + k0) = o;
    }
}
__device__ __forceinline__ void weights_phase(const Ctx& p) {
    const int gtid = BIDX * 512 + TIDX, gth = GDIM * 512;
    for (int l = 0; l < 2; ++l) {
        unsigned char* wl = PWS + WS_WB + (size_t)l * WL_SIZE;
        for (int f = 0; f < 2; ++f) {
            const float* wg = PIN(f ? 31 : 2) + (size_t)l * 1024 * 2816; const float* wu = PIN(f ? 32 : 3) + (size_t)l * 1024 * 2816; const float* wd = PIN(f ? 33 : 4) + (size_t)l * 2816 * 1024;
            prep_t((bf16_t*)(wl + (f ? WL_GU2 : WL_GU1)), 5632, 1024, [=](int n, int k) { const int t = n >> 8, i = n & 255; return (i < 128) ? wg[(size_t)k * 2816 + t * 128 + i] : wu[(size_t)k * 2816 + t * 128 + i - 128]; }, gtid, gth);
            prep_t((bf16_t*)(wl + (f ? WL_D2 : WL_D1)), 1024, 2816, [=](int n, int k) { return wd[(size_t)k * 1024 + n]; }, gtid, gth);
        }
        { const float* w = PIN(6) + (size_t)l * 1024 * 2816; prep_t((bf16_t*)(wl + WL_IN), 2816, 1024, [=](int n, int k) { return w[(size_t)k * 2816 + n]; }, gtid, gth); }
        { const float* w = PIN(7) + (size_t)l * 1024 * 1024; prep_t((bf16_t*)(wl + WL_OUT), 1024, 1024, [=](int n, int k) { return w[(size_t)k * 1024 + n]; }, gtid, gth); }
        { const float* w = PIN(28) + (size_t)l * 256 * 512; prep_t((bf16_t*)(wl + WL_GLU), 512, 256, [=](int n, int k) { const int t = n >> 8, i = n & 255; return (i < 128) ? w[k * 512 + t * 128 + i] : w[k * 512 + 256 + t * 128 + i - 128]; }, gtid, gth); }
        { const float* w = PIN(11) + (size_t)l * 2 * 64 * 384; prep_t((bf16_t*)(wl + WL_W2), 768, 64, [=](int n, int k) { const int d = n / 384, c = n % 384; return w[(d * 64 + k) * 384 + c]; }, gtid, gth); }
        { const float* w = PIN(13) + (size_t)l * 2 * 64 * 384; prep_t((bf16_t*)(wl + WL_A2), 768, 64, [=](int n, int k) { const int d = n / 384, c = n % 384; return w[(d * 64 + k) * 384 + c]; }, gtid, gth); }
        { const float* w = PIN(14) + (size_t)l * 128 * 384; prep_t((bf16_t*)(wl + WL_G2), 384, 128, [=](int n, int k) { return w[k * 384 + n]; }, gtid, gth); }
    }
}

__device__ __forceinline__ void norm_phase(const Ctx& p, const float* hin, const float* g, bf16_t* xn, float* fout) {
    const int lane = TIDX & 63, wave = BIDX * 8 + (TIDX >> 6), nw = GDIM * 8;
    float4 gv[4];
#pragma unroll
    for (int i = 0; i < 4; ++i) gv[i] = *(const float4*)(g + lane * 4 + 256 * i);
    for (int row = wave; row < MTOK; row += nw) {
        const float* pr = hin + (size_t)row * 1024;
        float4 v[4]; float ss = 0.f;
#pragma unroll
        for (int i = 0; i < 4; ++i) { v[i] = *(const float4*)(pr + lane * 4 + 256 * i); ss += v[i].x * v[i].x + v[i].y * v[i].y + v[i].z * v[i].z + v[i].w * v[i].w; }
        ss = wave_sum(ss, lane);
        const float rs = rsqrtf(ss * (1.f / 1024.f) + 1e-6f);
        if (xn) {
#pragma unroll
            for (int i = 0; i < 4; ++i) { uint2 o; o.x = pk2(v[i].x * rs * gv[i].x, v[i].y * rs * gv[i].y); o.y = pk2(v[i].z * rs * gv[i].z, v[i].w * rs * gv[i].w); *(uint2*)(xn + (size_t)row * 1024 + lane * 4 + 256 * i) = o; }
        } else {
#pragma unroll
            for (int i = 0; i < 4; ++i) { float4 o; o.x = v[i].x * rs * gv[i].x; o.y = v[i].y * rs * gv[i].y; o.z = v[i].z * rs * gv[i].z; o.w = v[i].w * rs * gv[i].w; *(float4*)(fout + (size_t)row * 1024 + lane * 4 + 256 * i) = o; }
        }
    }
}

struct EpiSwiGLU { int wv; static constexpr bool PERM = true, AFTER_DRAIN = false; bf16_t* O;
    __device__ __forceinline__ void operator()(const f32x4 (&acc)[2][2][4][2], const pg8::Unit& u, int wr, int wc, int fr_, int fq_) const {
        const int ln_ = tid_from(wv) & 63, fr = ln_ & 15, fq = ln_ >> 4;
        const int row0 = u.pm * 256 + wr * 64 + fr, col0 = u.pn * 128 + wc * 32 + 8 * fq;
#pragma unroll
        for (int ai = 0; ai < 2; ++ai)
#pragma unroll
            for (int m = 0; m < 4; ++m) {
                float r[8];
#pragma unroll
                for (int n = 0; n < 2; ++n)
#pragma unroll
                    for (int j = 0; j < 4; ++j) { const float g = acc[ai][0][m][n][j], uu = acc[ai][1][m][n][j]; r[n * 4 + j] = g * sigmoidf_(g) * uu; }
                uint4 o; o.x = pk2(r[0], r[1]); o.y = pk2(r[2], r[3]); o.z = pk2(r[4], r[5]); o.w = pk2(r[6], r[7]);
                *(uint4*)(O + (size_t)(row0 + ai * 128 + m * 16) * 2816 + col0) = o;
            }
    }
};
struct EpiResid { int wv; static constexpr bool PERM = false, AFTER_DRAIN = false; const float* hin; float* hout; float alpha;
    __device__ __forceinline__ void operator()(const f32x4 (&acc)[2][2][4][2], const pg8::Unit& u, int wr, int wc, int fr_, int fq_) const {
        const int ln_ = tid_from(wv) & 63, fr = ln_ & 15, fq = ln_ >> 4;
        const int row0 = u.pm * 256 + wr * 64 + fr, col0 = u.pn * 256 + wc * 32 + 4 * fq;
#pragma unroll
        for (int ai = 0; ai < 2; ++ai)
#pragma unroll
            for (int m = 0; m < 4; ++m) { const size_t ro = (size_t)(row0 + ai * 128 + m * 16) * 1024 + col0;
#pragma unroll
                for (int bj = 0; bj < 2; ++bj)
#pragma unroll
                    for (int n = 0; n < 2; ++n) { const f32x4 hv = *(const f32x4*)(hin + ro + bj * 128 + n * 16); *(f32x4*)(hout + ro + bj * 128 + n * 16) = hv + alpha * acc[ai][bj][m][n]; } }
    }
};
struct EpiZ { int wv; static constexpr bool PERM = true, AFTER_DRAIN = false; bf16_t* O;
    __device__ __forceinline__ void operator()(const f32x4 (&acc)[2][2][4][2], const pg8::Unit& u, int wr, int wc, int fr_, int fq_) const {
        const int ln_ = tid_from(wv) & 63, fr = ln_ & 15, fq = ln_ >> 4;
        const int row0 = u.pm * 256 + wr * 64 + fr, col0 = u.pn * 256 + wc * 32 + 8 * fq;
#pragma unroll
        for (int ai = 0; ai < 2; ++ai)
#pragma unroll
            for (int m = 0; m < 4; ++m)
#pragma unroll
                for (int bj = 0; bj < 2; ++bj) { const f32x4 a = acc[ai][bj][m][0], b = acc[ai][bj][m][1];
                    uint4 o; o.x = pk2(a[0], a[1]); o.y = pk2(a[2], a[3]); o.z = pk2(b[0], b[1]); o.w = pk2(b[2], b[3]);
                    *(uint4*)(O + (size_t)(row0 + ai * 128 + m * 16) * 2816 + col0 + bj * 128) = o; }
    }
};
struct EpiGLU { int wv; static constexpr bool PERM = true, AFTER_DRAIN = false; bf16_t* O; const float* bias;
    __device__ __forceinline__ void operator()(const f32x4 (&acc)[2][2][4][2], const pg8::Unit& u, int wr, int wc, int fr_, int fq_) const {
        const int ln_ = tid_from(wv) & 63, fr = ln_ & 15, fq = ln_ >> 4;
        const int row0 = u.pm * 256 + wr * 64 + fr, cw = u.pn * 128 + wc * 32 + 8 * fq;
        const f32x4 bv0 = *(const f32x4*)(bias + cw), bv1 = *(const f32x4*)(bias + cw + 4), bg0 = *(const f32x4*)(bias + 256 + cw), bg1 = *(const f32x4*)(bias + 256 + cw + 4);
#pragma unroll
        for (int ai = 0; ai < 2; ++ai)
#pragma unroll
            for (int m = 0; m < 4; ++m) {
                const f32x4 v0 = acc[ai][0][m][0] + bv0, v1 = acc[ai][0][m][1] + bv1, g0 = acc[ai][1][m][0] + bg0, g1 = acc[ai][1][m][1] + bg1;
                uint4 o; o.x = pk2(v0[0] * sigmoidf_(g0[0]), v0[1] * sigmoidf_(g0[1])); o.y = pk2(v0[2] * sigmoidf_(g0[2]), v0[3] * sigmoidf_(g0[3]));
                o.z = pk2(v1[0] * sigmoidf_(g1[0]), v1[1] * sigmoidf_(g1[1])); o.w = pk2(v1[2] * sigmoidf_(g1[2]), v1[3] * sigmoidf_(g1[3]));
                *(uint4*)(O + (size_t)(row0 + ai * 128 + m * 16) * 1024 + 768 + cw) = o;
            }
    }
};
template <class Epi> __device__ __forceinline__ void gemm_run(const Ctx& p, LAS unsigned char* lds, const bf16_t* A, const bf16_t* Bt, int N, int K, const Epi& E) {
    asm volatile("" : "+s"(N), "+s"(K));
    pg8::Gemm g; g.A = A; g.Bt = Bt; g.M = MTOK; g.N = N; g.K = K;
    pg8::StaticOrder S; S.init(MTOK, N, (int)GDIM, (int)BIDX);
    pg8::gemm_phase<Epi, pg8::StaticOrder, false>(lds, g, S, E, nullptr, TIDX);
}

__device__ __forceinline__ void rwkv_prep_phase(const Ctx& p, int l) {
    const bf16_t* z = (const bf16_t*)(PWS + WS_BIG);
    const unsigned char* wl = PWS + WS_WB + (size_t)l * WL_SIZE;
    const bf16_t* w2t = (const bf16_t*)(wl + WL_W2); const bf16_t* a2t = (const bf16_t*)(wl + WL_A2); const bf16_t* g2t = (const bf16_t*)(wl + WL_G2);
    const float* mup = PIN(8) + l * 1408; const float* mun = PIN(9) + l * 1408;
    const float* w0 = PIN(10) + l * 768; const float* a0 = PIN(12) + l * 768;
    f16_t* lam = (f16_t*)(PWS + WS_LAM); f16_t* aa = (f16_t*)(PWS + WS_AA); f16_t* gg = (f16_t*)(PWS + WS_GG);
    const int lane = TIDX & 63, fr = lane & 15, fq = lane >> 4;
    const int gw = BIDX * 8 + (TIDX >> 6), nw = GDIM * 8;
    for (int it = gw; it < MTOK / 32; it += nw) {
        const int m0 = it * 32;
        bf16x8 A[2][8];
#pragma unroll
        for (int sub = 0; sub < 2; ++sub) {
            const int tok = m0 + sub * 16 + fr, t = tok & (SEQ - 1);
            const bf16_t* zc = z + (size_t)tok * 2816;
            const bf16_t* zp = (t > 0) ? zc - 2816 : zc; const bf16_t* zn = (t < SEQ - 1) ? zc + 2816 : zc;
            const float fp = (t > 0) ? 1.f : 0.f, fn = (t < SEQ - 1) ? 1.f : 0.f;
#pragma unroll
            for (int ks = 0; ks < 8; ++ks) {
                const int col = 1152 + ks * 32 + fq * 8;
                const bf16x8 c8 = *(const bf16x8*)(zc + col), p8 = *(const bf16x8*)(zp + col), n8 = *(const bf16x8*)(zn + col);
                float r[8];
#pragma unroll
                for (int e = 0; e < 8; ++e) {
                    const float x = bf2f((unsigned short)c8[e]), xp = fp * bf2f((unsigned short)p8[e]), xn = fn * bf2f((unsigned short)n8[e]);
                    const float xm = x + mup[col + e] * (xp - x) + mun[col + e] * (xn - x);
                    r[e] = (ks < 2) ? tanhf_(xm) : ((ks < 4) ? xm : sigmoidf_(xm));
                }
                union { uint4 u; bf16x8 v; } cv; cv.u.x = pk2(r[0], r[1]); cv.u.y = pk2(r[2], r[3]); cv.u.z = pk2(r[4], r[5]); cv.u.w = pk2(r[6], r[7]);
                A[sub][ks] = cv.v;
            }
        }
#pragma unroll 1
        for (int nt = 0; nt < 48; ++nt) {
            const bf16x8 b0 = *(const bf16x8*)(w2t + (nt * 16 + fr) * 64 + fq * 8), b1 = *(const bf16x8*)(w2t + (nt * 16 + fr) * 64 + 32 + fq * 8);
            const bf16x8 c0 = *(const bf16x8*)(a2t + (nt * 16 + fr) * 64 + fq * 8), c1 = *(const bf16x8*)(a2t + (nt * 16 + fr) * 64 + 32 + fq * 8);
            const int n0 = nt * 16 + fq * 4;
            const f32x4 w0v = *(const f32x4*)(w0 + n0), a0v = *(const f32x4*)(a0 + n0);
#pragma unroll
            for (int sub = 0; sub < 2; ++sub) {
                const int tok = m0 + sub * 16 + fr;
                f32x4 acc = {0.f, 0.f, 0.f, 0.f}; acc = mfma16(b0, A[sub][0], acc); acc = mfma16(b1, A[sub][1], acc);
                f32x4 aca = {0.f, 0.f, 0.f, 0.f}; aca = mfma16(c0, A[sub][2], aca); aca = mfma16(c1, A[sub][3], aca);
                union { f16_t h[4]; uint2 u; } o1, o2;
#pragma unroll
                for (int j = 0; j < 4; ++j) { o1.h[j] = (f16_t)(0.60653066f * sigmoidf_(w0v[j] + acc[j])); o2.h[j] = (f16_t)sigmoidf_(a0v[j] + aca[j]); }
                *(uint2*)(lam + (size_t)tok * 768 + n0) = o1.u; *(uint2*)(aa + (size_t)tok * 768 + n0) = o2.u;
            }
        }
#pragma unroll 1
        for (int nt = 0; nt < 24; ++nt) {
            bf16x8 bb[4];
#pragma unroll
            for (int ks = 0; ks < 4; ++ks) bb[ks] = *(const bf16x8*)(g2t + (nt * 16 + fr) * 128 + ks * 32 + fq * 8);
            const int n0 = nt * 16 + fq * 4;
#pragma unroll
            for (int sub = 0; sub < 2; ++sub) {
                const int tok = m0 + sub * 16 + fr;
                f32x4 acc = {0.f, 0.f, 0.f, 0.f};
#pragma unroll
                for (int ks = 0; ks < 4; ++ks) acc = mfma16(bb[ks], A[sub][4 + ks], acc);
                union { f16_t h[4]; uint2 u; } o1;
#pragma unroll
                for (int j = 0; j < 4; ++j) o1.h[j] = (f16_t)acc[j];
                *(uint2*)(gg + (size_t)tok * 384 + n0) = o1.u;
            }
        }
    }
}

struct S5Lane { float lbr, lbi; float bre[16], bim[16]; };
__device__ __forceinline__ void s5_lane_params(const Ctx& p, int l, int d, int g, int pp, S5Lane& q) {
    const int idx = ((l * 2 + d) * 16 + g) * 64 + pp;
    const float are = PIN(20)[idx], aim = PIN(21)[idx], st = __expf(PIN(22)[(l * 2 + d) * 16 + g]);
    const float er = __expf(are * st), ang = aim * st;
    const float kf = rintf(ang * 0.15915494309f); float rr = fmaf(-kf, 6.2831855f, ang); rr = fmaf(-kf, -1.7484555e-7f, rr);
    float sn, cs; __sincosf(rr, &sn, &cs);
    q.lbr = er * cs; q.lbi = er * sn;
    const float nr = q.lbr - 1.f, ni = q.lbi, den = __builtin_amdgcn_rcpf(are * are + aim * aim);
    const float zr = (nr * are + ni * aim) * den, zi = (ni * are - nr * aim) * den;
    const float* br = PIN(23) + ((size_t)(l * 16 + g) * 64 + pp) * 16; const float* bi = PIN(24) + ((size_t)(l * 16 + g) * 64 + pp) * 16;
#pragma unroll
    for (int c = 0; c < 16; ++c) { const float x = br[c], y = bi[c]; q.bre[c] = zr * x - zi * y; q.bim[c] = zr * y + zi * x; }
}
__device__ __forceinline__ void s5_stage_u(const Ctx& p, int b, int c, int gq, LAS float* uf) {
    const bf16_t* z = (const bf16_t*)(PWS + WS_BIG);
#pragma unroll
    for (int i = 0; i < 2; ++i) {
        const int e = TIDX + 512 * i, t = e >> 3, part = e & 7;
        const bf16x8 v = *(const bf16x8*)(z + (size_t)(b * SEQ + c * 128 + t) * 2816 + 2560 + gq * 64 + part * 8);
#pragma unroll
        for (int k = 0; k < 8; ++k) uf[t * 64 + part * 8 + k] = bf2f((unsigned short)v[k]);
    }
}
__device__ __forceinline__ void s5_step(const S5Lane& q, const LAS float* urow, float& hr, float& hi) {
    float bur = 0.f, bui = 0.f;
#pragma unroll
    for (int c4 = 0; c4 < 4; ++c4) { const f32x4 u = *(const LAS f32x4*)(urow + c4 * 4);
#pragma unroll
        for (int k = 0; k < 4; ++k) { bur = fmaf(q.bre[c4 * 4 + k], u[k], bur); bui = fmaf(q.bim[c4 * 4 + k], u[k], bui); } }
    const float nr = q.lbr * hr - q.lbi * hi + bur, ni = q.lbr * hi + q.lbi * hr + bui; hr = nr; hi = ni;
}
__device__ __forceinline__ void s5_passA_item(const Ctx& p, int l, int item, LAS unsigned char* lds) {
    const int gq = item & 3, c = (item >> 2) & 63, b = item >> 8;
    const int wid = TIDX >> 6, lane = TIDX & 63, gi = wid >> 1, d = wid & 1, g = gq * 4 + gi;
    LAS float* uf = (LAS float*)lds;
    __syncthreads();
    s5_stage_u(p, b, c, gq, uf);
    S5Lane q; s5_lane_params(p, l, d, g, lane, q);
    __syncthreads();
    float hr = 0.f, hi = 0.f;
    for (int s = 0; s < 128; ++s) { const int ti = d ? 127 - s : s; s5_step(q, uf + ti * 64 + gi * 16, hr, hi); }
    float2* E = (float2*)(PWS + WS_S5E);
    E[((size_t)((b * 16 + g) * 2 + d) * 64 + c) * 64 + lane] = make_float2(hr, hi);
}
__device__ __forceinline__ void s5_passC_item(const Ctx& p, int l, int item, LAS unsigned char* lds) {
    const int gq = item & 3, c = (item >> 2) & 63, b = item >> 8;
    const int tid = TIDX, wid = tid >> 6, lane = tid & 63, gi = wid >> 1, d = wid & 1, g = gq * 4 + gi, fr = lane & 15, fq = lane >> 4;
    LAS float* uf = (LAS float*)lds;
    LAS bf16_t* hs = (LAS bf16_t*)(lds + 32768) + wid * 16 * 136;
    LAS float* yl = (LAS float*)(lds + 32768 + 34816);
    __syncthreads();
    s5_stage_u(p, b, c, gq, uf);
    S5Lane q; s5_lane_params(p, l, d, g, lane, q);
    bf16x8 Cf[4];
    {
        const float* cre = PIN(25) + ((size_t)((l * 2 + d) * 16 + g) * 16 + fr) * 64; const float* cim = PIN(26) + ((size_t)((l * 2 + d) * 16 + g) * 16 + fr) * 64;
#pragma unroll
        for (int ks = 0; ks < 4; ++ks) { const int q0 = ks * 32 + fq * 8; float r[8];
#pragma unroll
            for (int e = 0; e < 8; ++e) r[e] = (q0 < 64) ? cre[q0 + e] : -cim[q0 - 64 + e];
            union { uint4 u; bf16x8 v; } cv; cv.u.x = pk2(r[0], r[1]); cv.u.y = pk2(r[2], r[3]); cv.u.z = pk2(r[4], r[5]); cv.u.w = pk2(r[6], r[7]); Cf[ks] = cv.v; }
    }
    float hr = 0.f, hi = 0.f;
    {
        float tr = q.lbr, ti = q.lbi;
#pragma unroll
        for (int k = 0; k < 7; ++k) { const float a = tr * tr - ti * ti, bq = 2.f * tr * ti; tr = a; ti = bq; }
        const float2* E = (const float2*)(PWS + WS_S5E) + ((size_t)((b * 16 + g) * 2 + d) * 64) * 64 + lane;
        if (d == 0) { for (int cc = 0; cc < c; ++cc) { const float2 e = E[(size_t)cc * 64]; const float nr = tr * hr - ti * hi + e.x, ni = tr * hi + ti * hr + e.y; hr = nr; hi = ni; } }
        else { for (int cc = 63; cc > c; --cc) { const float2 e = E[(size_t)cc * 64]; const float nr = tr * hr - ti * hi + e.x, ni = tr * hi + ti * hr + e.y; hr = nr; hi = ni; } }
    }
    __syncthreads();
    {
        const float* dsk = PIN(27) + l * 256 + gq * 64;
        for (int e = tid; e < 128 * 64; e += 512) { const int t = e >> 6, ch = e & 63; yl[((ch >> 4) * 128 + t) * 17 + (ch & 15)] = dsk[ch] * uf[e]; }
    }
    for (int sub = 0; sub < 8; ++sub) {
        for (int s16 = 0; s16 < 16; ++s16) {
            const int s = sub * 16 + s16, ti = d ? 127 - s : s;
            s5_step(q, uf + ti * 64 + gi * 16, hr, hi);
            const unsigned pk = pk2(hr, hi);
            hs[(ti & 15) * 136 + lane] = (bf16_t)(pk & 0xffffu); hs[(ti & 15) * 136 + 64 + lane] = (bf16_t)(pk >> 16);
        }
        __syncthreads();
        {
            f32x4 acc = {0.f, 0.f, 0.f, 0.f};
#pragma unroll
            for (int ks = 0; ks < 4; ++ks) { const bf16x8 af = *(const LAS bf16x8*)(hs + fr * 136 + ks * 32 + fq * 8); acc = mfma16(Cf[ks], af, acc); }
            const int tile = d ? 7 - sub : sub;
            LAS float* yp = yl + (gi * 128 + tile * 16 + fr) * 17 + fq * 4;
#pragma unroll
            for (int j = 0; j < 4; ++j) yp[j] += acc[j];
        }
        __syncthreads();
    }
    {
        bf16_t* yo = (bf16_t*)(PWS + WS_YPRE);
        const int t = tid >> 2, g4 = tid & 3;
        float r[16];
#pragma unroll
        for (int k = 0; k < 16; ++k) { const float x = yl[(g4 * 128 + t) * 17 + k]; r[k] = 0.5f * x * (1.f + tanhf_(0.7978845608f * (x + 0.044715f * x * x * x))); }
        uint4 o0, o1; o0.x = pk2(r[0], r[1]); o0.y = pk2(r[2], r[3]); o0.z = pk2(r[4], r[5]); o0.w = pk2(r[6], r[7]); o1.x = pk2(r[8], r[9]); o1.y = pk2(r[10], r[11]); o1.z = pk2(r[12], r[13]); o1.w = pk2(r[14], r[15]);
        bf16_t* dst = yo + (size_t)(b * SEQ + c * 128 + t) * 256 + gq * 64 + g4 * 16;
        *(uint4*)dst = o0; *(uint4*)(dst + 8) = o1;
    }
}

constexpr int SC_T = 32, SC_ROW = 352;
struct ScanRaw { unsigned zr[10], zk[10], zv[10], ar[8], lr[8]; };
__device__ __forceinline__ void scan_load_raw(ScanRaw& R, const bf16_t* zb, const unsigned short* ab, const unsigned short* lb, int tlo, int h, int hf, int d, int lane) {
#pragma unroll
    for (int r = 0; r < 10; ++r) {
        int tok = tlo - 1 + r; tok = tok < 0 ? 0 : (tok > SEQ - 1 ? SEQ - 1 : tok);
        const bf16_t* zp = zb + (size_t)tok * 2816 + h * 64;
        R.zr[r] = zp[lane]; R.zk[r] = zp[384 + lane]; R.zv[r] = zp[768 + hf * 32 + (lane & 31)];
    }
#pragma unroll
    for (int i = 0; i < 8; ++i) { const size_t o = (size_t)(tlo + i) * 768 + d * 384 + h * 64 + lane; R.ar[i] = ab[o]; R.lr[i] = lb[o]; }
}
__device__ __forceinline__ float f16bits2f(unsigned u) { union { unsigned short s; f16_t h; } c; c.s = (unsigned short)u; return (float)c.h; }
__device__ __forceinline__ void rwkv_scan_item(const Ctx& p, int l, int item, LAS unsigned char* lds) {
    const int chain = item >> 1, hf = item & 1, d = chain & 1, h = (chain >> 1) % 6, b = chain / 12;
    const int tid = TIDX, wid = __builtin_amdgcn_readfirstlane(tid >> 6), lane = tid & 63;
    LAS float* buf = (LAS float*)lds;
    const bf16_t* zb = (const bf16_t*)(PWS + WS_BIG) + (size_t)b * SEQ * 2816;
    __syncthreads();
    if (wid < 4) {
        const int j = lane & 15, rg = lane >> 4, row0 = hf * 32 + wid * 8 + rg * 2;
        bf16_t* yy = (bf16_t*)(PWS + WS_YY) + ((size_t)d * MTOK + (size_t)b * SEQ) * 384 + h * 64 + row0;
        f32x4 S0 = {0.f, 0.f, 0.f, 0.f}, S1 = {0.f, 0.f, 0.f, 0.f}; float ys0 = 0.f, ys1 = 0.f;
        for (int c = 0; c < SEQ / SC_T; ++c) {
            __syncthreads();
            const LAS float* bb = buf + (c & 1) * SC_T * SC_ROW + 4 * j;
            const LAS float* vb = buf + (c & 1) * SC_T * SC_ROW + 320 + wid * 8 + rg * 2;
#pragma unroll 4
            for (int s = 0; s < SC_T; ++s) {
                const LAS float* st = bb + s * SC_ROW;
                const f32x4 w = *(const LAS f32x4*)(st), kn = *(const LAS f32x4*)(st + 64), ka = *(const LAS f32x4*)(st + 128), kd = *(const LAS f32x4*)(st + 192), rr = *(const LAS f32x4*)(st + 256);
                const float v0 = vb[s * SC_ROW], v1 = vb[s * SC_ROW + 1];
                float sa0 = S0[0] * kn[0] + S0[1] * kn[1] + S0[2] * kn[2] + S0[3] * kn[3];
                float sa1 = S1[0] * kn[0] + S1[1] * kn[1] + S1[2] * kn[2] + S1[3] * kn[3];
                sa0 = row16_sum(sa0); sa1 = row16_sum(sa1);
                S0 = S0 * w + sa0 * ka + v0 * kd;
                S1 = S1 * w + sa1 * ka + v1 * kd;
                float y0 = S0[0] * rr[0] + S0[1] * rr[1] + S0[2] * rr[2] + S0[3] * rr[3];
                float y1 = S1[0] * rr[0] + S1[1] * rr[1] + S1[2] * rr[2] + S1[3] * rr[3];
                y0 = row16_sum(y0); y1 = row16_sum(y1);
                if (j == (s & 15)) { ys0 = y0; ys1 = y1; }
                if ((s & 15) == 15) {
                    const int sa = c * SC_T + (s & ~15) + j, t = d ? SEQ - 1 - sa : sa;
                    *(unsigned*)(yy + (size_t)t * 384) = pk2(ys0, ys1);
                }
            }
        }
    } else {
        const int lw = wid - 4;
        const unsigned short* ab = (const unsigned short*)(PWS + WS_AA) + (size_t)b * SEQ * 768;
        const unsigned short* lb = (const unsigned short*)(PWS + WS_LAM) + (size_t)b * SEQ * 768;
        float* cb = (float*)(PWS + WS_CB);
        const float* mup = PIN(8) + l * 1408; const float* mun = PIN(9) + l * 1408;
        const int cr = h * 64 + lane, cv = 768 + h * 64 + hf * 32 + (lane & 31);
        const float mpr = mup[cr], mnr = mun[cr], mpk = mup[384 + cr], mnk = mun[384 + cr], mpv = mup[cv], mnv = mun[cv];
        const float kkc = PIN(15)[l * 384 + cr], kac = PIN(16)[l * 384 + cr], rkc = PIN(17)[l * 384 + cr];
        ScanRaw Rc, Rn;
        auto tlo_of = [&](int c) { const int s0 = c * SC_T + lw * 8; return d ? SEQ - 1 - (s0 + 7) : s0; };
        auto process = [&](const ScanRaw& R, int c) {
            const int tlo = tlo_of(c);
            LAS float* nb = buf + (c & 1) * SC_T * SC_ROW;
            float fr_[10], fk_[10], fv_[10];
#pragma unroll
            for (int r = 0; r < 10; ++r) { const int tok = tlo - 1 + r; const float ok = (tok >= 0 && tok < SEQ) ? 1.f : 0.f;
                fr_[r] = ok * bf2f((unsigned short)R.zr[r]); fk_[r] = ok * bf2f((unsigned short)R.zk[r]); fv_[r] = ok * bf2f((unsigned short)R.zv[r]); }
#pragma unroll
            for (int i = 0; i < 8; ++i) {
                const float r = fr_[i + 1] + mpr * (fr_[i] - fr_[i + 1]) + mnr * (fr_[i + 2] - fr_[i + 1]);
                const float k = fk_[i + 1] + mpk * (fk_[i] - fk_[i + 1]) + mnk * (fk_[i + 2] - fk_[i + 1]);
                const float v = fv_[i + 1] + mpv * (fv_[i] - fv_[i + 1]) + mnv * (fv_[i + 2] - fv_[i + 1]);
                const float a = f16bits2f(R.ar[i]), lamv = f16bits2f(R.lr[i]);
                const float w = __expf(-lamv);
                const float kk = k * kkc; const float ss = wave_sum(kk * kk, lane); const float kh = kk * rsqrtf(ss + 1e-12f);
                const float kd = k * (1.f + (a - 1.f) * kac);
                const float cbv = wave_sum(r * kd * rkc, lane);
                const int slot = lw * 8 + (d ? 7 - i : i);
                LAS float* st = nb + slot * SC_ROW;
                st[lane] = w; st[64 + lane] = -kh; st[128 + lane] = kh * a; st[192 + lane] = kd; st[256 + lane] = r; if (lane < 32) st[320 + lane] = v;
                if (hf == 0 && lane == 0) cb[((size_t)(b * SEQ + tlo + i) * 2 + d) * 6 + h] = cbv;
            }
        };
        scan_load_raw(Rc, zb, ab, lb, tlo_of(0), h, hf, d, lane);
        scan_load_raw(Rn, zb, ab, lb, tlo_of(1), h, hf, d, lane);
        process(Rc, 0);
        for (int c = 0; c < SEQ / SC_T; ++c) {
            __syncthreads();
            if (c + 1 < SEQ / SC_T) {
                Rc = Rn;
                if (c + 2 < SEQ / SC_T) scan_load_raw(Rn, zb, ab, lb, tlo_of(c + 2), h, hf, d, lane);
                process(Rc, c + 1);
            }
        }
    }
}

__device__ __forceinline__ void rwkv_post_phase(const Ctx& p, int l) {
    const bf16_t* z = (const bf16_t*)(PWS + WS_BIG); const bf16_t* yy = (const bf16_t*)(PWS + WS_YY);
    const unsigned short* gg = (const unsigned short*)(PWS + WS_GG); const float* cb = (const float*)(PWS + WS_CB);
    bf16_t* O = (bf16_t*)(PWS + WS_XN);
    const float* mup = PIN(8) + l * 1408 + 768; const float* mun = PIN(9) + l * 1408 + 768;
    const float* lw_ = PIN(18) + l * 384; const float* lb_ = PIN(19) + l * 384;
    const int lane = TIDX & 63, gw = BIDX * 8 + (TIDX >> 6), nw = GDIM * 8;
    for (int it = gw; it < MTOK * 6; it += nw) {
        const int tok = it / 6, h = it - tok * 6, t = tok & (SEQ - 1), col = h * 64 + lane;
        const float y = bf2f(yy[(size_t)tok * 384 + col]) + bf2f(yy[((size_t)MTOK + tok) * 384 + col]);
        const float mean = wave_sum(y, lane) * (1.f / 64.f); const float dv = y - mean; const float var = wave_sum(dv * dv, lane) * (1.f / 64.f);
        const float yn = dv * rsqrtf(var + 64e-5f);
        const bf16_t* zc = z + (size_t)tok * 2816 + 768 + col;
        const float vc = bf2f(zc[0]), vp = (t > 0) ? bf2f(zc[-2816]) : 0.f, vn = (t < SEQ - 1) ? bf2f(zc[2816]) : 0.f;
        const float v = vc + mup[col] * (vp - vc) + mun[col] * (vn - vc);
        const float bon = (cb[((size_t)tok * 2 + 0) * 6 + h] + cb[((size_t)tok * 2 + 1) * 6 + h]) * v;
        const float o = (yn * lw_[col] + lb_[col] + bon) * f16bits2f(gg[(size_t)tok * 384 + col]);
        const unsigned ob = pk2(o, 0.f);
        O[(size_t)tok * 1024 + col] = (bf16_t)(ob & 0xffffu);
    }
}

__device__ __forceinline__ void attn_item(const Ctx& p, int item, LAS unsigned char* lds) {
    const int sp = item & 7, h = (item >> 3) % 6, b = item / 48;
    const int tid = TIDX, wid = tid >> 6, lane = tid & 63, sl = wid >> 2, wq = wid & 3;
    LAS bf16_t* Ks = (LAS bf16_t*)lds;
    LAS bf16_t* Vt = Ks + 2 * 192 * 80;
    const bf16_t* zb = (const bf16_t*)(PWS + WS_BIG) + (size_t)b * SEQ * 2816;
    bf16_t* O = (bf16_t*)(PWS + WS_XN); float* lsebuf = (float*)(PWS + WS_LSE);
    const float slope = (h == 0) ? 0.25f : (h == 1) ? 0.0625f : (h == 2) ? 0.015625f : (h == 3) ? 0.00390625f : (h == 4) ? 0.5f : 0.125f;
    for (int pi = 0; pi < 3; ++pi) {
        const int dsh = 2 * pi, dm1 = (1 << dsh) - 1, n = SEQ >> dsh;
        for (int rnd = 0; rnd < 8; ++rnd) {
            __syncthreads();
            {
                int tt = tid & 255; LAUNDER(tt);
                const int s = tid >> 8, uidx = rnd * 2 + s, r = uidx & dm1, lb = uidx >> dsh, i = sp * (16 >> dsh) + lb, jbase = 64 * (i - 1);
#pragma unroll
                for (int it = 0; it < 6; ++it) {
                    const int cid = tt + 256 * it, row = cid >> 3, part = cid & 7, jj = jbase + row; const bool ok = (jj >= 0 && jj < n);
                    u32x4 v = {0u, 0u, 0u, 0u};
                    if (ok) v = *(const u32x4*)(zb + (size_t)(r + (jj << dsh)) * 2816 + 1792 + h * 64 + part * 8);
                    *(LAS u32x4*)(Ks + (s * 192 + row) * 80 + part * 8) = v;
                }
#pragma unroll
                for (int it = 0; it < 6; ++it) {
                    const int cid = tt + 256 * it, row = cid % 192, part = cid / 192, jj = jbase + row; const bool ok = (jj >= 0 && jj < n);
                    union { uint4 u; unsigned short e[8]; } v; v.u = make_uint4(0u, 0u, 0u, 0u);
                    if (ok) v.u = *(const uint4*)(zb + (size_t)(r + (jj << dsh)) * 2816 + 2176 + h * 64 + part * 8);
#pragma unroll
                    for (int e = 0; e < 8; ++e) Vt[(s * 64 + part * 8 + e) * 200 + row] = v.e[e];
                }
            }
            __syncthreads();
            {
                const int uidx = rnd * 2 + sl, r = uidx & dm1, lb = uidx >> dsh, i = sp * (16 >> dsh) + lb;
                int fr = lane & 15, fq = lane >> 4; LAUNDER(fr); LAUNDER(fq);
                const int qi = wq * 16 + fr, posq = r + ((64 * i + qi) << dsh); const size_t tokq = (size_t)b * SEQ + posq;
                bf16x8 qf[2];
#pragma unroll
                for (int ks = 0; ks < 2; ++ks) qf[ks] = *(const bf16x8*)(zb + (size_t)posq * 2816 + 1408 + h * 64 + ks * 32 + fq * 8);
                f32x4 sacc[12];
#pragma unroll
                for (int kt = 0; kt < 12; ++kt) { f32x4 acc = {0.f, 0.f, 0.f, 0.f};
#pragma unroll
                    for (int ks = 0; ks < 2; ++ks) { const bf16x8 kf = *(const LAS bf16x8*)(Ks + (sl * 192 + kt * 16 + fr) * 80 + ks * 32 + fq * 8); acc = mfma16(kf, qf[ks], acc); }
                    sacc[kt] = acc; }
                float mx = -1e30f;
#pragma unroll
                for (int kt = 0; kt < 12; ++kt)
#pragma unroll
                    for (int jj = 0; jj < 4; ++jj) { const int kap = kt * 16 + fq * 4 + jj, rel = kap - 64 - qi, arel = rel < 0 ? -rel : rel, jk = 64 * (i - 1) + kap;
                        const bool ok = (arel <= 64) && (jk >= 0) && (jk < n);
                        const float lg = ok ? sacc[kt][jj] * 0.125f - slope * (float)(arel << dsh) : -1e30f; sacc[kt][jj] = lg; mx = fmaxf(mx, lg); }
                mx = fmaxf(mx, shx(mx, 16, lane)); mx = fmaxf(mx, shx(mx, 32, lane));
                float lsum = 0.f;
#pragma unroll
                for (int kt = 0; kt < 12; ++kt)
#pragma unroll
                    for (int jj = 0; jj < 4; ++jj) { const float pv = __expf(sacc[kt][jj] - mx); sacc[kt][jj] = pv; lsum += pv; }
                lsum += shx(lsum, 16, lane); lsum += shx(lsum, 32, lane);
                f32x4 oacc[4];
#pragma unroll
                for (int dt = 0; dt < 4; ++dt) oacc[dt] = (f32x4){0.f, 0.f, 0.f, 0.f};
#pragma unroll
                for (int kk = 0; kk < 6; ++kk) {
                    union { uint4 u; bf16x8 v; } pf; pf.u.x = pk2(sacc[2 * kk][0], sacc[2 * kk][1]); pf.u.y = pk2(sacc[2 * kk][2], sacc[2 * kk][3]); pf.u.z = pk2(sacc[2 * kk + 1][0], sacc[2 * kk + 1][1]); pf.u.w = pk2(sacc[2 * kk + 1][2], sacc[2 * kk + 1][3]);
#pragma unroll
                    for (int dt = 0; dt < 4; ++dt) {
                        const LAS bf16_t* vp = Vt + (sl * 64 + dt * 16 + fr) * 200 + kk * 32 + fq * 4;
                        union { u32x2 h[2]; bf16x8 v; } vf; vf.h[0] = *(const LAS u32x2*)vp; vf.h[1] = *(const LAS u32x2*)(vp + 16);
                        oacc[dt] = mfma16(vf.v, pf.v, oacc[dt]);
                    }
                }
                const float inv = __builtin_amdgcn_rcpf(lsum); float lse = mx + __logf(lsum);
                bf16_t* op = O + tokq * 1024 + 384 + h * 64 + fq * 4; float* lp = lsebuf + tokq * 6 + h;
                float wn = inv, wp = 0.f;
                if (pi > 0) { const float lprev = *lp; const float L = fmaxf(lprev, lse); const float ep = __expf(lprev - L), en = __expf(lse - L); const float den = __builtin_amdgcn_rcpf(ep + en);
                    wp = ep * den; wn = en * den * inv; lse = L + __logf(ep + en); }
#pragma unroll
                for (int dt = 0; dt < 4; ++dt) {
                    float o0 = oacc[dt][0] * wn, o1 = oacc[dt][1] * wn, o2 = oacc[dt][2] * wn, o3 = oacc[dt][3] * wn;
                    if (pi > 0) { const uint2 pv = *(const uint2*)(op + dt * 16); o0 += wp * __uint_as_float(pv.x << 16); o1 += wp * __uint_as_float(pv.x & 0xffff0000u); o2 += wp * __uint_as_float(pv.y << 16); o3 += wp * __uint_as_float(pv.y & 0xffff0000u); }
                    uint2 ov; ov.x = pk2(o0, o1); ov.y = pk2(o2, o3); *(uint2*)(op + dt * 16) = ov;
                }
                if (fq == 0) *lp = lse;
            }
        }
    }
}

__device__ __forceinline__ void zero_cols(const Ctx& p, bf16_t* O, int c0, int ncols) {
    const int per = ncols >> 3; const size_t total = (size_t)MTOK * per;
    for (size_t i = (size_t)BIDX * 512 + TIDX; i < total; i += (size_t)GDIM * 512) { const size_t row = i / per; const int pc = (int)(i % per); *(uint4*)(O + row * 1024 + c0 + pc * 8) = make_uint4(0u, 0u, 0u, 0u); }
}
__device__ __forceinline__ void mixer_phase(const Ctx& p, int l, LAS unsigned char* lds) {
    unsigned* ctr = (unsigned*)(PWS + WS_CTR) + l;
    LAS int* sitem = (LAS int*)(lds + 131072);
    for (;;) {
        __syncthreads();
        if (TIDX == 0) *sitem = (int)atomicAdd(ctr, 1u);
        __syncthreads();
        const int item = __builtin_amdgcn_readfirstlane(*sitem);
        if (item >= 192 + 384 + 2048) break;
        if (item < 192) {
#if EN_RWKV
            rwkv_scan_item(p, l, item, lds);
#endif
        } else if (item < 576) {
#if EN_ATTN
            attn_item(p, item - 192, lds);
#endif
        } else {
#if EN_S5
            s5_passC_item(p, l, item - 576, lds);
#endif
        }
    }
}
constexpr int NPH = 25;
__device__ __forceinline__ void run_phase(const Ctx& p, int ph, LAS unsigned char* lds) {
    bf16_t* XN = (bf16_t*)(PWS + WS_XN); bf16_t* BIG = (bf16_t*)(PWS + WS_BIG);
    if (ph == 0) {
        weights_phase(p);
        if (BIDX == 0 && TIDX < 64) ((unsigned*)(PWS + WS_CTR))[TIDX] = 0u;
        norm_phase(p, PIN(0), PIN(1), XN, nullptr);
        return;
    }
    const int l = (ph - 1) / 12, k = (ph - 1) % 12;
    const unsigned char* wl = PWS + WS_WB + (size_t)l * WL_SIZE;
    switch (k) {
    case 0: case 9: {
#if EN_FFN
        EpiSwiGLU E; E.wv = p.wv; E.O = BIG; gemm_run(p, lds, XN, (const bf16_t*)(wl + (k == 0 ? WL_GU1 : WL_GU2)), 5632, 1024, E);
#endif
    } break;
    case 1: case 10: {
        const float* hin = (l == 0 && k == 1) ? PIN(0) : POUT;
#if EN_FFN
        EpiResid E; E.wv = p.wv; E.hin = hin; E.hout = POUT; E.alpha = 0.5f; gemm_run(p, lds, BIG, (const bf16_t*)(wl + (k == 1 ? WL_D1 : WL_D2)), 1024, 2816, E);
#else
        if (l == 0 && k == 1) { for (size_t i = (size_t)BIDX * 512 + TIDX; i < (size_t)MTOK * 256; i += (size_t)GDIM * 512) ((float4*)POUT)[i] = ((const float4*)hin)[i]; }
#endif
    } break;
    case 2: norm_phase(p, POUT, PIN(5) + l * 1024, XN, nullptr); break;
    case 3: { EpiZ E; E.wv = p.wv; E.O = BIG; gemm_run(p, lds, XN, (const bf16_t*)(wl + WL_IN), 2816, 1024, E); } break;
    case 4: {
#if EN_RWKV
        rwkv_prep_phase(p, l);
#endif
#if EN_S5
        for (int item = BIDX; item < 2048; item += GDIM) s5_passA_item(p, l, item, lds);
#endif
    } break;
    case 5: mixer_phase(p, l, lds); break;
    case 6: {
#if EN_S5
        { EpiGLU E; E.wv = p.wv; E.O = XN; E.bias = PIN(29) + l * 512; gemm_run(p, lds, (const bf16_t*)(PWS + WS_YPRE), (const bf16_t*)(wl + WL_GLU), 512, 256, E); }
#else
        zero_cols(p, XN, 768, 256);
#endif
#if EN_RWKV
        rwkv_post_phase(p, l);
#else
        zero_cols(p, XN, 0, 384);
#endif
#if !EN_ATTN
        zero_cols(p, XN, 384, 384);
#endif
    } break;
    case 7: { EpiResid E; E.wv = p.wv; E.hin = POUT; E.hout = POUT; E.alpha = 1.0f; gemm_run(p, lds, XN, (const bf16_t*)(wl + WL_OUT), 1024, 1024, E); } break;
    case 8: norm_phase(p, POUT, PIN(30) + l * 1024, XN, nullptr); break;
    case 11: if (l == 0) norm_phase(p, POUT, PIN(1) + 1024, XN, nullptr); else norm_phase(p, POUT, PIN(34), nullptr, POUT); break;
    }
}

__global__ void __launch_bounds__(512, 2) mega(Params kp, int ph_lo, int ph_hi) {
    extern __shared__ __attribute__((aligned(16))) unsigned char shm[];
    LAS unsigned char* lds = (LAS unsigned char*)shm;
    cg::grid_group grid = cg::this_grid();
    LAS unsigned long long* tab = (LAS unsigned long long*)(lds + 131072 + 64);
    if (threadIdx.x == 0) {
#pragma unroll
        for (int i = 0; i < 35; ++i) tab[i] = (unsigned long long)kp.in[i];
        tab[35] = (unsigned long long)kp.out; tab[36] = (unsigned long long)kp.ws;
    }
    __syncthreads();
    Ctx p; p.tab = tab; p.wv = __builtin_amdgcn_readfirstlane((int)(threadIdx.x >> 6));
    for (int ph = ph_lo; ph < ph_hi; ++ph) {
        run_phase(p, ph, lds);
        if (ph + 1 < ph_hi) grid.sync();
    }
}

#ifndef SPLIT_LAUNCH
#define SPLIT_LAUNCH 0
#endif
extern "C" void kernel_launch(void* const* d_in, const int* in_sizes, int n_in, void* d_out, int out_size, void* d_ws, size_t ws_size, hipStream_t stream) {
    static int grid = 0;
    if (grid == 0) {
        if (n_in != 35 || out_size != MTOK * 1024 || ws_size < WS_END) { fprintf(stderr, "kernel_launch: unexpected shapes (n_in %d out %d ws %zu need %zu)\n", n_in, out_size, ws_size, (size_t)WS_END); grid = -1; return; }
        int dev = 0, cus = 0, per_cu = 0;
        if (hipGetDevice(&dev) != hipSuccess || hipDeviceGetAttribute(&cus, hipDeviceAttributeMultiprocessorCount, dev) != hipSuccess) { grid = -1; return; }
        if (hipFuncSetAttribute((const void*)mega, hipFuncAttributeMaxDynamicSharedMemorySize, LDS_BYTES) != hipSuccess) { fprintf(stderr, "kernel_launch: hipFuncSetAttribute failed\n"); grid = -1; return; }
        if (hipOccupancyMaxActiveBlocksPerMultiprocessor(&per_cu, (const void*)mega, 512, LDS_BYTES) != hipSuccess || per_cu < 1) { fprintf(stderr, "kernel_launch: occupancy query says %d\n", per_cu); per_cu = 1; }
        (void)hipGetLastError();
        grid = cus;
    }
    if (grid < 0) return;
    Params p{};
    for (int i = 0; i < 35; ++i) p.in[i] = (const float*)d_in[i];
    p.out = (float*)d_out; p.ws = (unsigned char*)d_ws;
#if SPLIT_LAUNCH
    for (int ph = 0; ph < NPH; ++ph) { int lo = ph, hi = ph + 1; void* args[] = {&p, &lo, &hi};
        hipError_t e = hipLaunchCooperativeKernel((const void*)mega, dim3(grid), dim3(512), args, LDS_BYTES, stream);
        if (e != hipSuccess) { fprintf(stderr, "launch failed: %s\n", hipGetErrorString(e)); return; } }
#else
    int lo = 0, hi = NPH; void* args[] = {&p, &lo, &hi};
    hipError_t e = hipLaunchCooperativeKernel((const void*)mega, dim3(grid), dim3(512), args, LDS_BYTES, stream);
    if (e != hipSuccess) fprintf(stderr, "cooperative launch failed: %s (grid %d)\n", hipGetErrorString(e), grid);
#endif
}
```

```cpp
#include <hip/hip_cooperative_groups.h>
#include <cstdio>
#include <hip/hip_runtime.h>
__device__ __forceinline__ int tid_from(int wv) { unsigned m = ~0u; asm volatile("" : "+s"(m), "+s"(wv)); return wv * 64 + (int)__builtin_amdgcn_mbcnt_hi(m, __builtin_amdgcn_mbcnt_lo(m, 0u)); }
#define TIDX (tid_from(p.wv))
__device__ __forceinline__ int bid_() { int b = blockIdx.x; asm volatile("" : "+s"(b)); return b; }
__device__ __forceinline__ int gdim_() { int b = gridDim.x; asm volatile("" : "+s"(b)); return b; }
#define BIDX (bid_())
#define GDIM (gdim_())
#define CG_ONLY 1
#define WT_STORES 1
#include <hip/hip_runtime.h>
namespace pg8 {
#define PG8_LAS __attribute__((address_space(3)))
typedef unsigned short bf16_t;
typedef short bf16x8 __attribute__((ext_vector_type(8)));
typedef float f32x4 __attribute__((ext_vector_type(4)));
typedef unsigned u32x4 __attribute__((ext_vector_type(4)));
constexpr int BM = 256, BK = 64, HALF = 128, HTB = HALF * BK * 2  , STAGE_BYTES = 8 * HTB, NXCD = 8, WGM = 8;

__host__ __device__ __forceinline__ int lds_byte(int r, int c) { const int st = (r >> 4) * 2 + (c >> 5), rr = r & 15, cc = c & 31, ob = rr * 64 + cc * 2; return st * 1024 + (ob ^ (((ob >> 9) & 1) << 5)); }
__host__ __device__ __forceinline__ void stage_rc(int b, int& R, int& C) { const int st = b / 1024, sb = b % 1024, swz = sb ^ (((sb >> 9) & 1) << 5); R = (st >> 1) * 16 + swz / 64; C = (st & 1) * 32 + (swz % 64) / 2; }
__host__ __device__ __forceinline__ int perm32(int rho) { const int n = rho >> 4, i = rho & 15; return 8 * (i >> 2) + 4 * n + (i & 3); }

struct Unit { int pm, pn; };
struct Gemm { const bf16_t* A; const bf16_t* Bt; int M, N, K; };

struct StaticOrder {
    int nM, nN, nwg, G, c;
    __host__ __device__ void init(int M, int N, int G_, int c_) { nM = M / BM; nN = N / BM; nwg = nM * nN; G = G_; c = c_; }
    __host__ __device__ bool next(int i, Unit& u) const {
        const long L = (long)i * G + c; if (L >= nwg) return false;
        int wgid = (int)L; { const int q = nwg / NXCD, r = nwg % NXCD, xcd = wgid % NXCD, off = wgid / NXCD; wgid = (xcd < r ? xcd * (q + 1) : r * (q + 1) + (xcd - r) * q) + off; }
        const int nig = WGM * nN, gid = wgid / nig, fm = gid * WGM, gsz = (nM - fm) < WGM ? (nM - fm) : WGM;
        u.pm = fm + ((wgid % nig) % gsz); u.pn = (wgid % nig) / gsz; return true;
    }
    __device__ __forceinline__ void a_ready(const Unit&) const {}
    __device__ __forceinline__ void done(const Unit&) const {}
};
__device__ __forceinline__ unsigned cvt_pk_bf16(float lo, float hi) { unsigned r; asm volatile("v_cvt_pk_bf16_f32 %0, %1, %2" : "=v"(r) : "v"(lo), "v"(hi)); return r; }
template <class Epi, class Sched, bool STAMP = false>
__device__ __forceinline__ void gemm_phase(PG8_LAS unsigned char* lds, const Gemm g, const Sched& S, const Epi& E, unsigned long long* stamps, const int tid_in) {
    const int tid = tid_in, wid = __builtin_amdgcn_readfirstlane(tid >> 6), lane = tid & 63, wr = wid >> 2, wc = wid & 3, fr = lane & 15, fq = lane >> 4;
    const int K = g.K, nt = K / BK;
    int ts_lo = 0, ts_hi = 0, nts = 0; const unsigned long long rt_entry = STAMP ? (unsigned long long)wall_clock64() : 0ull;
#define PG8_STAMP() do { if (STAMP && wid == 0 && nts < 64) { const unsigned long long _c = (unsigned long long)clock64(); \
        ts_lo = (lane == nts) ? (int)(unsigned)_c : ts_lo; ts_hi = (lane == nts) ? (int)(unsigned)(_c >> 32) : ts_hi; ++nts; } } while (0)
    PG8_STAMP();
    unsigned voffA[2], voffB[2];
#pragma unroll
    for (int i = 0; i < 2; ++i) { int R, C; stage_rc(tid * 16 + i * 8192, R, C); const int Rb = Epi::PERM ? ((R & ~31) + perm32(R & 31)) : R;
        voffA[i] = (unsigned)(R * K + C) * 2u; voffB[i] = (unsigned)(Rb * K + C) * 2u; }
    const size_t kstep = (size_t)(BK * 2);
    const size_t hstep = (size_t)HALF * K * 2;
    const size_t tstep = 2 * hstep;
    const unsigned ldsw = (unsigned)wid * 1024u;
    const int aoff = lds_byte(wr * 64 + fr, fq * 8), boff = lds_byte(wc * 32 + fr, fq * 8);
#define PG8_SA(b, h) (((b) * 2 + (h)) * HTB)
#define PG8_SB(b, h) ((4 + (b) * 2 + (h)) * HTB)
#define PG8_STAGE(bufoff, gbase, voff) do { _Pragma("unroll") for (int _i = 0; _i < 2; ++_i) \
        __builtin_amdgcn_global_load_lds((const unsigned*)((const char*)(gbase) + (voff)[_i]), (PG8_LAS unsigned*)(lds + (bufoff) + ldsw + _i * 8192), 16, 0, 0); } while (0)
#define PG8_LDA(dst, b, h) do { _Pragma("unroll") for (int m = 0; m < 4; ++m) _Pragma("unroll") for (int k = 0; k < 2; ++k) dst[m][k] = *(const PG8_LAS bf16x8*)(lds + PG8_SA(b, h) + aoff + m * 2048 + k * 1024); } while (0)
#define PG8_LDB(dst, b, h) do { _Pragma("unroll") for (int n = 0; n < 2; ++n) _Pragma("unroll") for (int k = 0; k < 2; ++k) dst[n][k] = *(const PG8_LAS bf16x8*)(lds + PG8_SB(b, h) + boff + n * 2048 + k * 1024); } while (0)
#define PG8_MMA(ai, bj, At, Bt) do { __builtin_amdgcn_s_setprio(1); _Pragma("unroll") for (int m = 0; m < 4; ++m) _Pragma("unroll") for (int n = 0; n < 2; ++n) _Pragma("unroll") for (int k = 0; k < 2; ++k) \
        acc[ai][bj][m][n] = __builtin_amdgcn_mfma_f32_16x16x32_bf16(Bt[n][k], At[m][k], acc[ai][bj][m][n], 0, 0, 0); __builtin_amdgcn_s_setprio(0); } while (0)
#define PG8_WAIT_V(n) asm volatile("s_waitcnt vmcnt(" #n ")" ::: "memory")
#define PG8_WAIT_L(n) asm volatile("s_waitcnt lgkmcnt(" #n ")" ::: "memory")
#define PG8_BAR __builtin_amdgcn_s_barrier()
#define PG8_SCHED __builtin_amdgcn_sched_barrier(0)
    Unit cur, nxt; int ui = 0;
    if (!S.next(0, cur)) return;
    f32x4 acc[2][2][4][2];
#pragma unroll
    for (int a = 0; a < 2; ++a)
#pragma unroll
        for (int b = 0; b < 2; ++b)
#pragma unroll
            for (int m = 0; m < 4; ++m)
#pragma unroll
                for (int n = 0; n < 2; ++n) acc[a][b][m][n] = (f32x4){0.f, 0.f, 0.f, 0.f};
    bf16x8 At[4][2], B0[2][2], B1[2][2];
    const char* cA = (const char*)g.A + (size_t)cur.pm * tstep; const char* cB = (const char*)g.Bt + (size_t)cur.pn * tstep;
    S.a_ready(cur);
    PG8_STAGE(PG8_SB(0, 0), cB, voffB); PG8_STAGE(PG8_SA(0, 0), cA, voffA); PG8_STAGE(PG8_SB(0, 1), cB + hstep, voffB); PG8_STAGE(PG8_SA(0, 1), cA + hstep, voffA);
    if (wr == 1) PG8_BAR;
    PG8_WAIT_V(4); PG8_BAR;
    PG8_STAGE(PG8_SB(1, 0), cB + kstep, voffB); PG8_STAGE(PG8_SA(1, 0), cA + kstep, voffA); PG8_STAGE(PG8_SB(1, 1), cB + hstep + kstep, voffB);
    PG8_WAIT_V(6); PG8_BAR;
    PG8_STAMP();
    for (;;) {
        const bool has_next = S.next(ui + 1, nxt);
        const char* nA = has_next ? (const char*)g.A + (size_t)nxt.pm * tstep : cA; const char* nB = has_next ? (const char*)g.Bt + (size_t)nxt.pn * tstep : cB;
        for (int t = 0; t < nt; t += 2) {
            const bool last = (t == nt - 2);
            const char* a1 = cA + (size_t)(t + 1) * kstep;
            const char* a2 = last ? nA : cA + (size_t)(t + 2) * kstep; const char* b2 = last ? nB : cB + (size_t)(t + 2) * kstep;
            const char* a3 = a2 + kstep; const char* b3 = b2 + kstep;
            if (last && has_next) S.a_ready(nxt);
            PG8_LDB(B0, 0, 0); PG8_SCHED; PG8_LDA(At, 0, 0); PG8_STAGE(PG8_SA(1, 1), a1 + hstep, voffA);
            PG8_WAIT_L(8); PG8_BAR; PG8_WAIT_L(0); PG8_MMA(0, 0, At, B0); PG8_BAR; PG8_SCHED;
            PG8_LDB(B1, 0, 1); PG8_STAGE(PG8_SB(0, 0), b2, voffB);
            PG8_BAR; PG8_WAIT_L(0); PG8_MMA(0, 1, At, B1); PG8_BAR;
            PG8_LDA(At, 0, 1); PG8_STAGE(PG8_SA(0, 0), a2, voffA);
            PG8_BAR; PG8_WAIT_L(0); PG8_MMA(1, 0, At, B0); PG8_BAR; PG8_SCHED;
            PG8_STAGE(PG8_SB(0, 1), b2 + hstep, voffB);
            PG8_WAIT_V(6); PG8_BAR; PG8_MMA(1, 1, At, B1); PG8_BAR;
            PG8_LDB(B0, 1, 0); PG8_SCHED; PG8_LDA(At, 1, 0); PG8_STAGE(PG8_SA(0, 1), a2 + hstep, voffA);
            PG8_WAIT_L(8); PG8_BAR; PG8_WAIT_L(0); PG8_MMA(0, 0, At, B0); PG8_BAR; PG8_SCHED;
            PG8_LDB(B1, 1, 1); PG8_STAGE(PG8_SB(1, 0), b3, voffB);
            PG8_BAR; PG8_WAIT_L(0); PG8_MMA(0, 1, At, B1); PG8_BAR;
            PG8_LDA(At, 1, 1); PG8_STAGE(PG8_SA(1, 0), a3, voffA);
            PG8_BAR; PG8_WAIT_L(0); PG8_MMA(1, 0, At, B0); PG8_BAR; PG8_SCHED;
            PG8_STAGE(PG8_SB(1, 1), b3 + hstep, voffB);
            PG8_WAIT_V(6); PG8_BAR; PG8_MMA(1, 1, At, B1); PG8_BAR;
        }
        PG8_STAMP();
        if constexpr (!Epi::AFTER_DRAIN) { E(acc, cur, wr, wc, fr, fq); S.done(cur); }
        PG8_STAMP();
        if (!has_next) break;
#pragma unroll
        for (int a = 0; a < 2; ++a)
#pragma unroll
            for (int b = 0; b < 2; ++b)
#pragma unroll
                for (int m = 0; m < 4; ++m)
#pragma unroll
                    for (int n = 0; n < 2; ++n) acc[a][b][m][n] = (f32x4){0.f, 0.f, 0.f, 0.f};
        cur = nxt; cA = nA; cB = nB; ++ui;
    }
    PG8_WAIT_V(0);
    if (wr == 0) PG8_BAR;
    PG8_BAR;
    if constexpr (Epi::AFTER_DRAIN) { E.fused(acc, cur, wr, wc, fr, fq, lds, wid, lane); S.done(cur); }
    PG8_STAMP();
    if (STAMP && wid == 0) { stamps[lane] = lane < nts ? (((unsigned long long)(unsigned)ts_hi << 32) | (unsigned)ts_lo) : 0ull;
        if (lane == 62) stamps[62] = rt_entry; if (lane == 63) stamps[63] = (unsigned long long)wall_clock64(); }
#undef PG8_STAMP
#undef PG8_SA
#undef PG8_SB
#undef PG8_STAGE
#undef PG8_LDA
#undef PG8_LDB
#undef PG8_MMA
#undef PG8_WAIT_V
#undef PG8_WAIT_L
#undef PG8_BAR
#undef PG8_SCHED
}
}

#include <cstdio>
#include <ctime>
#include <cstdlib>
#include <cstring>
#include <cmath>
#include <vector>
#include <algorithm>

namespace cg = cooperative_groups;
using pg8::bf16_t; using pg8::bf16x8; using pg8::f32x4;
typedef _Float16 f16_t;
typedef short bf16x4 __attribute__((ext_vector_type(4)));
typedef unsigned u32x4 __attribute__((ext_vector_type(4)));
typedef unsigned u32x2 __attribute__((ext_vector_type(2)));
#define LAS __attribute__((address_space(3)))

#ifndef EN_RWKV
#define EN_RWKV 1
#endif
#ifndef EN_ATTN
#define EN_ATTN 1
#endif
#ifndef EN_S5
#define EN_S5 1
#endif
#ifndef EN_FFN
#define EN_FFN 1
#endif

constexpr int MTOK = 65536, SEQ = 8192;
constexpr int LDS_BYTES = 131072 + 512;
constexpr size_t WL_GU1 = 0, WL_D1 = WL_GU1 + 11534336, WL_IN = WL_D1 + 5767168, WL_OUT = WL_IN + 5767168, WL_GU2 = WL_OUT + 2097152,
                 WL_D2 = WL_GU2 + 11534336, WL_GLU = WL_D2 + 5767168, WL_W2 = WL_GLU + 262144, WL_A2 = WL_W2 + 98304, WL_G2 = WL_A2 + 98304, WL_SIZE = WL_G2 + 98304;
constexpr size_t WS_WB = 0, WS_XN = WS_WB + 2 * WL_SIZE, WS_BIG = WS_XN + 134217728, WS_LAM = WS_BIG + 369098752, WS_AA = WS_LAM + 100663296,
                 WS_GG = WS_AA + 100663296, WS_YY = WS_GG + 50331648, WS_YPRE = WS_YY + 100663296, WS_LSE = WS_YPRE + 33554432, WS_CB = WS_LSE + 1572864,
                 WS_S5E = WS_CB + 3145728, WS_CTR = WS_S5E + 8388608, WS_BAR = WS_CTR + 256, WS_END = WS_BAR + 16384;

struct Params { const float* in[35]; float* out; unsigned char* ws; };
struct Ctx { LAS const unsigned long long* tab; int wv; };
template <class T> __device__ __forceinline__ T* ldsptr(LAS const unsigned long long* tab, int i) {
    unsigned a_; asm volatile("s_mov_b32 %0, 0x20040" : "=s"(a_)); a_ += (unsigned)i * 8u;
    const unsigned long long v = *(LAS const unsigned long long*)a_; const unsigned lo = __builtin_amdgcn_readfirstlane((unsigned)v), hi = __builtin_amdgcn_readfirstlane((unsigned)(v >> 32));
    unsigned long long r = ((unsigned long long)hi << 32) | lo; asm volatile("" : "+s"(r));
    return (T*)(__attribute__((address_space(1))) T*)r; }
#define PWS (ldsptr<unsigned char>(p.tab, 36))
#define POUT (ldsptr<float>(p.tab, 35))
#define PIN(i) (ldsptr<const float>(p.tab, i))

__device__ __forceinline__ float bf2f(unsigned short b) { return __uint_as_float(((unsigned)b) << 16); }
__device__ __forceinline__ unsigned pk2(float lo, float hi) { return pg8::cvt_pk_bf16(lo, hi); }
#ifdef WT_STORES
__device__ __forceinline__ void wt8(void* p, unsigned long long v) { __hip_atomic_store((unsigned long long*)p, v, __ATOMIC_RELAXED, __HIP_MEMORY_SCOPE_AGENT); }
__device__ __forceinline__ void wt4(void* p, unsigned v) { __hip_atomic_store((unsigned*)p, v, __ATOMIC_RELAXED, __HIP_MEMORY_SCOPE_AGENT); }
__device__ __forceinline__ void wt2(void* p, unsigned short v) { __hip_atomic_store((unsigned short*)p, v, __ATOMIC_RELAXED, __HIP_MEMORY_SCOPE_AGENT); }
#else
__device__ __forceinline__ void wt8(void* p, unsigned long long v) { *(unsigned long long*)p = v; }
__device__ __forceinline__ void wt4(void* p, unsigned v) { *(unsigned*)p = v; }
__device__ __forceinline__ void wt2(void* p, unsigned short v) { *(unsigned short*)p = v; }
#endif
#ifdef WT_STORES
__device__ __forceinline__ void wt16(void* p, uint4 v) {
    u32x4 d = {v.x, v.y, v.z, v.w}; __builtin_nontemporal_store(d, (u32x4*)p); }
#else
__device__ __forceinline__ void wt16(void* p, uint4 v) { *(uint4*)p = v; }
#endif
__device__ __forceinline__ void wt8u(void* p, uint2 v) { wt8(p, ((unsigned long long)v.y << 32) | v.x); }
__device__ __forceinline__ void wt16f(void* p, f32x4 v) { uint4 u; u.x = __float_as_uint(v[0]); u.y = __float_as_uint(v[1]); u.z = __float_as_uint(v[2]); u.w = __float_as_uint(v[3]); wt16(p, u); }
__device__ __forceinline__ float shx(float v, int o, int lane) { return __builtin_bit_cast(float, __builtin_amdgcn_ds_bpermute((lane ^ o) << 2, __builtin_bit_cast(int, v))); }
#define LAUNDER(x) asm volatile("" : "+v"(x))
__device__ __forceinline__ float dpp_ror_add(float x, const int ctrl_unused) { return x; }
#define DPP_ROR_ADD(x, N) ((x) + __builtin_bit_cast(float, __builtin_amdgcn_update_dpp(0, __builtin_bit_cast(int, (x)), 0x120 + (N), 0xf, 0xf, false)))
__device__ __forceinline__ float row16_sum(float x) {
    x = DPP_ROR_ADD(x, 8); x = DPP_ROR_ADD(x, 4); x = DPP_ROR_ADD(x, 2); x = DPP_ROR_ADD(x, 1); return x;
}
__device__ __forceinline__ float wave_sum(float v, int lane) {
    v = row16_sum(v); v += shx(v, 16, lane); v += shx(v, 32, lane); return v;
}
__device__ __forceinline__ float sigmoidf_(float x) { return __builtin_amdgcn_rcpf(1.f + __expf(-x)); }
__device__ __forceinline__ float tanhf_(float x) { const float e = __expf(2.f * x); return 1.f - 2.f * __builtin_amdgcn_rcpf(e + 1.f); }
__device__ __forceinline__ f32x4 mfma16(bf16x8 a, bf16x8 b, f32x4 c) { return __builtin_amdgcn_mfma_f32_16x16x32_bf16(a, b, c, 0, 0, 0); }

template <class F> __device__ __forceinline__ void prep_t(const Ctx& p, LAS unsigned char* lds, bf16_t* dst, int N, int K, F rowp) {
    LAS float* T = (LAS float*)lds;
    const int tid = TIDX, ntn = N >> 6, ntk = K >> 6, total = ntn * ntk;
    for (int t = BIDX; t < total; t += GDIM) {
        const int n0 = (t % ntn) << 6, k0 = (t / ntn) << 6;
        __syncthreads();
        { const int k = tid >> 3, c8 = (tid & 7) << 3; const float* s = rowp(n0, k0 + k) + c8;
          const f32x4 a = *(const f32x4*)s, c = *(const f32x4*)(s + 4);
#pragma unroll
          for (int e = 0; e < 4; ++e) { T[k * 65 + c8 + e] = a[e]; T[k * 65 + c8 + 4 + e] = c[e]; } }
        __syncthreads();
        { const int n = tid >> 3, k8 = (tid & 7) << 3; float v[8];
#pragma unroll
          for (int e = 0; e < 8; ++e) v[e] = T[(k8 + e) * 65 + n];
          uint4 o; o.x = pk2(v[0], v[1]); o.y = pk2(v[2], v[3]); o.z = pk2(v[4], v[5]); o.w = pk2(v[6], v[7]);
          wt16(dst + (size_t)(n0 + n) * K + k0 + k8, o); }
    }
}
__device__ __forceinline__ void weights_phase(const Ctx& p, LAS unsigned char* lds) {
    for (int l = 0; l < 2; ++l) {
        unsigned char* wl = PWS + WS_WB + (size_t)l * WL_SIZE;
        for (int f = 0; f < 2; ++f) {
            const float* wg = PIN(f ? 31 : 2) + (size_t)l * 1024 * 2816; const float* wu = PIN(f ? 32 : 3) + (size_t)l * 1024 * 2816; const float* wd = PIN(f ? 33 : 4) + (size_t)l * 2816 * 1024;
            prep_t(p, lds, (bf16_t*)(wl + (f ? WL_GU2 : WL_GU1)), 5632, 1024, [=](int n0, int k) { const int t = n0 >> 8, i = n0 & 255; return ((i < 128) ? wg + t * 128 + i : wu + t * 128 + i - 128) + (size_t)k * 2816; });
            prep_t(p, lds, (bf16_t*)(wl + (f ? WL_D2 : WL_D1)), 1024, 2816, [=](int n0, int k) { return wd + (size_t)k * 1024 + n0; });
        }
        { const float* w = PIN(6) + (size_t)l * 1024 * 2816; prep_t(p, lds, (bf16_t*)(wl + WL_IN), 2816, 1024, [=](int n0, int k) { return w + (size_t)k * 2816 + n0; }); }
        { const float* w = PIN(7) + (size_t)l * 1024 * 1024; prep_t(p, lds, (bf16_t*)(wl + WL_OUT), 1024, 1024, [=](int n0, int k) { return w + (size_t)k * 1024 + n0; }); }
        { const float* w = PIN(28) + (size_t)l * 256 * 512; prep_t(p, lds, (bf16_t*)(wl + WL_GLU), 512, 256, [=](int n0, int k) { const int t = n0 >> 8, i = n0 & 255; return w + (size_t)k * 512 + ((i < 128) ? t * 128 + i : 256 + t * 128 + i - 128); }); }
        { const float* w = PIN(11) + (size_t)l * 2 * 64 * 384; prep_t(p, lds, (bf16_t*)(wl + WL_W2), 768, 64, [=](int n0, int k) { const int d = n0 / 384, c = n0 % 384; return w + (size_t)(d * 64 + k) * 384 + c; }); }
        { const float* w = PIN(13) + (size_t)l * 2 * 64 * 384; prep_t(p, lds, (bf16_t*)(wl + WL_A2), 768, 64, [=](int n0, int k) { const int d = n0 / 384, c = n0 % 384; return w + (size_t)(d * 64 + k) * 384 + c; }); }
        { const float* w = PIN(14) + (size_t)l * 128 * 384; prep_t(p, lds, (bf16_t*)(wl + WL_G2), 384, 128, [=](int n0, int k) { return w + (size_t)k * 384 + n0; }); }
    }
}

__device__ __forceinline__ void norm_phase(const Ctx& p, const float* hin, const float* g, bf16_t* xn, float* fout) {
    const int lane = TIDX & 63, wave = BIDX * 8 + (TIDX >> 6), nw = GDIM * 8;
    float4 gv[4];
#pragma unroll
    for (int i = 0; i < 4; ++i) gv[i] = *(const float4*)(g + lane * 4 + 256 * i);
    for (int row = wave; row < MTOK; row += nw) {
        const float* pr = hin + (size_t)row * 1024;
        float4 v[4]; float ss = 0.f;
#pragma unroll
        for (int i = 0; i < 4; ++i) { v[i] = *(const float4*)(pr + lane * 4 + 256 * i); ss += v[i].x * v[i].x + v[i].y * v[i].y + v[i].z * v[i].z + v[i].w * v[i].w; }
        ss = wave_sum(ss, lane);
        const float rs = rsqrtf(ss * (1.f / 1024.f) + 1e-6f);
        if (xn) {
#pragma unroll
            for (int i = 0; i < 4; ++i) { uint2 o; o.x = pk2(v[i].x * rs * gv[i].x, v[i].y * rs * gv[i].y); o.y = pk2(v[i].z * rs * gv[i].z, v[i].w * rs * gv[i].w); wt8u(xn + (size_t)row * 1024 + lane * 4 + 256 * i, o); }
        } else {
#pragma unroll
            for (int i = 0; i < 4; ++i) { float4 o; o.x = v[i].x * rs * gv[i].x; o.y = v[i].y * rs * gv[i].y; o.z = v[i].z * rs * gv[i].z; o.w = v[i].w * rs * gv[i].w; wt16f(fout + (size_t)row * 1024 + lane * 4 + 256 * i, (f32x4){o.x, o.y, o.z, o.w}); }
        }
    }
}

struct EpiSwiGLU { int wv; static constexpr bool PERM = true, AFTER_DRAIN = false; bf16_t* O;
    __device__ __forceinline__ void operator()(const f32x4 (&acc)[2][2][4][2], const pg8::Unit& u, int wr, int wc, int fr_, int fq_) const {
        const int ln_ = tid_from(wv) & 63, fr = ln_ & 15, fq = ln_ >> 4;
        const int row0 = u.pm * 256 + wr * 64 + fr, col0 = u.pn * 128 + wc * 32 + 8 * fq;
#pragma unroll
        for (int ai = 0; ai < 2; ++ai)
#pragma unroll
            for (int m = 0; m < 4; ++m) {
                float r[8];
#pragma unroll
                for (int n = 0; n < 2; ++n)
#pragma unroll
                    for (int j = 0; j < 4; ++j) { const float g = acc[ai][0][m][n][j], uu = acc[ai][1][m][n][j]; r[n * 4 + j] = g * sigmoidf_(g) * uu; }
                uint4 o; o.x = pk2(r[0], r[1]); o.y = pk2(r[2], r[3]); o.z = pk2(r[4], r[5]); o.w = pk2(r[6], r[7]);
                wt16(O + (size_t)(row0 + ai * 128 + m * 16) * 2816 + col0, o);
            }
    }
};
struct EpiResid { int wv; static constexpr bool PERM = false, AFTER_DRAIN = false; const float* hin; float* hout; float alpha;
    __device__ __forceinline__ void operator()(const f32x4 (&acc)[2][2][4][2], const pg8::Unit& u, int wr, int wc, int fr_, int fq_) const {
        const int ln_ = tid_from(wv) & 63, fr = ln_ & 15, fq = ln_ >> 4;
        const int row0 = u.pm * 256 + wr * 64 + fr, col0 = u.pn * 256 + wc * 32 + 4 * fq;
#pragma unroll
        for (int ai = 0; ai < 2; ++ai)
#pragma unroll
            for (int m = 0; m < 4; ++m) { const size_t ro = (size_t)(row0 + ai * 128 + m * 16) * 1024 + col0;
#pragma unroll
                for (int bj = 0; bj < 2; ++bj)
#pragma unroll
                    for (int n = 0; n < 2; ++n) { const f32x4 hv = *(const f32x4*)(hin + ro + bj * 128 + n * 16); wt16f(hout + ro + bj * 128 + n * 16, hv + alpha * acc[ai][bj][m][n]); } }
    }
};
struct EpiZ { int wv; static constexpr bool PERM = true, AFTER_DRAIN = false; bf16_t* O;
    __device__ __forceinline__ void operator()(const f32x4 (&acc)[2][2][4][2], const pg8::Unit& u, int wr, int wc, int fr_, int fq_) const {
        const int ln_ = tid_from(wv) & 63, fr = ln_ & 15, fq = ln_ >> 4;
        const int row0 = u.pm * 256 + wr * 64 + fr, col0 = u.pn * 256 + wc * 32 + 8 * fq;
#pragma unroll
        for (int ai = 0; ai < 2; ++ai)
#pragma unroll
            for (int m = 0; m < 4; ++m)
#pragma unroll
                for (int bj = 0; bj < 2; ++bj) { const f32x4 a = acc[ai][bj][m][0], b = acc[ai][bj][m][1];
                    uint4 o; o.x = pk2(a[0], a[1]); o.y = pk2(a[2], a[3]); o.z = pk2(b[0], b[1]); o.w = pk2(b[2], b[3]);
                    wt16(O + (size_t)(row0 + ai * 128 + m * 16) * 2816 + col0 + bj * 128, o); }
    }
};
struct EpiGLU { int wv; static constexpr bool PERM = true, AFTER_DRAIN = false; bf16_t* O; const float* bias;
    __device__ __forceinline__ void operator()(const f32x4 (&acc)[2][2][4][2], const pg8::Unit& u, int wr, int wc, int fr_, int fq_) const {
        const int ln_ = tid_from(wv) & 63, fr = ln_ & 15, fq = ln_ >> 4;
        const int row0 = u.pm * 256 + wr * 64 + fr, cw = u.pn * 128 + wc * 32 + 8 * fq;
        const f32x4 bv0 = *(const f32x4*)(bias + cw), bv1 = *(const f32x4*)(bias + cw + 4), bg0 = *(const f32x4*)(bias + 256 + cw), bg1 = *(const f32x4*)(bias + 256 + cw + 4);
#pragma unroll
        for (int ai = 0; ai < 2; ++ai)
#pragma unroll
            for (int m = 0; m < 4; ++m) {
                const f32x4 v0 = acc[ai][0][m][0] + bv0, v1 = acc[ai][0][m][1] + bv1, g0 = acc[ai][1][m][0] + bg0, g1 = acc[ai][1][m][1] + bg1;
                uint4 o; o.x = pk2(v0[0] * sigmoidf_(g0[0]), v0[1] * sigmoidf_(g0[1])); o.y = pk2(v0[2] * sigmoidf_(g0[2]), v0[3] * sigmoidf_(g0[3]));
                o.z = pk2(v1[0] * sigmoidf_(g1[0]), v1[1] * sigmoidf_(g1[1])); o.w = pk2(v1[2] * sigmoidf_(g1[2]), v1[3] * sigmoidf_(g1[3]));
                wt16(O + (size_t)(row0 + ai * 128 + m * 16) * 1024 + 768 + cw, o);
            }
    }
};
template <class Epi> __device__ __forceinline__ void gemm_run(const Ctx& p, LAS unsigned char* lds, const bf16_t* A, const bf16_t* Bt, int N, int K, const Epi& E) {
    asm volatile("" : "+s"(N), "+s"(K));
    pg8::Gemm g; g.A = A; g.Bt = Bt; g.M = MTOK; g.N = N; g.K = K;
    pg8::StaticOrder S; S.init(MTOK, N, (int)GDIM, (int)BIDX);
    pg8::gemm_phase<Epi, pg8::StaticOrder, false>(lds, g, S, E, nullptr, TIDX);
}

__device__ __forceinline__ void rwkv_prep_phase(const Ctx& p, int l) {
    const bf16_t* z = (const bf16_t*)(PWS + WS_BIG);
    const unsigned char* wl = PWS + WS_WB + (size_t)l * WL_SIZE;
    const bf16_t* w2t = (const bf16_t*)(wl + WL_W2); const bf16_t* a2t = (const bf16_t*)(wl + WL_A2); const bf16_t* g2t = (const bf16_t*)(wl + WL_G2);
    const float* mup = PIN(8) + l * 1408; const float* mun = PIN(9) + l * 1408;
    const float* w0 = PIN(10) + l * 768; const float* a0 = PIN(12) + l * 768;
    f16_t* lam = (f16_t*)(PWS + WS_LAM); f16_t* aa = (f16_t*)(PWS + WS_AA); f16_t* gg = (f16_t*)(PWS + WS_GG);
    const int lane = TIDX & 63, fr = lane & 15, fq = lane >> 4;
    const int gw = BIDX * 8 + (TIDX >> 6), nw = GDIM * 8;
    for (int it = gw; it < MTOK / 32; it += nw) {
        const int m0 = it * 32;
        bf16x8 A[2][8];
#pragma unroll
        for (int sub = 0; sub < 2; ++sub) {
            const int tok = m0 + sub * 16 + fr, t = tok & (SEQ - 1);
            const bf16_t* zc = z + (size_t)tok * 2816;
            const bf16_t* zp = (t > 0) ? zc - 2816 : zc; const bf16_t* zn = (t < SEQ - 1) ? zc + 2816 : zc;
            const float fp = (t > 0) ? 1.f : 0.f, fn = (t < SEQ - 1) ? 1.f : 0.f;
#pragma unroll
            for (int ks = 0; ks < 8; ++ks) {
                const int col = 1152 + ks * 32 + fq * 8;
                const bf16x8 c8 = *(const bf16x8*)(zc + col), p8 = *(const bf16x8*)(zp + col), n8 = *(const bf16x8*)(zn + col);
#ifdef VEC_MU
                const f32x4 mpa = *(const f32x4*)(mup + col), mpb = *(const f32x4*)(mup + col + 4), mna = *(const f32x4*)(mun + col), mnb = *(const f32x4*)(mun + col + 4);
#endif
                float r[8];
#pragma unroll
                for (int e = 0; e < 8; ++e) {
                    const float x = bf2f((unsigned short)c8[e]), xp = fp * bf2f((unsigned short)p8[e]), xn = fn * bf2f((unsigned short)n8[e]);
#ifdef VEC_MU
                    const float xm = x + (e < 4 ? mpa[e & 3] : mpb[e & 3]) * (xp - x) + (e < 4 ? mna[e & 3] : mnb[e & 3]) * (xn - x);
#else
                    const float xm = x + mup[col + e] * (xp - x) + mun[col + e] * (xn - x);
#endif
                    r[e] = (ks < 2) ? tanhf_(xm) : ((ks < 4) ? xm : sigmoidf_(xm));
                }
                union { uint4 u; bf16x8 v; } cv; cv.u.x = pk2(r[0], r[1]); cv.u.y = pk2(r[2], r[3]); cv.u.z = pk2(r[4], r[5]); cv.u.w = pk2(r[6], r[7]);
                A[sub][ks] = cv.v;
            }
        }
#pragma unroll 1
        for (int nt = 0; nt < 48; ++nt) {
            const bf16x8 b0 = *(const bf16x8*)(w2t + (nt * 16 + fr) * 64 + fq * 8), b1 = *(const bf16x8*)(w2t + (nt * 16 + fr) * 64 + 32 + fq * 8);
            const bf16x8 c0 = *(const bf16x8*)(a2t + (nt * 16 + fr) * 64 + fq * 8), c1 = *(const bf16x8*)(a2t + (nt * 16 + fr) * 64 + 32 + fq * 8);
            const int n0 = nt * 16 + fq * 4;
            const f32x4 w0v = *(const f32x4*)(w0 + n0), a0v = *(const f32x4*)(a0 + n0);
#pragma unroll
            for (int sub = 0; sub < 2; ++sub) {
                const int tok = m0 + sub * 16 + fr;
                f32x4 acc = {0.f, 0.f, 0.f, 0.f}; acc = mfma16(b0, A[sub][0], acc); acc = mfma16(b1, A[sub][1], acc);
                f32x4 aca = {0.f, 0.f, 0.f, 0.f}; aca = mfma16(c0, A[sub][2], aca); aca = mfma16(c1, A[sub][3], aca);
                union { f16_t h[4]; uint2 u; } o1, o2;
#pragma unroll
                for (int j = 0; j < 4; ++j) { o1.h[j] = (f16_t)(0.60653066f * sigmoidf_(w0v[j] + acc[j])); o2.h[j] = (f16_t)sigmoidf_(a0v[j] + aca[j]); }
                wt8u(lam + (size_t)tok * 768 + n0, o1.u); wt8u(aa + (size_t)tok * 768 + n0, o2.u);
            }
        }
#pragma unroll 1
        for (int nt = 0; nt < 24; ++nt) {
            bf16x8 bb[4];
#pragma unroll
            for (int ks = 0; ks < 4; ++ks) bb[ks] = *(const bf16x8*)(g2t + (nt * 16 + fr) * 128 + ks * 32 + fq * 8);
            const int n0 = nt * 16 + fq * 4;
#pragma unroll
            for (int sub = 0; sub < 2; ++sub) {
                const int tok = m0 + sub * 16 + fr;
                f32x4 acc = {0.f, 0.f, 0.f, 0.f};
#pragma unroll
                for (int ks = 0; ks < 4; ++ks) acc = mfma16(bb[ks], A[sub][4 + ks], acc);
                union { f16_t h[4]; uint2 u; } o1;
#pragma unroll
                for (int j = 0; j < 4; ++j) o1.h[j] = (f16_t)acc[j];
                wt8u(gg + (size_t)tok * 384 + n0, o1.u);
            }
        }
    }
}

typedef float f32x2_ __attribute__((ext_vector_type(2)));
struct S5Lane { float lbr, lbi; f32x2_ b2[16]; };
__device__ __forceinline__ void s5_lane_params(const Ctx& p, int l, int d, int g, int pp, S5Lane& q) {
    const int idx = ((l * 2 + d) * 16 + g) * 64 + pp;
    const float are = PIN(20)[idx], aim = PIN(21)[idx], st = __expf(PIN(22)[(l * 2 + d) * 16 + g]);
    const float er = __expf(are * st), ang = aim * st;
    const float kf = rintf(ang * 0.15915494309f); float rr = fmaf(-kf, 6.2831855f, ang); rr = fmaf(-kf, -1.7484555e-7f, rr);
    float sn, cs; __sincosf(rr, &sn, &cs);
    q.lbr = er * cs; q.lbi = er * sn;
    const float nr = q.lbr - 1.f, ni = q.lbi, den = __builtin_amdgcn_rcpf(are * are + aim * aim);
    const float zr = (nr * are + ni * aim) * den, zi = (ni * are - nr * aim) * den;
    const float* br = PIN(23) + ((size_t)(l * 16 + g) * 64 + pp) * 16; const float* bi = PIN(24) + ((size_t)(l * 16 + g) * 64 + pp) * 16;
#pragma unroll
    for (int c = 0; c < 16; ++c) { const float x = br[c], y = bi[c]; q.b2[c] = (f32x2_){zr * x - zi * y, zr * y + zi * x}; }
}
__device__ __forceinline__ void s5_stage_u(const Ctx& p, int b, int c, int gq, LAS float* uf) {
    const bf16_t* z = (const bf16_t*)(PWS + WS_BIG);
#pragma unroll
    for (int i = 0; i < 2; ++i) {
        const int e = TIDX + 512 * i, t = e >> 3, part = e & 7;
        const bf16x8 v = *(const bf16x8*)(z + (size_t)(b * SEQ + c * 128 + t) * 2816 + 2560 + gq * 64 + part * 8);
#pragma unroll
        for (int k = 0; k < 8; ++k) uf[t * 64 + part * 8 + k] = bf2f((unsigned short)v[k]);
    }
}
__device__ __forceinline__ void s5_step(const S5Lane& q, const LAS float* urow, float& hr, float& hi) {
    f32x2_ bu0 = {0.f, 0.f}, bu1 = {0.f, 0.f};
#pragma unroll
    for (int c4 = 0; c4 < 4; ++c4) { const f32x4 u = *(const LAS f32x4*)(urow + c4 * 4);
        bu0 += q.b2[c4 * 4 + 0] * (f32x2_){u[0], u[0]}; bu1 += q.b2[c4 * 4 + 1] * (f32x2_){u[1], u[1]};
        bu0 += q.b2[c4 * 4 + 2] * (f32x2_){u[2], u[2]}; bu1 += q.b2[c4 * 4 + 3] * (f32x2_){u[3], u[3]}; }
    const f32x2_ bu = bu0 + bu1;
    const float nr = q.lbr * hr - q.lbi * hi + bu[0], ni = q.lbr * hi + q.lbi * hr + bu[1]; hr = nr; hi = ni;
}
__device__ __forceinline__ void s5_passA_item(const Ctx& p, int l, int item, LAS unsigned char* lds) {
    const int gq = item & 3, c = (item >> 2) & 63, b = item >> 8;
    const int wid = TIDX >> 6, lane = TIDX & 63, gi = wid >> 1, d = wid & 1, g = gq * 4 + gi;
    LAS float* uf = (LAS float*)lds;
    __syncthreads();
    s5_stage_u(p, b, c, gq, uf);
    S5Lane q; s5_lane_params(p, l, d, g, lane, q);
    __syncthreads();
    float hr = 0.f, hi = 0.f;
    for (int s = 0; s < 128; ++s) { const int ti = d ? 127 - s : s; s5_step(q, uf + ti * 64 + gi * 16, hr, hi); }
    float2* E = (float2*)(PWS + WS_S5E);
    wt8(&E[((size_t)((b * 16 + g) * 2 + d) * 64 + c) * 64 + lane], ((unsigned long long)__float_as_uint(hi) << 32) | __float_as_uint(hr));
}
__device__ __forceinline__ void s5_passC_item(const Ctx& p, int l, int item, LAS unsigned char* lds) {
    const int gq = item & 3, c = (item >> 2) & 63, b = item >> 8;
    const int tid = TIDX, wid = tid >> 6, lane = tid & 63, gi = wid >> 1, d = wid & 1, g = gq * 4 + gi, fr = lane & 15, fq = lane >> 4;
    LAS float* uf = (LAS float*)lds;
    LAS bf16_t* hs = (LAS bf16_t*)(lds + 32768) + wid * 16 * 136;
    LAS float* yl = (LAS float*)(lds + 32768 + 34816);
    __syncthreads();
    s5_stage_u(p, b, c, gq, uf);
    S5Lane q; s5_lane_params(p, l, d, g, lane, q);
    bf16x8 Cf[4];
    {
        const float* cre = PIN(25) + ((size_t)((l * 2 + d) * 16 + g) * 16 + fr) * 64; const float* cim = PIN(26) + ((size_t)((l * 2 + d) * 16 + g) * 16 + fr) * 64;
#pragma unroll
        for (int ks = 0; ks < 4; ++ks) { const int q0 = ks * 32 + fq * 8; float r[8];
#pragma unroll
            for (int e = 0; e < 8; ++e) r[e] = (q0 < 64) ? cre[q0 + e] : -cim[q0 - 64 + e];
            union { uint4 u; bf16x8 v; } cv; cv.u.x = pk2(r[0], r[1]); cv.u.y = pk2(r[2], r[3]); cv.u.z = pk2(r[4], r[5]); cv.u.w = pk2(r[6], r[7]); Cf[ks] = cv.v; }
    }
    float hr = 0.f, hi = 0.f;
    {
        float tr = q.lbr, ti = q.lbi;
#pragma unroll
        for (int k = 0; k < 7; ++k) { const float a = tr * tr - ti * ti, bq = 2.f * tr * ti; tr = a; ti = bq; }
        const float2* E = (const float2*)(PWS + WS_S5E) + ((size_t)((b * 16 + g) * 2 + d) * 64) * 64 + lane;
        if (d == 0) { for (int cc = 0; cc < c; ++cc) { const float2 e = E[(size_t)cc * 64]; const float nr = tr * hr - ti * hi + e.x, ni = tr * hi + ti * hr + e.y; hr = nr; hi = ni; } }
        else { for (int cc = 63; cc > c; --cc) { const float2 e = E[(size_t)cc * 64]; const float nr = tr * hr - ti * hi + e.x, ni = tr * hi + ti * hr + e.y; hr = nr; hi = ni; } }
    }
    __syncthreads();
    {
        const float* dsk = PIN(27) + l * 256 + gq * 64;
        for (int e = tid; e < 128 * 64; e += 512) { const int t = e >> 6, ch = e & 63; yl[((ch >> 4) * 128 + t) * 17 + (ch & 15)] = dsk[ch] * uf[e]; }
    }
    for (int sub = 0; sub < 8; ++sub) {
        for (int s16 = 0; s16 < 16; ++s16) {
            const int s = sub * 16 + s16, ti = d ? 127 - s : s;
            s5_step(q, uf + ti * 64 + gi * 16, hr, hi);
            const unsigned pk = pk2(hr, hi);
            hs[(ti & 15) * 136 + lane] = (bf16_t)(pk & 0xffffu); hs[(ti & 15) * 136 + 64 + lane] = (bf16_t)(pk >> 16);
        }
        __syncthreads();
        {
            f32x4 acc = {0.f, 0.f, 0.f, 0.f};
#pragma unroll
            for (int ks = 0; ks < 4; ++ks) { const bf16x8 af = *(const LAS bf16x8*)(hs + fr * 136 + ks * 32 + fq * 8); acc = mfma16(Cf[ks], af, acc); }
            const int tile = d ? 7 - sub : sub;
            LAS float* yp = yl + (gi * 128 + tile * 16 + fr) * 17 + fq * 4;
#pragma unroll
            for (int j = 0; j < 4; ++j) yp[j] += acc[j];
        }
        __syncthreads();
    }
    {
        bf16_t* yo = (bf16_t*)(PWS + WS_YPRE);
        const int t = tid >> 2, g4 = tid & 3;
        float r[16];
#pragma unroll
        for (int k = 0; k < 16; ++k) { const float x = yl[(g4 * 128 + t) * 17 + k]; r[k] = 0.5f * x * (1.f + tanhf_(0.7978845608f * (x + 0.044715f * x * x * x))); }
        uint4 o0, o1; o0.x = pk2(r[0], r[1]); o0.y = pk2(r[2], r[3]); o0.z = pk2(r[4], r[5]); o0.w = pk2(r[6], r[7]); o1.x = pk2(r[8], r[9]); o1.y = pk2(r[10], r[11]); o1.z = pk2(r[12], r[13]); o1.w = pk2(r[14], r[15]);
        bf16_t* dst = yo + (size_t)(b * SEQ + c * 128 + t) * 256 + gq * 64 + g4 * 16;
        wt16(dst, o0); wt16(dst + 8, o1);
    }
}

constexpr int SC_T = 32, SC_ROW = 352;
struct ScanRaw { unsigned zr[10], zk[10], zv[10], ar[8], lr[8]; };
__device__ __forceinline__ void scan_load_raw(ScanRaw& R, const bf16_t* zb, const unsigned short* ab, const unsigned short* lb, int tlo, int h, int hf, int d, int lane) {
#pragma unroll
    for (int r = 0; r < 10; ++r) {
        int tok = tlo - 1 + r; tok = tok < 0 ? 0 : (tok > SEQ - 1 ? SEQ - 1 : tok);
        const bf16_t* zp = zb + (size_t)tok * 2816 + h * 64;
        R.zr[r] = zp[lane]; R.zk[r] = zp[384 + lane]; R.zv[r] = zp[768 + hf * 32 + (lane & 31)];
    }
#pragma unroll
    for (int i = 0; i < 8; ++i) { const size_t o = (size_t)(tlo + i) * 768 + d * 384 + h * 64 + lane; R.ar[i] = ab[o]; R.lr[i] = lb[o]; }
}
__device__ __forceinline__ float row16_sum_asm(float x) {
    asm volatile("s_nop 1\n\tv_add_f32_dpp %0, %0, %0 row_ror:8 row_mask:0xf bank_mask:0xf\n\ts_nop 1\n\tv_add_f32_dpp %0, %0, %0 row_ror:4 row_mask:0xf bank_mask:0xf\n\ts_nop 1\n\tv_add_f32_dpp %0, %0, %0 row_ror:2 row_mask:0xf bank_mask:0xf\n\ts_nop 1\n\tv_add_f32_dpp %0, %0, %0 row_ror:1 row_mask:0xf bank_mask:0xf" : "+v"(x));
    return x; }
#define DPP_ADD(x, CTRL) ((x) + __builtin_bit_cast(float, __builtin_amdgcn_update_dpp(0, __builtin_bit_cast(int, (x)), (CTRL), 0xf, 0xf, false)))
__device__ __forceinline__ float red8(float x) {
    x = DPP_ADD(x, 0x141); x = DPP_ADD(x, 0x1B); x = DPP_ADD(x, 0xB1); return x;
}
__device__ __forceinline__ float dot4(f32x4 a, f32x4 b) { return a[0] * b[0] + a[1] * b[1] + a[2] * b[2] + a[3] * b[3]; }
typedef float f32p __attribute__((ext_vector_type(2)));
__device__ __forceinline__ float dot8(f32x4 sa, f32x4 sb, f32x4 a, f32x4 b) {
    f32p acc = __builtin_shufflevector(sa, sa, 0, 1) * __builtin_shufflevector(a, a, 0, 1);
    acc += __builtin_shufflevector(sa, sa, 2, 3) * __builtin_shufflevector(a, a, 2, 3);
    acc += __builtin_shufflevector(sb, sb, 0, 1) * __builtin_shufflevector(b, b, 0, 1);
    acc += __builtin_shufflevector(sb, sb, 2, 3) * __builtin_shufflevector(b, b, 2, 3);
    return acc[0] + acc[1];
}
__device__ __forceinline__ float f16bits2f(unsigned u) { union { unsigned short s; f16_t h; } c; c.s = (unsigned short)u; return (float)c.h; }
__device__ __forceinline__ void rwkv_scan_item(const Ctx& p, int l, int item, LAS unsigned char* lds) {
    const int chain = item >> 1, hf = item & 1, d = chain & 1, h = (chain >> 1) % 6, b = chain / 12;
    const int tid = TIDX, wid = __builtin_amdgcn_readfirstlane(tid >> 6), lane = tid & 63;
    LAS float* buf = (LAS float*)lds;
    const bf16_t* zb = (const bf16_t*)(PWS + WS_BIG) + (size_t)b * SEQ * 2816;
    __syncthreads();
    if (wid < 4) {
        const int j = lane & 7, rg = lane >> 3, row = wid * 8 + rg;
        bf16_t* yy = (bf16_t*)(PWS + WS_YY) + ((size_t)(((d * 8 + b) * 6 + h) * 2 + hf) * SEQ) * 32 + row;
        f32x4 Sa = {0.f, 0.f, 0.f, 0.f}, Sb = Sa; float ys = 0.f;
        __builtin_amdgcn_s_setprio(3);
        for (int c = 0; c < SEQ / SC_T; ++c) {
            __syncthreads();
            const LAS float* bb = buf + (c & 1) * SC_T * SC_ROW + 8 * j;
            const LAS float* vb = buf + (c & 1) * SC_T * SC_ROW + 320 + row;
            struct Ops { f32x4 wa, wb, na, nb, aa, ab, da, db, ra, rb; float v; };
            auto ld = [&](Ops& o, int s) {
                const LAS float* st = bb + s * SC_ROW;
                o.wa = *(const LAS f32x4*)(st); o.wb = *(const LAS f32x4*)(st + 4); o.na = *(const LAS f32x4*)(st + 64); o.nb = *(const LAS f32x4*)(st + 68); o.aa = *(const LAS f32x4*)(st + 128); o.ab = *(const LAS f32x4*)(st + 132);
                o.da = *(const LAS f32x4*)(st + 192); o.db = *(const LAS f32x4*)(st + 196); o.ra = *(const LAS f32x4*)(st + 256); o.rb = *(const LAS f32x4*)(st + 260);
                o.v = vb[s * SC_ROW];
            };
            auto stepf = [&](const Ops& o, int s) {
                float sa = dot8(Sa, Sb, o.na, o.nb);
                const f32x4 ta = Sa * o.wa + o.v * o.da, tb = Sb * o.wb + o.v * o.db;
                sa = red8(sa);
                Sa = ta + sa * o.aa; Sb = tb + sa * o.ab;
                float y = dot8(Sa, Sb, o.ra, o.rb);
                y = red8(y);
                if (j == (s & 7)) ys = y;
                if ((s & 7) == 7) {
                    const int sidx = c * SC_T + (s & ~7) + j, t = d ? SEQ - 1 - sidx : sidx;
                    wt2(&yy[(size_t)t * 32], (unsigned short)(pk2(ys, 0.f) & 0xffffu));
                }
            };
            Ops A, B;
            ld(A, 0);
#pragma unroll 2
            for (int s = 0; s < SC_T; s += 2) {
                ld(B, s + 1);
                stepf(A, s);
                if (s + 2 < SC_T) ld(A, s + 2);
                stepf(B, s + 1);
            }
        }
        __builtin_amdgcn_s_setprio(0);
    } else {
        const int lw = wid - 4;
        const unsigned short* ab = (const unsigned short*)(PWS + WS_AA) + (size_t)b * SEQ * 768;
        const unsigned short* lb = (const unsigned short*)(PWS + WS_LAM) + (size_t)b * SEQ * 768;
        float* cb = (float*)(PWS + WS_CB);
        const float* mup = PIN(8) + l * 1408; const float* mun = PIN(9) + l * 1408;
        const int cr = h * 64 + lane, cv = 768 + h * 64 + hf * 32 + (lane & 31);
        const float mpr = mup[cr], mnr = mun[cr], mpk = mup[384 + cr], mnk = mun[384 + cr], mpv = mup[cv], mnv = mun[cv];
        const float kkc = PIN(15)[l * 384 + cr], kac = PIN(16)[l * 384 + cr], rkc = PIN(17)[l * 384 + cr];
        ScanRaw Rc, Rn;
        auto tlo_of = [&](int c) { const int s0 = c * SC_T + lw * 8; return d ? SEQ - 1 - (s0 + 7) : s0; };
        auto process = [&](const ScanRaw& R, int c) {
            const int tlo = tlo_of(c);
            LAS float* nb = buf + (c & 1) * SC_T * SC_ROW;
            float fr_[10], fk_[10], fv_[10];
#pragma unroll
            for (int r = 0; r < 10; ++r) { const int tok = tlo - 1 + r; const float ok = (tok >= 0 && tok < SEQ) ? 1.f : 0.f;
                fr_[r] = ok * bf2f((unsigned short)R.zr[r]); fk_[r] = ok * bf2f((unsigned short)R.zk[r]); fv_[r] = ok * bf2f((unsigned short)R.zv[r]); }
            float r_[8], k_[8], v_[8], a_[8], w_[8], kk_[8], kd_[8], ss_[8], cb_[8];
#pragma unroll
            for (int i = 0; i < 8; ++i) {
                r_[i] = fr_[i + 1] + mpr * (fr_[i] - fr_[i + 1]) + mnr * (fr_[i + 2] - fr_[i + 1]);
                k_[i] = fk_[i + 1] + mpk * (fk_[i] - fk_[i + 1]) + mnk * (fk_[i + 2] - fk_[i + 1]);
                v_[i] = fv_[i + 1] + mpv * (fv_[i] - fv_[i + 1]) + mnv * (fv_[i + 2] - fv_[i + 1]);
                a_[i] = f16bits2f(R.ar[i]); w_[i] = __expf(-f16bits2f(R.lr[i]));
                kk_[i] = k_[i] * kkc; kd_[i] = k_[i] * (1.f + (a_[i] - 1.f) * kac);
                ss_[i] = row16_sum(kk_[i] * kk_[i]); cb_[i] = (hf == 0) ? row16_sum(r_[i] * kd_[i] * rkc) : 0.f;
            }
            {
                float t1[8], t2[8];
#pragma unroll
                for (int i = 0; i < 8; ++i) { t1[i] = shx(ss_[i], 16, lane); if (hf == 0) t2[i] = shx(cb_[i], 16, lane); }
#pragma unroll
                for (int i = 0; i < 8; ++i) { ss_[i] += t1[i]; if (hf == 0) cb_[i] += t2[i]; }
#pragma unroll
                for (int i = 0; i < 8; ++i) { t1[i] = shx(ss_[i], 32, lane); if (hf == 0) t2[i] = shx(cb_[i], 32, lane); }
#pragma unroll
                for (int i = 0; i < 8; ++i) { ss_[i] += t1[i]; if (hf == 0) cb_[i] += t2[i]; }
            }
#pragma unroll
            for (int i = 0; i < 8; ++i) {
                const float kh = kk_[i] * rsqrtf(ss_[i] + 1e-12f);
                const int slot = lw * 8 + (d ? 7 - i : i);
                LAS float* st = nb + slot * SC_ROW;
                st[lane] = w_[i]; st[64 + lane] = -kh; st[128 + lane] = kh * a_[i]; st[192 + lane] = kd_[i]; st[256 + lane] = r_[i]; if (lane < 32) st[320 + lane] = v_[i];
                if (hf == 0 && lane == 0) wt4(&cb[(size_t)((d * 8 + b) * 6 + h) * SEQ + tlo + i], __float_as_uint(cb_[i]));
            }
        };
        scan_load_raw(Rc, zb, ab, lb, tlo_of(0), h, hf, d, lane);
        scan_load_raw(Rn, zb, ab, lb, tlo_of(1), h, hf, d, lane);
        process(Rc, 0);
        for (int c = 0; c < SEQ / SC_T; ++c) {
            __syncthreads();
            if (c + 1 < SEQ / SC_T) {
                Rc = Rn;
                if (c + 2 < SEQ / SC_T) scan_load_raw(Rn, zb, ab, lb, tlo_of(c + 2), h, hf, d, lane);
                process(Rc, c + 1);
            }
        }
    }
}

__device__ __forceinline__ void rwkv_post_phase(const Ctx& p, int l) {
    const bf16_t* z = (const bf16_t*)(PWS + WS_BIG); const bf16_t* yy = (const bf16_t*)(PWS + WS_YY);
    const unsigned short* gg = (const unsigned short*)(PWS + WS_GG); const float* cb = (const float*)(PWS + WS_CB);
    bf16_t* O = (bf16_t*)(PWS + WS_XN);
    const float* mup = PIN(8) + l * 1408 + 768; const float* mun = PIN(9) + l * 1408 + 768;
    const float* lw_ = PIN(18) + l * 384; const float* lb_ = PIN(19) + l * 384;
    const int lane = TIDX & 63, gw = BIDX * 8 + (TIDX >> 6), nw = GDIM * 8;
    float mp_[6], mn_[6], lwv[6], lbv[6];
#pragma unroll
    for (int h = 0; h < 6; ++h) { mp_[h] = mup[h * 64 + lane]; mn_[h] = mun[h * 64 + lane]; lwv[h] = lw_[h * 64 + lane]; lbv[h] = lb_[h * 64 + lane]; }
    for (int tok = gw; tok < MTOK; tok += nw) {
        const int t = tok & (SEQ - 1), bb_ = tok >> 13;
        float y[6], vc[6], vp[6], vn[6], c0[6], c1[6], gv[6];
#pragma unroll
        for (int h = 0; h < 6; ++h) {
            const int col = h * 64 + lane;
            const size_t yo = ((size_t)((bb_ * 6 + h) * 2 + (lane >> 5)) * SEQ + t) * 32 + (lane & 31);
            y[h] = bf2f(yy[yo]) + bf2f(yy[yo + (size_t)8 * 6 * 2 * SEQ * 32]);
            const bf16_t* zc = z + (size_t)tok * 2816 + 768 + col;
            vc[h] = bf2f(zc[0]); vp[h] = (t > 0) ? bf2f(zc[-2816]) : 0.f; vn[h] = (t < SEQ - 1) ? bf2f(zc[2816]) : 0.f;
            c0[h] = cb[(size_t)(bb_ * 6 + h) * SEQ + t]; c1[h] = cb[(size_t)((8 + bb_) * 6 + h) * SEQ + t];
            gv[h] = f16bits2f(gg[(size_t)tok * 384 + col]);
        }
#pragma unroll
        for (int h = 0; h < 6; ++h) {
            const float mean = wave_sum(y[h], lane) * (1.f / 64.f); const float dv = y[h] - mean; const float var = wave_sum(dv * dv, lane) * (1.f / 64.f);
            const float yn = dv * rsqrtf(var + 64e-5f);
            const float v = vc[h] + mp_[h] * (vp[h] - vc[h]) + mn_[h] * (vn[h] - vc[h]);
            const float o = (yn * lwv[h] + lbv[h] + (c0[h] + c1[h]) * v) * gv[h];
            const unsigned ob = pk2(o, 0.f);
            wt2(&O[(size_t)tok * 1024 + h * 64 + lane], (unsigned short)(ob & 0xffffu));
        }
    }
}

struct AttnPre { u32x4 k[6]; u32x4 v[6]; bf16x8 q[2]; };
__device__ __forceinline__ void attn_issue(AttnPre& P, const bf16_t* zb, int h, int sp, int step, int tid, int lane) {
    const int pi = step >> 3, rnd = step & 7, dsh = 2 * pi, dm1 = (1 << dsh) - 1, n = SEQ >> dsh;
    int tt = tid & 255; LAUNDER(tt);
    const int s = tid >> 8, uidx = rnd * 2 + s, r = uidx & dm1, lb = uidx >> dsh, i = sp * (16 >> dsh) + lb, jbase = 64 * (i - 1);
#pragma unroll
    for (int it = 0; it < 6; ++it) {
        const int cid = tt + 256 * it, row = cid >> 3, part = cid & 7, jj = jbase + row; const bool ok = (jj >= 0 && jj < n);
        u32x4 v = {0u, 0u, 0u, 0u};
        if (ok) v = *(const u32x4*)(zb + (size_t)(r + (jj << dsh)) * 2816 + 1792 + h * 64 + part * 8);
        P.k[it] = v;
    }
#pragma unroll
    for (int it = 0; it < 3; ++it) {
        const int cid = tt + 256 * it, rp = cid % 96, part = cid / 96;
#pragma unroll
        for (int hh = 0; hh < 2; ++hh) { const int jj = jbase + 2 * rp + hh; const bool ok = (jj >= 0 && jj < n);
            u32x4 v = {0u, 0u, 0u, 0u};
            if (ok) v = *(const u32x4*)(zb + (size_t)(r + (jj << dsh)) * 2816 + 2176 + h * 64 + part * 8);
            P.v[it * 2 + hh] = v; }
    }
    {
        const int wid = tid >> 6, sl = wid >> 2, wq = wid & 3, fr = lane & 15, fq = lane >> 4;
        const int u2 = rnd * 2 + sl, r2 = u2 & dm1, lb2 = u2 >> dsh, i2 = sp * (16 >> dsh) + lb2, posq = r2 + ((64 * i2 + wq * 16 + fr) << dsh);
#pragma unroll
        for (int ks = 0; ks < 2; ++ks) P.q[ks] = *(const bf16x8*)(zb + (size_t)posq * 2816 + 1408 + h * 64 + ks * 32 + fq * 8);
    }
}
__device__ __forceinline__ void attn_item(const Ctx& p, int item, LAS unsigned char* lds) {
    const int sp = item & 7, h = (item >> 3) % 6, b = item / 48;
    const int tid = TIDX, wid = tid >> 6, lane = tid & 63, sl = wid >> 2, wq = wid & 3;
    LAS bf16_t* Ks = (LAS bf16_t*)lds;
    LAS bf16_t* Vt = Ks + 2 * 192 * 80;
    const bf16_t* zb = (const bf16_t*)(PWS + WS_BIG) + (size_t)b * SEQ * 2816;
    bf16_t* O = (bf16_t*)(PWS + WS_XN); float* lsebuf = (float*)(PWS + WS_LSE);
    const float slope = (h == 0) ? 0.25f : (h == 1) ? 0.0625f : (h == 2) ? 0.015625f : (h == 3) ? 0.00390625f : (h == 4) ? 0.5f : 0.125f;
    AttnPre P;
    attn_issue(P, zb, h, sp, 0, tid, lane);
#pragma unroll 1
    for (int step = 0; step < 24; ++step) {
        const int pi = step >> 3, rnd = step & 7, dsh = 2 * pi, dm1 = (1 << dsh) - 1, n = SEQ >> dsh;
        __syncthreads();
        {
            int tt = tid & 255; LAUNDER(tt);
            const int s = tid >> 8;
#pragma unroll
            for (int it = 0; it < 6; ++it) { const int cid = tt + 256 * it, row = cid >> 3, part = cid & 7; *(LAS u32x4*)(Ks + (s * 192 + row) * 80 + part * 8) = P.k[it]; }
#pragma unroll
            for (int it = 0; it < 3; ++it) { const int cid = tt + 256 * it, rp = cid % 96, part = cid / 96; const u32x4 a = P.v[it * 2], c = P.v[it * 2 + 1];
#pragma unroll
                for (int e = 0; e < 4; ++e) {
                    *(LAS unsigned*)(Vt + (s * 64 + part * 8 + 2 * e) * 200 + 2 * rp) = (a[e] & 0xffffu) | (c[e] << 16);
                    *(LAS unsigned*)(Vt + (s * 64 + part * 8 + 2 * e + 1) * 200 + 2 * rp) = (a[e] >> 16) | (c[e] & 0xffff0000u);
                } }
        }
        const bf16x8 qf0 = P.q[0], qf1 = P.q[1];
        if (step + 1 < 24) attn_issue(P, zb, h, sp, step + 1, tid, lane);
        __syncthreads();
        {
            const int uidx = rnd * 2 + sl, r = uidx & dm1, lb = uidx >> dsh, i = sp * (16 >> dsh) + lb;
            int fr = lane & 15, fq = lane >> 4; LAUNDER(fr); LAUNDER(fq);
            const int qi = wq * 16 + fr, posq = r + ((64 * i + qi) << dsh); const size_t tokq = (size_t)b * SEQ + posq;
            bf16_t* op = O + tokq * 1024 + 384 + h * 64 + fq * 4; float* lp = lsebuf + (size_t)(b * 6 + h) * SEQ + posq;
            float lprev = 0.f; unsigned long long pq[4] = {0ull, 0ull, 0ull, 0ull};
            if (pi > 0) { lprev = __hip_atomic_load(lp, __ATOMIC_RELAXED, __HIP_MEMORY_SCOPE_AGENT);
#pragma unroll
                for (int dt = 0; dt < 4; ++dt) pq[dt] = __hip_atomic_load((const unsigned long long*)(op + dt * 16), __ATOMIC_RELAXED, __HIP_MEMORY_SCOPE_AGENT); }
            f32x4 sacc[12];
#pragma unroll
            for (int kt = 0; kt < 12; ++kt) { f32x4 acc = {0.f, 0.f, 0.f, 0.f};
                acc = mfma16(*(const LAS bf16x8*)(Ks + (sl * 192 + kt * 16 + fr) * 80 + fq * 8), qf0, acc);
                acc = mfma16(*(const LAS bf16x8*)(Ks + (sl * 192 + kt * 16 + fr) * 80 + 32 + fq * 8), qf1, acc);
                sacc[kt] = acc; }
            const float basef = (float)(fq * 4 - 64 - qi), sd2 = slope * (float)(1 << dsh) * 1.44269504f;
            const bool edge = (i == 0) || (64 * (i + 2) > n);
            float mx = -1e30f;
#pragma unroll
            for (int kt = 0; kt < 12; ++kt)
#pragma unroll
                for (int jj = 0; jj < 4; ++jj) { const float ar = fabsf((float)(kt * 16 + jj) + basef); bool ok = ar <= 64.f;
                    if (edge) { const int jk = 64 * (i - 1) + kt * 16 + fq * 4 + jj; ok = ok && (jk >= 0) && (jk < n); }
                    const float lg = ok ? fmaf(sacc[kt][jj], 0.125f * 1.44269504f, -sd2 * ar) : -1e30f; sacc[kt][jj] = lg; mx = fmaxf(mx, lg); }
            mx = fmaxf(mx, shx(mx, 16, lane)); mx = fmaxf(mx, shx(mx, 32, lane));
            float lsum = 0.f;
#pragma unroll
            for (int kt = 0; kt < 12; ++kt)
#pragma unroll
                for (int jj = 0; jj < 4; ++jj) { const float pv = __builtin_amdgcn_exp2f(sacc[kt][jj] - mx); sacc[kt][jj] = pv; lsum += pv; }
            lsum += shx(lsum, 16, lane); lsum += shx(lsum, 32, lane);
            f32x4 oacc[4];
#pragma unroll
            for (int dt = 0; dt < 4; ++dt) oacc[dt] = (f32x4){0.f, 0.f, 0.f, 0.f};
#pragma unroll
            for (int kk = 0; kk < 6; ++kk) {
                union { uint4 u; bf16x8 v; } pf; pf.u.x = pk2(sacc[2 * kk][0], sacc[2 * kk][1]); pf.u.y = pk2(sacc[2 * kk][2], sacc[2 * kk][3]); pf.u.z = pk2(sacc[2 * kk + 1][0], sacc[2 * kk + 1][1]); pf.u.w = pk2(sacc[2 * kk + 1][2], sacc[2 * kk + 1][3]);
#pragma unroll
                for (int dt = 0; dt < 4; ++dt) {
                    const LAS bf16_t* vp = Vt + (sl * 64 + dt * 16 + fr) * 200 + kk * 32 + fq * 4;
                    union { u32x2 h[2]; bf16x8 v; } vf; vf.h[0] = *(const LAS u32x2*)vp; vf.h[1] = *(const LAS u32x2*)(vp + 16);
                    oacc[dt] = mfma16(vf.v, pf.v, oacc[dt]);
                }
            }
            const float inv = __builtin_amdgcn_rcpf(lsum); float lse = mx * 0.69314718f + __logf(lsum);
            float wn = inv, wp = 0.f;
            if (pi > 0) { const float L = fmaxf(lprev, lse); const float ep = __expf(lprev - L), en = __expf(lse - L); const float den = __builtin_amdgcn_rcpf(ep + en);
                wp = ep * den; wn = en * den * inv; lse = L + __logf(ep + en); }
#pragma unroll
            for (int dt = 0; dt < 4; ++dt) {
                float o0 = oacc[dt][0] * wn, o1 = oacc[dt][1] * wn, o2 = oacc[dt][2] * wn, o3 = oacc[dt][3] * wn;
                if (pi > 0) { const unsigned px = (unsigned)pq[dt], py = (unsigned)(pq[dt] >> 32);
                    o0 += wp * __uint_as_float(px << 16); o1 += wp * __uint_as_float(px & 0xffff0000u); o2 += wp * __uint_as_float(py << 16); o3 += wp * __uint_as_float(py & 0xffff0000u); }
                uint2 ov; ov.x = pk2(o0, o1); ov.y = pk2(o2, o3); wt8u(op + dt * 16, ov);
            }
            if (fq == 0) wt4(lp, __float_as_uint(lse));
        }
    }
}
#ifndef DUP_MASK
#define DUP_MASK 7
#endif

__device__ __forceinline__ void zero_cols(const Ctx& p, bf16_t* O, int c0, int ncols) {
    const int per = ncols >> 3; const size_t total = (size_t)MTOK * per;
    for (size_t i = (size_t)BIDX * 512 + TIDX; i < total; i += (size_t)GDIM * 512) { const size_t row = i / per; const int pc = (int)(i % per); *(uint4*)(O + row * 1024 + c0 + pc * 8) = make_uint4(0u, 0u, 0u, 0u); }
}
__device__ __forceinline__ void mixer_phase(const Ctx& p, int l, LAS unsigned char* lds, int rep = 0) {
    unsigned* ctr = (unsigned*)(PWS + WS_CTR) + l + 2 * rep;
    LAS int* sitem = (LAS int*)(lds + 131072);
    for (;;) {
        __syncthreads();
        if (TIDX == 0) *sitem = (int)atomicAdd(ctr, 1u);
        __syncthreads();
        const int item = __builtin_amdgcn_readfirstlane(*sitem);
        if (item >= 192 + 384 + 2048) break;
        if (item < 192) {
#if EN_RWKV
            if (!rep || (DUP_MASK & 1)) rwkv_scan_item(p, l, item, lds);
#endif
        } else if (item < 576) {
#if EN_ATTN
            if (!rep || (DUP_MASK & 2)) attn_item(p, item - 192, lds);
#endif
        } else {
#if EN_S5
            if (!rep || (DUP_MASK & 4)) s5_passC_item(p, l, item - 576, lds);
#endif
        }
    }
}
constexpr int NPH = 25;
__device__ __forceinline__ void run_phase(const Ctx& p, int ph, LAS unsigned char* lds) {
    bf16_t* XN = (bf16_t*)(PWS + WS_XN); bf16_t* BIG = (bf16_t*)(PWS + WS_BIG);
    if (ph == 0) {
#ifdef DUP_W
        weights_phase(p, lds);
#endif
        weights_phase(p, lds);
        if (BIDX == 0 && TIDX < 128) ((unsigned*)(PWS + WS_CTR))[TIDX] = 0u;
        norm_phase(p, PIN(0), PIN(1), XN, nullptr);
        return;
    }
    const int l = (ph - 1) / 12, k = (ph - 1) % 12;
    const unsigned char* wl = PWS + WS_WB + (size_t)l * WL_SIZE;
    switch (k) {
    case 0: case 9: {
#if EN_FFN
        EpiSwiGLU E; E.wv = p.wv; E.O = BIG;
#ifdef DUP_GU
        for (int rep = 0; rep < 2; ++rep)
#endif
        gemm_run(p, lds, XN, (const bf16_t*)(wl + (k == 0 ? WL_GU1 : WL_GU2)), 5632, 1024, E);
#endif
    } break;
    case 1: case 10: {
        const float* hin = (l == 0 && k == 1) ? PIN(0) : POUT;
#if EN_FFN
        EpiResid E; E.wv = p.wv; E.hin = hin; E.hout = POUT; E.alpha = 0.5f; gemm_run(p, lds, BIG, (const bf16_t*)(wl + (k == 1 ? WL_D1 : WL_D2)), 1024, 2816, E);
#else
        if (l == 0 && k == 1) { for (size_t i = (size_t)BIDX * 512 + TIDX; i < (size_t)MTOK * 256; i += (size_t)GDIM * 512) ((float4*)POUT)[i] = ((const float4*)hin)[i]; }
#endif
    } break;
    case 2: norm_phase(p, POUT, PIN(5) + l * 1024, XN, nullptr);
#ifdef DUP_NORM
        norm_phase(p, POUT, PIN(5) + l * 1024, XN, nullptr); norm_phase(p, POUT, PIN(5) + l * 1024, XN, nullptr); norm_phase(p, POUT, PIN(5) + l * 1024, XN, nullptr);
#endif
        break;
    case 3: { EpiZ E; E.wv = p.wv; E.O = BIG; gemm_run(p, lds, XN, (const bf16_t*)(wl + WL_IN), 2816, 1024, E); } break;
    case 4: {
#if EN_RWKV
        rwkv_prep_phase(p, l);
#ifdef DUP_PREP
        rwkv_prep_phase(p, l);
#endif
#endif
#if EN_S5
        for (int item = BIDX; item < 2048; item += GDIM) s5_passA_item(p, l, item, lds);
#ifdef DUP_PASSA
        for (int item = BIDX; item < 2048; item += GDIM) s5_passA_item(p, l, item, lds);
#endif
#endif
    } break;
    case 5: mixer_phase(p, l, lds); break;
    case 6: {
#if EN_S5
        { EpiGLU E; E.wv = p.wv; E.O = XN; E.bias = PIN(29) + l * 512; gemm_run(p, lds, (const bf16_t*)(PWS + WS_YPRE), (const bf16_t*)(wl + WL_GLU), 512, 256, E); }
#else
        zero_cols(p, XN, 768, 256);
#endif
#if EN_RWKV
        rwkv_post_phase(p, l);
#ifdef DUP_POST
        rwkv_post_phase(p, l);
#endif
#else
        zero_cols(p, XN, 0, 384);
#endif
#if !EN_ATTN
        zero_cols(p, XN, 384, 384);
#endif
    } break;
    case 7: { EpiResid E; E.wv = p.wv; E.hin = POUT; E.hout = POUT; E.alpha = 1.0f; gemm_run(p, lds, XN, (const bf16_t*)(wl + WL_OUT), 1024, 1024, E); } break;
    case 8: norm_phase(p, POUT, PIN(30) + l * 1024, XN, nullptr); break;
    case 11: if (l == 0) norm_phase(p, POUT, PIN(1) + 1024, XN, nullptr); else norm_phase(p, POUT, PIN(34), nullptr, POUT); break;
    }
}

__global__ void __launch_bounds__(512, 2) mega(Params kp, int ph_lo, int ph_hi) {
    extern __shared__ __attribute__((aligned(16))) unsigned char shm[];
    LAS unsigned char* lds = (LAS unsigned char*)shm;
    cg::grid_group grid = cg::this_grid();
    LAS unsigned long long* tab = (LAS unsigned long long*)(lds + 131072 + 64);
    if (threadIdx.x == 0) {
#pragma unroll
        for (int i = 0; i < 35; ++i) tab[i] = (unsigned long long)kp.in[i];
        tab[35] = (unsigned long long)kp.out; tab[36] = (unsigned long long)kp.ws;
    }
    __syncthreads();
    Ctx p; p.tab = tab; p.wv = __builtin_amdgcn_readfirstlane((int)(threadIdx.x >> 6));
    unsigned* bar = (unsigned*)(PWS + WS_BAR);
    unsigned nbar = 0;
    for (int ph = ph_lo; ph < ph_hi; ++ph) {
        run_phase(p, ph, lds);
        if (ph + 1 < ph_hi) {
#ifdef CG_ONLY
#ifdef HARDEN
            __builtin_amdgcn_fence(__ATOMIC_RELEASE, "agent");
            asm volatile("s_waitcnt vmcnt(0) lgkmcnt(0)" ::: "memory");
#endif
            grid.sync();
#ifdef HARDEN
            __builtin_amdgcn_fence(__ATOMIC_ACQUIRE, "agent");
            asm volatile("s_waitcnt vmcnt(0)" ::: "memory");
            __syncthreads();
#endif
#else
            if (ph == ph_lo) {
                grid.sync();
            } else {
                ++nbar;
                asm volatile("s_waitcnt vmcnt(0) lgkmcnt(0)" ::: "memory");
                __syncthreads();
                if (threadIdx.x == 0) {
                    const unsigned target = nbar * (unsigned)gridDim.x;
                    __builtin_amdgcn_fence(__ATOMIC_RELEASE, "agent");
                    asm volatile("s_waitcnt vmcnt(0)" ::: "memory");
                    __hip_atomic_fetch_add(bar, 1u, __ATOMIC_RELAXED, __HIP_MEMORY_SCOPE_AGENT);
                    while (__hip_atomic_load(bar, __ATOMIC_RELAXED, __HIP_MEMORY_SCOPE_AGENT) < target) __builtin_amdgcn_s_sleep(1);
                    __builtin_amdgcn_fence(__ATOMIC_ACQUIRE, "agent");
                    asm volatile("s_waitcnt vmcnt(0)" ::: "memory");
                    __hip_atomic_fetch_add(bar + 64, 1u, __ATOMIC_RELAXED, __HIP_MEMORY_SCOPE_AGENT);
                    while (__hip_atomic_load(bar + 64, __ATOMIC_RELAXED, __HIP_MEMORY_SCOPE_AGENT) < target) __builtin_amdgcn_s_sleep(1);
                }
                __syncthreads();
            }
#endif
        }
    }
}

#ifndef SPLIT_LAUNCH
#define SPLIT_LAUNCH 0
#endif
extern "C" void kernel_launch(void* const* d_in, const int* in_sizes, int n_in, void* d_out, int out_size, void* d_ws, size_t ws_size, hipStream_t stream) {
    static int grid = 0;
    if (grid == 0) {
        if (n_in != 35 || out_size != MTOK * 1024 || ws_size < WS_END) { fprintf(stderr, "kernel_launch: unexpected shapes (n_in %d out %d ws %zu need %zu)\n", n_in, out_size, ws_size, (size_t)WS_END); grid = -1; return; }
        int dev = 0, cus = 0, per_cu = 0;
        if (hipGetDevice(&dev) != hipSuccess || hipDeviceGetAttribute(&cus, hipDeviceAttributeMultiprocessorCount, dev) != hipSuccess) { grid = -1; return; }
        if (hipFuncSetAttribute((const void*)mega, hipFuncAttributeMaxDynamicSharedMemorySize, LDS_BYTES) != hipSuccess) { fprintf(stderr, "kernel_launch: hipFuncSetAttribute failed\n"); grid = -1; return; }
        if (hipOccupancyMaxActiveBlocksPerMultiprocessor(&per_cu, (const void*)mega, 512, LDS_BYTES) != hipSuccess || per_cu < 1) { fprintf(stderr, "kernel_launch: occupancy query says %d\n", per_cu); per_cu = 1; }
        (void)hipGetLastError();
        grid = cus;
    }
    if (grid < 0) return;
    Params p{};
    for (int i = 0; i < 35; ++i) p.in[i] = (const float*)d_in[i];
    p.out = (float*)d_out; p.ws = (unsigned char*)d_ws;
#if SPLIT_LAUNCH
    for (int ph = 0; ph < NPH; ++ph) { int lo = ph, hi = ph + 1; void* args[] = {&p, &lo, &hi};
        hipError_t e = hipLaunchCooperativeKernel((const void*)mega, dim3(grid), dim3(512), args, LDS_BYTES, stream);
        if (e != hipSuccess) { fprintf(stderr, "launch failed: %s\n", hipGetErrorString(e)); return; } }
#else
    int lo = 0, hi = NPH; void* args[] = {&p, &lo, &hi};
    hipError_t e = hipLaunchCooperativeKernel((const void*)mega, dim3(grid), dim3(512), args, LDS_BYTES, stream);
    if (e != hipSuccess) fprintf(stderr, "cooperative launch failed: %s (grid %d)\n", hipGetErrorString(e), grid);
#endif
}
```

```cpp
#include <hip/hip_cooperative_groups.h>
#include <cstdio>
#include <hip/hip_runtime.h>
__device__ __forceinline__ int tid_from(int wv) { unsigned m = ~0u; asm volatile("" : "+s"(m), "+s"(wv)); return wv * 64 + (int)__builtin_amdgcn_mbcnt_hi(m, __builtin_amdgcn_mbcnt_lo(m, 0u)); }
#define TIDX (tid_from(p.wv))
__device__ __forceinline__ int bid_() { int b = blockIdx.x; asm volatile("" : "+s"(b)); return b; }
__device__ __forceinline__ int gdim_() { int b = gridDim.x; asm volatile("" : "+s"(b)); return b; }
#define BIDX (bid_())
#define GDIM (gdim_())
#define CG_ONLY 1
#include <hip/hip_runtime.h>
namespace pg8 {
#define PG8_LAS __attribute__((address_space(3)))
typedef unsigned short bf16_t;
typedef short bf16x8 __attribute__((ext_vector_type(8)));
typedef float f32x4 __attribute__((ext_vector_type(4)));
typedef unsigned u32x4 __attribute__((ext_vector_type(4)));
constexpr int BM = 256, BK = 64, HALF = 128, HTB = HALF * BK * 2  , STAGE_BYTES = 8 * HTB, NXCD = 8, WGM = 8;

__host__ __device__ __forceinline__ int lds_byte(int r, int c) { const int st = (r >> 4) * 2 + (c >> 5), rr = r & 15, cc = c & 31, ob = rr * 64 + cc * 2; return st * 1024 + (ob ^ (((ob >> 9) & 1) << 5)); }
__host__ __device__ __forceinline__ void stage_rc(int b, int& R, int& C) { const int st = b / 1024, sb = b % 1024, swz = sb ^ (((sb >> 9) & 1) << 5); R = (st >> 1) * 16 + swz / 64; C = (st & 1) * 32 + (swz % 64) / 2; }
__host__ __device__ __forceinline__ int perm32(int rho) { const int n = rho >> 4, i = rho & 15; return 8 * (i >> 2) + 4 * n + (i & 3); }

struct Unit { int pm, pn; };
struct Gemm { const bf16_t* A; const bf16_t* Bt; int M, N, K; };

struct StaticOrder {
    int nM, nN, nwg, G, c;
    __host__ __device__ void init(int M, int N, int G_, int c_) { nM = M / BM; nN = N / BM; nwg = nM * nN; G = G_; c = c_; }
    __host__ __device__ bool next(int i, Unit& u) const {
        const long L = (long)i * G + c; if (L >= nwg) return false;
        int wgid = (int)L; { const int q = nwg / NXCD, r = nwg % NXCD, xcd = wgid % NXCD, off = wgid / NXCD; wgid = (xcd < r ? xcd * (q + 1) : r * (q + 1) + (xcd - r) * q) + off; }
        const int nig = WGM * nN, gid = wgid / nig, fm = gid * WGM, gsz = (nM - fm) < WGM ? (nM - fm) : WGM;
        u.pm = fm + ((wgid % nig) % gsz); u.pn = (wgid % nig) / gsz; return true;
    }
    __device__ __forceinline__ void a_ready(const Unit&) const {}
    __device__ __forceinline__ void done(const Unit&) const {}
};
__device__ __forceinline__ unsigned cvt_pk_bf16(float lo, float hi) { unsigned r; asm volatile("v_cvt_pk_bf16_f32 %0, %1, %2" : "=v"(r) : "v"(lo), "v"(hi)); return r; }
template <class Epi, class Sched, bool STAMP = false>
__device__ __forceinline__ void gemm_phase(PG8_LAS unsigned char* lds, const Gemm g, const Sched& S, const Epi& E, unsigned long long* stamps, const int tid_in) {
    const int tid = tid_in, wid = __builtin_amdgcn_readfirstlane(tid >> 6), lane = tid & 63, wr = wid >> 2, wc = wid & 3, fr = lane & 15, fq = lane >> 4;
    const int K = g.K, nt = K / BK;
    int ts_lo = 0, ts_hi = 0, nts = 0; const unsigned long long rt_entry = STAMP ? (unsigned long long)wall_clock64() : 0ull;
#define PG8_STAMP() do { if (STAMP && wid == 0 && nts < 64) { const unsigned long long _c = (unsigned long long)clock64(); \
        ts_lo = (lane == nts) ? (int)(unsigned)_c : ts_lo; ts_hi = (lane == nts) ? (int)(unsigned)(_c >> 32) : ts_hi; ++nts; } } while (0)
    PG8_STAMP();
    unsigned voffA[2], voffB[2];
#pragma unroll
    for (int i = 0; i < 2; ++i) { int R, C; stage_rc(tid * 16 + i * 8192, R, C); const int Rb = Epi::PERM ? ((R & ~31) + perm32(R & 31)) : R;
        voffA[i] = (unsigned)(R * K + C) * 2u; voffB[i] = (unsigned)(Rb * K + C) * 2u; }
    const size_t kstep = (size_t)(BK * 2);
    const size_t hstep = (size_t)HALF * K * 2;
    const size_t tstep = 2 * hstep;
    const unsigned ldsw = (unsigned)wid * 1024u;
    const int aoff = lds_byte(wr * 64 + fr, fq * 8), boff = lds_byte(wc * 32 + fr, fq * 8);
#define PG8_SA(b, h) (((b) * 2 + (h)) * HTB)
#define PG8_SB(b, h) ((4 + (b) * 2 + (h)) * HTB)
#define PG8_STAGE(bufoff, gbase, voff) do { _Pragma("unroll") for (int _i = 0; _i < 2; ++_i) \
        __builtin_amdgcn_global_load_lds((const unsigned*)((const char*)(gbase) + (voff)[_i]), (PG8_LAS unsigned*)(lds + (bufoff) + ldsw + _i * 8192), 16, 0, 0); } while (0)
#define PG8_LDA(dst, b, h) do { _Pragma("unroll") for (int m = 0; m < 4; ++m) _Pragma("unroll") for (int k = 0; k < 2; ++k) dst[m][k] = *(const PG8_LAS bf16x8*)(lds + PG8_SA(b, h) + aoff + m * 2048 + k * 1024); } while (0)
#define PG8_LDB(dst, b, h) do { _Pragma("unroll") for (int n = 0; n < 2; ++n) _Pragma("unroll") for (int k = 0; k < 2; ++k) dst[n][k] = *(const PG8_LAS bf16x8*)(lds + PG8_SB(b, h) + boff + n * 2048 + k * 1024); } while (0)
#define PG8_MMA(ai, bj, At, Bt) do { __builtin_amdgcn_s_setprio(1); _Pragma("unroll") for (int m = 0; m < 4; ++m) _Pragma("unroll") for (int n = 0; n < 2; ++n) _Pragma("unroll") for (int k = 0; k < 2; ++k) \
        acc[ai][bj][m][n] = __builtin_amdgcn_mfma_f32_16x16x32_bf16(Bt[n][k], At[m][k], acc[ai][bj][m][n], 0, 0, 0); __builtin_amdgcn_s_setprio(0); } while (0)
#define PG8_WAIT_V(n) asm volatile("s_waitcnt vmcnt(" #n ")" ::: "memory")
#define PG8_WAIT_L(n) asm volatile("s_waitcnt lgkmcnt(" #n ")" ::: "memory")
#define PG8_BAR __builtin_amdgcn_s_barrier()
#define PG8_SCHED __builtin_amdgcn_sched_barrier(0)
    Unit cur, nxt; int ui = 0;
    if (!S.next(0, cur)) return;
    f32x4 acc[2][2][4][2];
#pragma unroll
    for (int a = 0; a < 2; ++a)
#pragma unroll
        for (int b = 0; b < 2; ++b)
#pragma unroll
            for (int m = 0; m < 4; ++m)
#pragma unroll
                for (int n = 0; n < 2; ++n) acc[a][b][m][n] = (f32x4){0.f, 0.f, 0.f, 0.f};
    bf16x8 At[4][2], B0[2][2], B1[2][2];
    const char* cA = (const char*)g.A + (size_t)cur.pm * tstep; const char* cB = (const char*)g.Bt + (size_t)cur.pn * tstep;
    S.a_ready(cur);
    PG8_STAGE(PG8_SB(0, 0), cB, voffB); PG8_STAGE(PG8_SA(0, 0), cA, voffA); PG8_STAGE(PG8_SB(0, 1), cB + hstep, voffB); PG8_STAGE(PG8_SA(0, 1), cA + hstep, voffA);
    if (wr == 1) PG8_BAR;
    PG8_WAIT_V(4); PG8_BAR;
    PG8_STAGE(PG8_SB(1, 0), cB + kstep, voffB); PG8_STAGE(PG8_SA(1, 0), cA + kstep, voffA); PG8_STAGE(PG8_SB(1, 1), cB + hstep + kstep, voffB);
    PG8_WAIT_V(6); PG8_BAR;
    PG8_STAMP();
    for (;;) {
        const bool has_next = S.next(ui + 1, nxt);
        const char* nA = has_next ? (const char*)g.A + (size_t)nxt.pm * tstep : cA; const char* nB = has_next ? (const char*)g.Bt + (size_t)nxt.pn * tstep : cB;
        for (int t = 0; t < nt; t += 2) {
            const bool last = (t == nt - 2);
            const char* a1 = cA + (size_t)(t + 1) * kstep;
            const char* a2 = last ? nA : cA + (size_t)(t + 2) * kstep; const char* b2 = last ? nB : cB + (size_t)(t + 2) * kstep;
            const char* a3 = a2 + kstep; const char* b3 = b2 + kstep;
            if (last && has_next) S.a_ready(nxt);
            PG8_LDB(B0, 0, 0); PG8_SCHED; PG8_LDA(At, 0, 0); PG8_STAGE(PG8_SA(1, 1), a1 + hstep, voffA);
            PG8_WAIT_L(8); PG8_BAR; PG8_WAIT_L(0); PG8_MMA(0, 0, At, B0); PG8_BAR; PG8_SCHED;
            PG8_LDB(B1, 0, 1); PG8_STAGE(PG8_SB(0, 0), b2, voffB);
            PG8_BAR; PG8_WAIT_L(0); PG8_MMA(0, 1, At, B1); PG8_BAR;
            PG8_LDA(At, 0, 1); PG8_STAGE(PG8_SA(0, 0), a2, voffA);
            PG8_BAR; PG8_WAIT_L(0); PG8_MMA(1, 0, At, B0); PG8_BAR; PG8_SCHED;
            PG8_STAGE(PG8_SB(0, 1), b2 + hstep, voffB);
            PG8_WAIT_V(6); PG8_BAR; PG8_MMA(1, 1, At, B1); PG8_BAR;
            PG8_LDB(B0, 1, 0); PG8_SCHED; PG8_LDA(At, 1, 0); PG8_STAGE(PG8_SA(0, 1), a2 + hstep, voffA);
            PG8_WAIT_L(8); PG8_BAR; PG8_WAIT_L(0); PG8_MMA(0, 0, At, B0); PG8_BAR; PG8_SCHED;
            PG8_LDB(B1, 1, 1); PG8_STAGE(PG8_SB(1, 0), b3, voffB);
            PG8_BAR; PG8_WAIT_L(0); PG8_MMA(0, 1, At, B1); PG8_BAR;
            PG8_LDA(At, 1, 1); PG8_STAGE(PG8_SA(1, 0), a3, voffA);
            PG8_BAR; PG8_WAIT_L(0); PG8_MMA(1, 0, At, B0); PG8_BAR; PG8_SCHED;
            PG8_STAGE(PG8_SB(1, 1), b3 + hstep, voffB);
            PG8_WAIT_V(6); PG8_BAR; PG8_MMA(1, 1, At, B1); PG8_BAR;
        }
        PG8_STAMP();
        if constexpr (!Epi::AFTER_DRAIN) { E(acc, cur, wr, wc, fr, fq); S.done(cur); }
        PG8_STAMP();
        if (!has_next) break;
#pragma unroll
        for (int a = 0; a < 2; ++a)
#pragma unroll
            for (int b = 0; b < 2; ++b)
#pragma unroll
                for (int m = 0; m < 4; ++m)
#pragma unroll
                    for (int n = 0; n < 2; ++n) acc[a][b][m][n] = (f32x4){0.f, 0.f, 0.f, 0.f};
        cur = nxt; cA = nA; cB = nB; ++ui;
    }
    PG8_WAIT_V(0);
    if (wr == 0) PG8_BAR;
    PG8_BAR;
    if constexpr (Epi::AFTER_DRAIN) { E.fused(acc, cur, wr, wc, fr, fq, lds, wid, lane); S.done(cur); }
    PG8_STAMP();
    if (STAMP && wid == 0) { stamps[lane] = lane < nts ? (((unsigned long long)(unsigned)ts_hi << 32) | (unsigned)ts_lo) : 0ull;
        if (lane == 62) stamps[62] = rt_entry; if (lane == 63) stamps[63] = (unsigned long long)wall_clock64(); }
#undef PG8_STAMP
#undef PG8_SA
#undef PG8_SB
#undef PG8_STAGE
#undef PG8_LDA
#undef PG8_LDB
#undef PG8_MMA
#undef PG8_WAIT_V
#undef PG8_WAIT_L
#undef PG8_BAR
#undef PG8_SCHED
}
}

#include <cstdio>
#include <ctime>
#include <cstdlib>
#include <cstring>
#include <cmath>
#include <vector>
#include <algorithm>

namespace cg = cooperative_groups;
using pg8::bf16_t; using pg8::bf16x8; using pg8::f32x4;
typedef _Float16 f16_t;
typedef short bf16x4 __attribute__((ext_vector_type(4)));
typedef unsigned u32x4 __attribute__((ext_vector_type(4)));
typedef unsigned u32x2 __attribute__((ext_vector_type(2)));
#define LAS __attribute__((address_space(3)))

#ifndef EN_RWKV
#define EN_RWKV 1
#endif
#ifndef EN_ATTN
#define EN_ATTN 1
#endif
#ifndef EN_S5
#define EN_S5 1
#endif
#ifndef EN_FFN
#define EN_FFN 1
#endif

constexpr int MTOK = 65536, SEQ = 8192;
constexpr int LDS_BYTES = 131072 + 512;
constexpr size_t WL_GU1 = 0, WL_D1 = WL_GU1 + 11534336, WL_IN = WL_D1 + 5767168, WL_OUT = WL_IN + 5767168, WL_GU2 = WL_OUT + 2097152,
                 WL_D2 = WL_GU2 + 11534336, WL_GLU = WL_D2 + 5767168, WL_W2 = WL_GLU + 262144, WL_A2 = WL_W2 + 98304, WL_G2 = WL_A2 + 98304, WL_SIZE = WL_G2 + 98304;
constexpr size_t WS_WB = 0, WS_XN = WS_WB + 2 * WL_SIZE, WS_BIG = WS_XN + 134217728, WS_LAM = WS_BIG + 369098752, WS_AA = WS_LAM + 100663296,
                 WS_GG = WS_AA + 100663296, WS_YY = WS_GG + 50331648, WS_YPRE = WS_YY + 100663296, WS_LSE = WS_YPRE + 33554432, WS_CB = WS_LSE + 1572864,
                 WS_S5E = WS_CB + 3145728, WS_CTR = WS_S5E + 8388608, WS_BAR = WS_CTR + 256, WS_END = WS_BAR + 16384;

struct Params { const float* in[35]; float* out; unsigned char* ws; };
struct Ctx { LAS const unsigned long long* tab; int wv; };
template <class T> __device__ __forceinline__ T* ldsptr(LAS const unsigned long long* tab, int i) {
    unsigned a_; asm volatile("s_mov_b32 %0, 0x20040" : "=s"(a_)); a_ += (unsigned)i * 8u;
    const unsigned long long v = *(LAS const unsigned long long*)a_; const unsigned lo = __builtin_amdgcn_readfirstlane((unsigned)v), hi = __builtin_amdgcn_readfirstlane((unsigned)(v >> 32));
    unsigned long long r = ((unsigned long long)hi << 32) | lo; asm volatile("" : "+s"(r));
    return (T*)(__attribute__((address_space(1))) T*)r; }
#define PWS (ldsptr<unsigned char>(p.tab, 36))
#define POUT (ldsptr<float>(p.tab, 35))
#define PIN(i) (ldsptr<const float>(p.tab, i))

__device__ __forceinline__ float bf2f(unsigned short b) { return __uint_as_float(((unsigned)b) << 16); }
typedef float f32v2_ __attribute__((ext_vector_type(2)));
typedef __bf16 bf16v2_ __attribute__((ext_vector_type(2)));
__device__ __forceinline__ unsigned pk2a(float lo, float hi) { return pg8::cvt_pk_bf16(lo, hi); }
__device__ __forceinline__ unsigned pk2(float lo, float hi) { return pg8::cvt_pk_bf16(lo, hi); }
#ifdef PK2_BUILTIN
__device__ __forceinline__ unsigned pk2m(float lo, float hi) { const f32v2_ f = {lo, hi}; const bf16v2_ r = __builtin_convertvector(f, bf16v2_); return __builtin_bit_cast(unsigned, r); }
#else
__device__ __forceinline__ unsigned pk2m(float lo, float hi) { return pg8::cvt_pk_bf16(lo, hi); }
#endif
#ifdef WT_STORES
__device__ __forceinline__ void wt8(void* p, unsigned long long v) { __hip_atomic_store((unsigned long long*)p, v, __ATOMIC_RELAXED, __HIP_MEMORY_SCOPE_AGENT); }
__device__ __forceinline__ void wt4(void* p, unsigned v) { __hip_atomic_store((unsigned*)p, v, __ATOMIC_RELAXED, __HIP_MEMORY_SCOPE_AGENT); }
__device__ __forceinline__ void wt2(void* p, unsigned short v) { __hip_atomic_store((unsigned short*)p, v, __ATOMIC_RELAXED, __HIP_MEMORY_SCOPE_AGENT); }
#else
__device__ __forceinline__ void wt8(void* p, unsigned long long v) { *(unsigned long long*)p = v; }
__device__ __forceinline__ void wt4(void* p, unsigned v) { *(unsigned*)p = v; }
__device__ __forceinline__ void wt2(void* p, unsigned short v) { *(unsigned short*)p = v; }
#endif
#if defined(WT_STORES) && defined(WT_ASM16)
__device__ __forceinline__ void wt16(void* p, uint4 v) {
    u32x4 d = {v.x, v.y, v.z, v.w};
    asm volatile("global_store_dwordx4 %0, %1, off sc1\n\ts_nop 1" :: "v"(p), "v"(d) : "memory"); }
#elif defined(WT_STORES)
__device__ __forceinline__ void wt16(void* p, uint4 v) {
    u32x4 d = {v.x, v.y, v.z, v.w}; __builtin_nontemporal_store(d, (u32x4*)p); }
#else
__device__ __forceinline__ void wt16(void* p, uint4 v) { *(uint4*)p = v; }
#endif
__device__ __forceinline__ void wt8u(void* p, uint2 v) { wt8(p, ((unsigned long long)v.y << 32) | v.x); }
__device__ __forceinline__ void wt16f(void* p, f32x4 v) { uint4 u; u.x = __float_as_uint(v[0]); u.y = __float_as_uint(v[1]); u.z = __float_as_uint(v[2]); u.w = __float_as_uint(v[3]); wt16(p, u); }
__device__ __forceinline__ float shx(float v, int o, int lane) { return __builtin_bit_cast(float, __builtin_amdgcn_ds_bpermute((lane ^ o) << 2, __builtin_bit_cast(int, v))); }
#define LAUNDER(x) asm volatile("" : "+v"(x))
__device__ __forceinline__ float dpp_ror_add(float x, const int ctrl_unused) { return x; }
#define DPP_ROR_ADD(x, N) ((x) + __builtin_bit_cast(float, __builtin_amdgcn_update_dpp(0, __builtin_bit_cast(int, (x)), 0x120 + (N), 0xf, 0xf, false)))
__device__ __forceinline__ float row16_sum(float x) {
    x = DPP_ROR_ADD(x, 8); x = DPP_ROR_ADD(x, 4); x = DPP_ROR_ADD(x, 2); x = DPP_ROR_ADD(x, 1); return x;
}
__device__ __forceinline__ float wave_sum(float v, int lane) {
    v = row16_sum(v); v += shx(v, 16, lane); v += shx(v, 32, lane); return v;
}
__device__ __forceinline__ float sigmoidf_(float x) { return __builtin_amdgcn_rcpf(1.f + __expf(-x)); }
__device__ __forceinline__ float tanhf_(float x) { const float e = __expf(2.f * x); return 1.f - 2.f * __builtin_amdgcn_rcpf(e + 1.f); }
__device__ __forceinline__ f32x4 mfma16(bf16x8 a, bf16x8 b, f32x4 c) { return __builtin_amdgcn_mfma_f32_16x16x32_bf16(a, b, c, 0, 0, 0); }

template <class F> __device__ __forceinline__ void prep_t(const Ctx& p, LAS unsigned char* lds, bf16_t* dst, int N, int K, F rowp) {
    LAS float* T = (LAS float*)lds;
    const int tid = TIDX, ntn = N >> 6, ntk = K >> 6, total = ntn * ntk;
    for (int t = BIDX; t < total; t += GDIM) {
        const int n0 = (t % ntn) << 6, k0 = (t / ntn) << 6;
        __syncthreads();
        { const int k = tid >> 3, c8 = (tid & 7) << 3; const float* s = rowp(n0, k0 + k) + c8;
          const f32x4 a = *(const f32x4*)s, c = *(const f32x4*)(s + 4);
#pragma unroll
          for (int e = 0; e < 4; ++e) { T[k * 65 + c8 + e] = a[e]; T[k * 65 + c8 + 4 + e] = c[e]; } }
        __syncthreads();
        { const int n = tid >> 3, k8 = (tid & 7) << 3; float v[8];
#pragma unroll
          for (int e = 0; e < 8; ++e) v[e] = T[(k8 + e) * 65 + n];
          uint4 o; o.x = pk2a(v[0], v[1]); o.y = pk2a(v[2], v[3]); o.z = pk2a(v[4], v[5]); o.w = pk2a(v[6], v[7]);
          wt16(dst + (size_t)(n0 + n) * K + k0 + k8, o); }
    }
}
__device__ __forceinline__ void weights_phase(const Ctx& p, LAS unsigned char* lds) {
    for (int l = 0; l < 2; ++l) {
        unsigned char* wl = PWS + WS_WB + (size_t)l * WL_SIZE;
        for (int f = 0; f < 2; ++f) {
            const float* wg = PIN(f ? 31 : 2) + (size_t)l * 1024 * 2816; const float* wu = PIN(f ? 32 : 3) + (size_t)l * 1024 * 2816; const float* wd = PIN(f ? 33 : 4) + (size_t)l * 2816 * 1024;
            prep_t(p, lds, (bf16_t*)(wl + (f ? WL_GU2 : WL_GU1)), 5632, 1024, [=](int n0, int k) { const int t = n0 >> 8, i = n0 & 255; return ((i < 128) ? wg + t * 128 + i : wu + t * 128 + i - 128) + (size_t)k * 2816; });
            prep_t(p, lds, (bf16_t*)(wl + (f ? WL_D2 : WL_D1)), 1024, 2816, [=](int n0, int k) { return wd + (size_t)k * 1024 + n0; });
        }
        { const float* w = PIN(6) + (size_t)l * 1024 * 2816; prep_t(p, lds, (bf16_t*)(wl + WL_IN), 2816, 1024, [=](int n0, int k) { return w + (size_t)k * 2816 + n0; }); }
        { const float* w = PIN(7) + (size_t)l * 1024 * 1024; prep_t(p, lds, (bf16_t*)(wl + WL_OUT), 1024, 1024, [=](int n0, int k) { return w + (size_t)k * 1024 + n0; }); }
        { const float* w = PIN(28) + (size_t)l * 256 * 512; prep_t(p, lds, (bf16_t*)(wl + WL_GLU), 512, 256, [=](int n0, int k) { const int t = n0 >> 8, i = n0 & 255; return w + (size_t)k * 512 + ((i < 128) ? t * 128 + i : 256 + t * 128 + i - 128); }); }
        { const float* w = PIN(11) + (size_t)l * 2 * 64 * 384; prep_t(p, lds, (bf16_t*)(wl + WL_W2), 768, 64, [=](int n0, int k) { const int d = n0 / 384, c = n0 % 384; return w + (size_t)(d * 64 + k) * 384 + c; }); }
        { const float* w = PIN(13) + (size_t)l * 2 * 64 * 384; prep_t(p, lds, (bf16_t*)(wl + WL_A2), 768, 64, [=](int n0, int k) { const int d = n0 / 384, c = n0 % 384; return w + (size_t)(d * 64 + k) * 384 + c; }); }
        { const float* w = PIN(14) + (size_t)l * 128 * 384; prep_t(p, lds, (bf16_t*)(wl + WL_G2), 384, 128, [=](int n0, int k) { return w + (size_t)k * 384 + n0; }); }
    }
}

__device__ __forceinline__ void norm_phase(const Ctx& p, const float* hin, const float* g, bf16_t* xn, float* fout) {
    const int lane = TIDX & 63, wave = BIDX * 8 + (TIDX >> 6), nw = GDIM * 8;
    float4 gv[4];
#pragma unroll
    for (int i = 0; i < 4; ++i) gv[i] = *(const float4*)(g + lane * 4 + 256 * i);
    for (int row = wave; row < MTOK; row += nw) {
        const float* pr = hin + (size_t)row * 1024;
        float4 v[4]; float ss = 0.f;
#pragma unroll
        for (int i = 0; i < 4; ++i) { v[i] = *(const float4*)(pr + lane * 4 + 256 * i); ss += v[i].x * v[i].x + v[i].y * v[i].y + v[i].z * v[i].z + v[i].w * v[i].w; }
        ss = wave_sum(ss, lane);
        const float rs = rsqrtf(ss * (1.f / 1024.f) + 1e-6f);
        if (xn) {
#pragma unroll
            for (int i = 0; i < 4; ++i) { uint2 o; o.x = pk2a(v[i].x * rs * gv[i].x, v[i].y * rs * gv[i].y); o.y = pk2a(v[i].z * rs * gv[i].z, v[i].w * rs * gv[i].w); wt8u(xn + (size_t)row * 1024 + lane * 4 + 256 * i, o); }
        } else {
#pragma unroll
            for (int i = 0; i < 4; ++i) { float4 o; o.x = v[i].x * rs * gv[i].x; o.y = v[i].y * rs * gv[i].y; o.z = v[i].z * rs * gv[i].z; o.w = v[i].w * rs * gv[i].w; wt16f(fout + (size_t)row * 1024 + lane * 4 + 256 * i, (f32x4){o.x, o.y, o.z, o.w}); }
        }
    }
}

struct EpiSwiGLU { int wv; static constexpr bool PERM = true, AFTER_DRAIN = false; bf16_t* O;
    __device__ __forceinline__ void operator()(const f32x4 (&acc)[2][2][4][2], const pg8::Unit& u, int wr, int wc, int fr_, int fq_) const {
        const int ln_ = tid_from(wv) & 63, fr = ln_ & 15, fq = ln_ >> 4;
        const int row0 = u.pm * 256 + wr * 64 + fr, col0 = u.pn * 128 + wc * 32 + 8 * fq;
#pragma unroll
        for (int ai = 0; ai < 2; ++ai)
#pragma unroll
            for (int m = 0; m < 4; ++m) {
                float r[8];
#pragma unroll
                for (int n = 0; n < 2; ++n)
#pragma unroll
                    for (int j = 0; j < 4; ++j) { const float g = acc[ai][0][m][n][j], uu = acc[ai][1][m][n][j]; r[n * 4 + j] = g * sigmoidf_(g) * uu; }
                uint4 o; o.x = pk2a(r[0], r[1]); o.y = pk2a(r[2], r[3]); o.z = pk2a(r[4], r[5]); o.w = pk2a(r[6], r[7]);
                wt16(O + (size_t)(row0 + ai * 128 + m * 16) * 2816 + col0, o);
            }
    }
};
struct EpiResid { int wv; static constexpr bool PERM = false, AFTER_DRAIN = false; const float* hin; float* hout; float alpha;
    __device__ __forceinline__ void operator()(const f32x4 (&acc)[2][2][4][2], const pg8::Unit& u, int wr, int wc, int fr_, int fq_) const {
        const int ln_ = tid_from(wv) & 63, fr = ln_ & 15, fq = ln_ >> 4;
        const int row0 = u.pm * 256 + wr * 64 + fr, col0 = u.pn * 256 + wc * 32 + 4 * fq;
#pragma unroll
        for (int ai = 0; ai < 2; ++ai)
#pragma unroll
            for (int m = 0; m < 4; ++m) { const size_t ro = (size_t)(row0 + ai * 128 + m * 16) * 1024 + col0;
#pragma unroll
                for (int bj = 0; bj < 2; ++bj)
#pragma unroll
                    for (int n = 0; n < 2; ++n) { const f32x4 hv = *(const f32x4*)(hin + ro + bj * 128 + n * 16); wt16f(hout + ro + bj * 128 + n * 16, hv + alpha * acc[ai][bj][m][n]); } }
    }
};
struct EpiZ { int wv; static constexpr bool PERM = true, AFTER_DRAIN = false; bf16_t* O;
    __device__ __forceinline__ void operator()(const f32x4 (&acc)[2][2][4][2], const pg8::Unit& u, int wr, int wc, int fr_, int fq_) const {
        const int ln_ = tid_from(wv) & 63, fr = ln_ & 15, fq = ln_ >> 4;
        const int row0 = u.pm * 256 + wr * 64 + fr, col0 = u.pn * 256 + wc * 32 + 8 * fq;
#pragma unroll
        for (int ai = 0; ai < 2; ++ai)
#pragma unroll
            for (int m = 0; m < 4; ++m)
#pragma unroll
                for (int bj = 0; bj < 2; ++bj) { const f32x4 a = acc[ai][bj][m][0], b = acc[ai][bj][m][1];
                    uint4 o; o.x = pk2a(a[0], a[1]); o.y = pk2a(a[2], a[3]); o.z = pk2a(b[0], b[1]); o.w = pk2a(b[2], b[3]);
                    wt16(O + (size_t)(row0 + ai * 128 + m * 16) * 2816 + col0 + bj * 128, o); }
    }
};
struct EpiGLU { int wv; static constexpr bool PERM = true, AFTER_DRAIN = false; bf16_t* O; const float* bias;
    __device__ __forceinline__ void operator()(const f32x4 (&acc)[2][2][4][2], const pg8::Unit& u, int wr, int wc, int fr_, int fq_) const {
        const int ln_ = tid_from(wv) & 63, fr = ln_ & 15, fq = ln_ >> 4;
        const int row0 = u.pm * 256 + wr * 64 + fr, cw = u.pn * 128 + wc * 32 + 8 * fq;
        const f32x4 bv0 = *(const f32x4*)(bias + cw), bv1 = *(const f32x4*)(bias + cw + 4), bg0 = *(const f32x4*)(bias + 256 + cw), bg1 = *(const f32x4*)(bias + 256 + cw + 4);
#pragma unroll
        for (int ai = 0; ai < 2; ++ai)
#pragma unroll
            for (int m = 0; m < 4; ++m) {
                const f32x4 v0 = acc[ai][0][m][0] + bv0, v1 = acc[ai][0][m][1] + bv1, g0 = acc[ai][1][m][0] + bg0, g1 = acc[ai][1][m][1] + bg1;
                uint4 o; o.x = pk2a(v0[0] * sigmoidf_(g0[0]), v0[1] * sigmoidf_(g0[1])); o.y = pk2a(v0[2] * sigmoidf_(g0[2]), v0[3] * sigmoidf_(g0[3]));
                o.z = pk2a(v1[0] * sigmoidf_(g1[0]), v1[1] * sigmoidf_(g1[1])); o.w = pk2a(v1[2] * sigmoidf_(g1[2]), v1[3] * sigmoidf_(g1[3]));
                wt16(O + (size_t)(row0 + ai * 128 + m * 16) * 1024 + 768 + cw, o);
            }
    }
};
template <class Epi> __device__ __forceinline__ void gemm_run(const Ctx& p, LAS unsigned char* lds, const bf16_t* A, const bf16_t* Bt, int N, int K, const Epi& E) {
    asm volatile("" : "+s"(N), "+s"(K));
    pg8::Gemm g; g.A = A; g.Bt = Bt; g.M = MTOK; g.N = N; g.K = K;
    pg8::StaticOrder S; S.init(MTOK, N, (int)GDIM, (int)BIDX);
    pg8::gemm_phase<Epi, pg8::StaticOrder, false>(lds, g, S, E, nullptr, TIDX);
}

__device__ __forceinline__ void rwkv_prep_phase(const Ctx& p, int l) {
    const bf16_t* z = (const bf16_t*)(PWS + WS_BIG);
    const unsigned char* wl = PWS + WS_WB + (size_t)l * WL_SIZE;
    const bf16_t* w2t = (const bf16_t*)(wl + WL_W2); const bf16_t* a2t = (const bf16_t*)(wl + WL_A2); const bf16_t* g2t = (const bf16_t*)(wl + WL_G2);
    const float* mup = PIN(8) + l * 1408; const float* mun = PIN(9) + l * 1408;
    const float* w0 = PIN(10) + l * 768; const float* a0 = PIN(12) + l * 768;
    f16_t* lam = (f16_t*)(PWS + WS_LAM); f16_t* aa = (f16_t*)(PWS + WS_AA); f16_t* gg = (f16_t*)(PWS + WS_GG);
    const int lane = TIDX & 63, fr = lane & 15, fq = lane >> 4;
    const int gw = BIDX * 8 + (TIDX >> 6), nw = GDIM * 8;
    for (int it = gw; it < MTOK / 32; it += nw) {
        const int m0 = it * 32;
        bf16x8 A[2][8];
#pragma unroll
        for (int sub = 0; sub < 2; ++sub) {
            const int tok = m0 + sub * 16 + fr, t = tok & (SEQ - 1);
            const bf16_t* zc = z + (size_t)tok * 2816;
            const bf16_t* zp = (t > 0) ? zc - 2816 : zc; const bf16_t* zn = (t < SEQ - 1) ? zc + 2816 : zc;
            const float fp = (t > 0) ? 1.f : 0.f, fn = (t < SEQ - 1) ? 1.f : 0.f;
#pragma unroll
            for (int ks = 0; ks < 8; ++ks) {
                const int col = 1152 + ks * 32 + fq * 8;
                const bf16x8 c8 = *(const bf16x8*)(zc + col), p8 = *(const bf16x8*)(zp + col), n8 = *(const bf16x8*)(zn + col);
#ifdef VEC_MU
                const f32x4 mpa = *(const f32x4*)(mup + col), mpb = *(const f32x4*)(mup + col + 4), mna = *(const f32x4*)(mun + col), mnb = *(const f32x4*)(mun + col + 4);
#endif
                float r[8];
#pragma unroll
                for (int e = 0; e < 8; ++e) {
                    const float x = bf2f((unsigned short)c8[e]), xp = fp * bf2f((unsigned short)p8[e]), xn = fn * bf2f((unsigned short)n8[e]);
#ifdef VEC_MU
                    const float xm = x + (e < 4 ? mpa[e & 3] : mpb[e & 3]) * (xp - x) + (e < 4 ? mna[e & 3] : mnb[e & 3]) * (xn - x);
#else
                    const float xm = x + mup[col + e] * (xp - x) + mun[col + e] * (xn - x);
#endif
                    r[e] = (ks < 2) ? tanhf_(xm) : ((ks < 4) ? xm : sigmoidf_(xm));
                }
                union { uint4 u; bf16x8 v; } cv; cv.u.x = pk2(r[0], r[1]); cv.u.y = pk2(r[2], r[3]); cv.u.z = pk2(r[4], r[5]); cv.u.w = pk2(r[6], r[7]);
                A[sub][ks] = cv.v;
            }
        }
#pragma unroll 1
        for (int nt = 0; nt < 48; ++nt) {
            const bf16x8 b0 = *(const bf16x8*)(w2t + (nt * 16 + fr) * 64 + fq * 8), b1 = *(const bf16x8*)(w2t + (nt * 16 + fr) * 64 + 32 + fq * 8);
            const bf16x8 c0 = *(const bf16x8*)(a2t + (nt * 16 + fr) * 64 + fq * 8), c1 = *(const bf16x8*)(a2t + (nt * 16 + fr) * 64 + 32 + fq * 8);
            const int n0 = nt * 16 + fq * 4;
            const f32x4 w0v = *(const f32x4*)(w0 + n0), a0v = *(const f32x4*)(a0 + n0);
#pragma unroll
            for (int sub = 0; sub < 2; ++sub) {
                const int tok = m0 + sub * 16 + fr;
                f32x4 acc = {0.f, 0.f, 0.f, 0.f}; acc = mfma16(b0, A[sub][0], acc); acc = mfma16(b1, A[sub][1], acc);
                f32x4 aca = {0.f, 0.f, 0.f, 0.f}; aca = mfma16(c0, A[sub][2], aca); aca = mfma16(c1, A[sub][3], aca);
                union { f16_t h[4]; uint2 u; } o1, o2;
#pragma unroll
                for (int j = 0; j < 4; ++j) { o1.h[j] = (f16_t)(0.60653066f * sigmoidf_(w0v[j] + acc[j])); o2.h[j] = (f16_t)sigmoidf_(a0v[j] + aca[j]); }
                wt8u(lam + (size_t)tok * 768 + n0, o1.u); wt8u(aa + (size_t)tok * 768 + n0, o2.u);
            }
        }
#pragma unroll 1
        for (int nt = 0; nt < 24; ++nt) {
            bf16x8 bb[4];
#pragma unroll
            for (int ks = 0; ks < 4; ++ks) bb[ks] = *(const bf16x8*)(g2t + (nt * 16 + fr) * 128 + ks * 32 + fq * 8);
            const int n0 = nt * 16 + fq * 4;
#pragma unroll
            for (int sub = 0; sub < 2; ++sub) {
                const int tok = m0 + sub * 16 + fr;
                f32x4 acc = {0.f, 0.f, 0.f, 0.f};
#pragma unroll
                for (int ks = 0; ks < 4; ++ks) acc = mfma16(bb[ks], A[sub][4 + ks], acc);
                union { f16_t h[4]; uint2 u; } o1;
#pragma unroll
                for (int j = 0; j < 4; ++j) o1.h[j] = (f16_t)acc[j];
                wt8u(gg + (size_t)tok * 384 + n0, o1.u);
            }
        }
    }
}

typedef float f32x2_ __attribute__((ext_vector_type(2)));
struct S5Lane { float lbr, lbi; f32x2_ b2[16]; };
__device__ __forceinline__ void s5_lane_params(const Ctx& p, int l, int d, int g, int pp, S5Lane& q) {
    const int idx = ((l * 2 + d) * 16 + g) * 64 + pp;
    const float are = PIN(20)[idx], aim = PIN(21)[idx], st = __expf(PIN(22)[(l * 2 + d) * 16 + g]);
    const float er = __expf(are * st), ang = aim * st;
    const float kf = rintf(ang * 0.15915494309f); float rr = fmaf(-kf, 6.2831855f, ang); rr = fmaf(-kf, -1.7484555e-7f, rr);
    float sn, cs; __sincosf(rr, &sn, &cs);
    q.lbr = er * cs; q.lbi = er * sn;
    const float nr = q.lbr - 1.f, ni = q.lbi, den = __builtin_amdgcn_rcpf(are * are + aim * aim);
    const float zr = (nr * are + ni * aim) * den, zi = (ni * are - nr * aim) * den;
    const float* br = PIN(23) + ((size_t)(l * 16 + g) * 64 + pp) * 16; const float* bi = PIN(24) + ((size_t)(l * 16 + g) * 64 + pp) * 16;
#pragma unroll
    for (int c = 0; c < 16; ++c) { const float x = br[c], y = bi[c]; q.b2[c] = (f32x2_){zr * x - zi * y, zr * y + zi * x}; }
}
__device__ __forceinline__ void s5_stage_u(const Ctx& p, int b, int c, int gq, LAS float* uf) {
    const bf16_t* z = (const bf16_t*)(PWS + WS_BIG);
#pragma unroll
    for (int i = 0; i < 2; ++i) {
        const int e = TIDX + 512 * i, t = e >> 3, part = e & 7;
        const bf16x8 v = *(const bf16x8*)(z + (size_t)(b * SEQ + c * 128 + t) * 2816 + 2560 + gq * 64 + part * 8);
#pragma unroll
        for (int k = 0; k < 8; ++k) uf[t * 64 + part * 8 + k] = bf2f((unsigned short)v[k]);
    }
}
__device__ __forceinline__ void s5_step(const S5Lane& q, const LAS float* urow, float& hr, float& hi) {
    f32x2_ bu0 = {0.f, 0.f}, bu1 = {0.f, 0.f};
#pragma unroll
    for (int c4 = 0; c4 < 4; ++c4) { const f32x4 u = *(const LAS f32x4*)(urow + c4 * 4);
        bu0 += q.b2[c4 * 4 + 0] * (f32x2_){u[0], u[0]}; bu1 += q.b2[c4 * 4 + 1] * (f32x2_){u[1], u[1]};
        bu0 += q.b2[c4 * 4 + 2] * (f32x2_){u[2], u[2]}; bu1 += q.b2[c4 * 4 + 3] * (f32x2_){u[3], u[3]}; }
    const f32x2_ bu = bu0 + bu1;
    const float nr = q.lbr * hr - q.lbi * hi + bu[0], ni = q.lbr * hi + q.lbi * hr + bu[1]; hr = nr; hi = ni;
}
__device__ __forceinline__ void s5_passA_item(const Ctx& p, int l, int item, LAS unsigned char* lds) {
    const int gq = item & 3, c = (item >> 2) & 63, b = item >> 8;
    const int wid = TIDX >> 6, lane = TIDX & 63, gi = wid >> 1, d = wid & 1, g = gq * 4 + gi;
    LAS float* uf = (LAS float*)lds;
    __syncthreads();
    s5_stage_u(p, b, c, gq, uf);
    S5Lane q; s5_lane_params(p, l, d, g, lane, q);
    __syncthreads();
    float hr = 0.f, hi = 0.f;
    for (int s = 0; s < 128; ++s) { const int ti = d ? 127 - s : s; s5_step(q, uf + ti * 64 + gi * 16, hr, hi); }
    float2* E = (float2*)(PWS + WS_S5E);
    wt8(&E[((size_t)((b * 16 + g) * 2 + d) * 64 + c) * 64 + lane], ((unsigned long long)__float_as_uint(hi) << 32) | __float_as_uint(hr));
}
__device__ __forceinline__ void s5_passC_item(const Ctx& p, int l, int item, LAS unsigned char* lds) {
    const int gq = item & 3, c = (item >> 2) & 63, b = item >> 8;
    const int tid = TIDX, wid = tid >> 6, lane = tid & 63, gi = wid >> 1, d = wid & 1, g = gq * 4 + gi, fr = lane & 15, fq = lane >> 4;
    LAS float* uf = (LAS float*)lds;
    LAS bf16_t* hs = (LAS bf16_t*)(lds + 32768) + wid * 16 * 136;
    LAS float* yl = (LAS float*)(lds + 32768 + 34816);
    __syncthreads();
    s5_stage_u(p, b, c, gq, uf);
    S5Lane q; s5_lane_params(p, l, d, g, lane, q);
    bf16x8 Cf[4];
    {
        const float* cre = PIN(25) + ((size_t)((l * 2 + d) * 16 + g) * 16 + fr) * 64; const float* cim = PIN(26) + ((size_t)((l * 2 + d) * 16 + g) * 16 + fr) * 64;
#pragma unroll
        for (int ks = 0; ks < 4; ++ks) { const int q0 = ks * 32 + fq * 8; float r[8];
#pragma unroll
            for (int e = 0; e < 8; ++e) r[e] = (q0 < 64) ? cre[q0 + e] : -cim[q0 - 64 + e];
            union { uint4 u; bf16x8 v; } cv; cv.u.x = pk2(r[0], r[1]); cv.u.y = pk2(r[2], r[3]); cv.u.z = pk2(r[4], r[5]); cv.u.w = pk2(r[6], r[7]); Cf[ks] = cv.v; }
    }
    float hr = 0.f, hi = 0.f;
    {
        float tr = q.lbr, ti = q.lbi;
#pragma unroll
        for (int k = 0; k < 7; ++k) { const float a = tr * tr - ti * ti, bq = 2.f * tr * ti; tr = a; ti = bq; }
        const float2* E = (const float2*)(PWS + WS_S5E) + ((size_t)((b * 16 + g) * 2 + d) * 64) * 64 + lane;
        if (d == 0) { for (int cc = 0; cc < c; ++cc) { const float2 e = E[(size_t)cc * 64]; const float nr = tr * hr - ti * hi + e.x, ni = tr * hi + ti * hr + e.y; hr = nr; hi = ni; } }
        else { for (int cc = 63; cc > c; --cc) { const float2 e = E[(size_t)cc * 64]; const float nr = tr * hr - ti * hi + e.x, ni = tr * hi + ti * hr + e.y; hr = nr; hi = ni; } }
    }
    __syncthreads();
    {
        const float* dsk = PIN(27) + l * 256 + gq * 64;
        for (int e = tid; e < 128 * 64; e += 512) { const int t = e >> 6, ch = e & 63; yl[((ch >> 4) * 128 + t) * 17 + (ch & 15)] = dsk[ch] * uf[e]; }
    }
    for (int sub = 0; sub < 8; ++sub) {
        for (int s16 = 0; s16 < 16; ++s16) {
            const int s = sub * 16 + s16, ti = d ? 127 - s : s;
            s5_step(q, uf + ti * 64 + gi * 16, hr, hi);
            const unsigned pk = pk2(hr, hi);
            hs[(ti & 15) * 136 + lane] = (bf16_t)(pk & 0xffffu); hs[(ti & 15) * 136 + 64 + lane] = (bf16_t)(pk >> 16);
        }
        __syncthreads();
        {
            f32x4 acc = {0.f, 0.f, 0.f, 0.f};
#pragma unroll
            for (int ks = 0; ks < 4; ++ks) { const bf16x8 af = *(const LAS bf16x8*)(hs + fr * 136 + ks * 32 + fq * 8); acc = mfma16(Cf[ks], af, acc); }
            const int tile = d ? 7 - sub : sub;
            LAS float* yp = yl + (gi * 128 + tile * 16 + fr) * 17 + fq * 4;
#pragma unroll
            for (int j = 0; j < 4; ++j) yp[j] += acc[j];
        }
        __syncthreads();
    }
    {
        bf16_t* yo = (bf16_t*)(PWS + WS_YPRE);
        const int t = tid >> 2, g4 = tid & 3;
        float r[16];
#pragma unroll
        for (int k = 0; k < 16; ++k) { const float x = yl[(g4 * 128 + t) * 17 + k]; r[k] = 0.5f * x * (1.f + tanhf_(0.7978845608f * (x + 0.044715f * x * x * x))); }
        uint4 o0, o1; o0.x = pk2(r[0], r[1]); o0.y = pk2(r[2], r[3]); o0.z = pk2(r[4], r[5]); o0.w = pk2(r[6], r[7]); o1.x = pk2(r[8], r[9]); o1.y = pk2(r[10], r[11]); o1.z = pk2(r[12], r[13]); o1.w = pk2(r[14], r[15]);
        bf16_t* dst = yo + (size_t)(b * SEQ + c * 128 + t) * 256 + gq * 64 + g4 * 16;
        wt16(dst, o0); wt16(dst + 8, o1);
    }
}

constexpr int SC_T = 32, SC_ROW = 352;
struct ScanRaw { unsigned zr[10], zk[10], zv[10], ar[8], lr[8]; };
__device__ __forceinline__ void scan_load_raw(ScanRaw& R, const bf16_t* zb, const unsigned short* ab, const unsigned short* lb, int tlo, int h, int hf, int d, int lane) {
#pragma unroll
    for (int r = 0; r < 10; ++r) {
        int tok = tlo - 1 + r; tok = tok < 0 ? 0 : (tok > SEQ - 1 ? SEQ - 1 : tok);
        const bf16_t* zp = zb + (size_t)tok * 2816 + h * 64;
        R.zr[r] = zp[lane]; R.zk[r] = zp[384 + lane]; R.zv[r] = zp[768 + hf * 32 + (lane & 31)];
    }
#pragma unroll
    for (int i = 0; i < 8; ++i) { const size_t o = (size_t)(tlo + i) * 768 + d * 384 + h * 64 + lane; R.ar[i] = ab[o]; R.lr[i] = lb[o]; }
}
__device__ __forceinline__ float row16_sum_asm(float x) {
    asm volatile("s_nop 1\n\tv_add_f32_dpp %0, %0, %0 row_ror:8 row_mask:0xf bank_mask:0xf\n\ts_nop 1\n\tv_add_f32_dpp %0, %0, %0 row_ror:4 row_mask:0xf bank_mask:0xf\n\ts_nop 1\n\tv_add_f32_dpp %0, %0, %0 row_ror:2 row_mask:0xf bank_mask:0xf\n\ts_nop 1\n\tv_add_f32_dpp %0, %0, %0 row_ror:1 row_mask:0xf bank_mask:0xf" : "+v"(x));
    return x; }
#define DPP_ADD(x, CTRL) ((x) + __builtin_bit_cast(float, __builtin_amdgcn_update_dpp(0, __builtin_bit_cast(int, (x)), (CTRL), 0xf, 0xf, false)))
__device__ __forceinline__ float red8(float x) {
    x = DPP_ADD(x, 0x141); x = DPP_ADD(x, 0x1B); x = DPP_ADD(x, 0xB1); return x;
}
__device__ __forceinline__ float dot4(f32x4 a, f32x4 b) { return a[0] * b[0] + a[1] * b[1] + a[2] * b[2] + a[3] * b[3]; }
typedef float f32p __attribute__((ext_vector_type(2)));
__device__ __forceinline__ float dot8(f32x4 sa, f32x4 sb, f32x4 a, f32x4 b) {
    f32p acc = __builtin_shufflevector(sa, sa, 0, 1) * __builtin_shufflevector(a, a, 0, 1);
    acc += __builtin_shufflevector(sa, sa, 2, 3) * __builtin_shufflevector(a, a, 2, 3);
    acc += __builtin_shufflevector(sb, sb, 0, 1) * __builtin_shufflevector(b, b, 0, 1);
    acc += __builtin_shufflevector(sb, sb, 2, 3) * __builtin_shufflevector(b, b, 2, 3);
    return acc[0] + acc[1];
}
__device__ __forceinline__ float f16bits2f(unsigned u) { union { unsigned short s; f16_t h; } c; c.s = (unsigned short)u; return (float)c.h; }
__device__ __forceinline__ void rwkv_scan_item(const Ctx& p, int l, int item, LAS unsigned char* lds) {
    const int chain = item >> 1, hf = item & 1, d = chain & 1, h = (chain >> 1) % 6, b = chain / 12;
    const int tid = TIDX, wid = __builtin_amdgcn_readfirstlane(tid >> 6), lane = tid & 63;
    LAS float* buf = (LAS float*)lds;
    const bf16_t* zb = (const bf16_t*)(PWS + WS_BIG) + (size_t)b * SEQ * 2816;
    __syncthreads();
    if (wid < 4) {
        const int j = lane & 7, rg = lane >> 3, row = wid * 8 + rg;
        bf16_t* yy = (bf16_t*)(PWS + WS_YY) + ((size_t)(((d * 8 + b) * 6 + h) * 2 + hf) * SEQ) * 32 + row;
        f32x4 Sa = {0.f, 0.f, 0.f, 0.f}, Sb = Sa; float ys = 0.f;
        __builtin_amdgcn_s_setprio(3);
        for (int c = 0; c < SEQ / SC_T; ++c) {
            __syncthreads();
            const LAS float* bb = buf + (c & 1) * SC_T * SC_ROW + 8 * j;
            const LAS float* vb = buf + (c & 1) * SC_T * SC_ROW + 320 + row;
            struct Ops { f32x4 wa, wb, na, nb, aa, ab, da, db, ra, rb; float v; };
            auto ld = [&](Ops& o, int s) {
                const LAS float* st = bb + s * SC_ROW;
                o.wa = *(const LAS f32x4*)(st); o.wb = *(const LAS f32x4*)(st + 4); o.na = *(const LAS f32x4*)(st + 64); o.nb = *(const LAS f32x4*)(st + 68); o.aa = *(const LAS f32x4*)(st + 128); o.ab = *(const LAS f32x4*)(st + 132);
                o.da = *(const LAS f32x4*)(st + 192); o.db = *(const LAS f32x4*)(st + 196); o.ra = *(const LAS f32x4*)(st + 256); o.rb = *(const LAS f32x4*)(st + 260);
                o.v = vb[s * SC_ROW];
            };
            auto stepf = [&](const Ops& o, int s) {
                float sa = dot8(Sa, Sb, o.na, o.nb);
                const f32x4 ta = Sa * o.wa + o.v * o.da, tb = Sb * o.wb + o.v * o.db;
                sa = red8(sa);
                Sa = ta + sa * o.aa; Sb = tb + sa * o.ab;
                float y = dot8(Sa, Sb, o.ra, o.rb);
                y = red8(y);
                if (j == (s & 7)) ys = y;
                if ((s & 7) == 7) {
                    const int sidx = c * SC_T + (s & ~7) + j, t = d ? SEQ - 1 - sidx : sidx;
                    wt2(&yy[(size_t)t * 32], (unsigned short)(pk2(ys, 0.f) & 0xffffu));
                }
            };
            Ops A, B;
            ld(A, 0);
#pragma unroll 4
            for (int s = 0; s < SC_T; s += 2) {
                ld(B, s + 1);
                stepf(A, s);
                if (s + 2 < SC_T) ld(A, s + 2);
                stepf(B, s + 1);
            }
        }
        __builtin_amdgcn_s_setprio(0);
    } else {
        const int lw = wid - 4;
        const unsigned short* ab = (const unsigned short*)(PWS + WS_AA) + (size_t)b * SEQ * 768;
        const unsigned short* lb = (const unsigned short*)(PWS + WS_LAM) + (size_t)b * SEQ * 768;
        float* cb = (float*)(PWS + WS_CB);
        const float* mup = PIN(8) + l * 1408; const float* mun = PIN(9) + l * 1408;
        const int cr = h * 64 + lane, cv = 768 + h * 64 + hf * 32 + (lane & 31);
        const float mpr = mup[cr], mnr = mun[cr], mpk = mup[384 + cr], mnk = mun[384 + cr], mpv = mup[cv], mnv = mun[cv];
        const float kkc = PIN(15)[l * 384 + cr], kac = PIN(16)[l * 384 + cr], rkc = PIN(17)[l * 384 + cr];
        ScanRaw Rc, Rn;
        auto tlo_of = [&](int c) { const int s0 = c * SC_T + lw * 8; return d ? SEQ - 1 - (s0 + 7) : s0; };
        auto process = [&](const ScanRaw& R, int c) {
            const int tlo = tlo_of(c);
            LAS float* nb = buf + (c & 1) * SC_T * SC_ROW;
            float fr_[10], fk_[10], fv_[10];
#pragma unroll
            for (int r = 0; r < 10; ++r) { const int tok = tlo - 1 + r; const float ok = (tok >= 0 && tok < SEQ) ? 1.f : 0.f;
                fr_[r] = ok * bf2f((unsigned short)R.zr[r]); fk_[r] = ok * bf2f((unsigned short)R.zk[r]); fv_[r] = ok * bf2f((unsigned short)R.zv[r]); }
            float r_[8], k_[8], v_[8], a_[8], w_[8], kk_[8], kd_[8], ss_[8], cb_[8];
#pragma unroll
            for (int i = 0; i < 8; ++i) {
                r_[i] = fr_[i + 1] + mpr * (fr_[i] - fr_[i + 1]) + mnr * (fr_[i + 2] - fr_[i + 1]);
                k_[i] = fk_[i + 1] + mpk * (fk_[i] - fk_[i + 1]) + mnk * (fk_[i + 2] - fk_[i + 1]);
                v_[i] = fv_[i + 1] + mpv * (fv_[i] - fv_[i + 1]) + mnv * (fv_[i + 2] - fv_[i + 1]);
                a_[i] = f16bits2f(R.ar[i]); w_[i] = __expf(-f16bits2f(R.lr[i]));
                kk_[i] = k_[i] * kkc; kd_[i] = k_[i] * (1.f + (a_[i] - 1.f) * kac);
                ss_[i] = row16_sum(kk_[i] * kk_[i]); cb_[i] = (hf == 0) ? row16_sum(r_[i] * kd_[i] * rkc) : 0.f;
            }
            {
                float t1[8], t2[8];
#pragma unroll
                for (int i = 0; i < 8; ++i) { t1[i] = shx(ss_[i], 16, lane); if (hf == 0) t2[i] = shx(cb_[i], 16, lane); }
#pragma unroll
                for (int i = 0; i < 8; ++i) { ss_[i] += t1[i]; if (hf == 0) cb_[i] += t2[i]; }
#pragma unroll
                for (int i = 0; i < 8; ++i) { t1[i] = shx(ss_[i], 32, lane); if (hf == 0) t2[i] = shx(cb_[i], 32, lane); }
#pragma unroll
                for (int i = 0; i < 8; ++i) { ss_[i] += t1[i]; if (hf == 0) cb_[i] += t2[i]; }
            }
#pragma unroll
            for (int i = 0; i < 8; ++i) {
                const float kh = kk_[i] * rsqrtf(ss_[i] + 1e-12f);
                const int slot = lw * 8 + (d ? 7 - i : i);
                LAS float* st = nb + slot * SC_ROW;
                st[lane] = w_[i]; st[64 + lane] = -kh; st[128 + lane] = kh * a_[i]; st[192 + lane] = kd_[i]; st[256 + lane] = r_[i]; if (lane < 32) st[320 + lane] = v_[i];
                if (hf == 0 && lane == 0) wt4(&cb[(size_t)((d * 8 + b) * 6 + h) * SEQ + tlo + i], __float_as_uint(cb_[i]));
            }
        };
        scan_load_raw(Rc, zb, ab, lb, tlo_of(0), h, hf, d, lane);
        scan_load_raw(Rn, zb, ab, lb, tlo_of(1), h, hf, d, lane);
        process(Rc, 0);
        for (int c = 0; c < SEQ / SC_T; ++c) {
            __syncthreads();
            if (c + 1 < SEQ / SC_T) {
                Rc = Rn;
                if (c + 2 < SEQ / SC_T) scan_load_raw(Rn, zb, ab, lb, tlo_of(c + 2), h, hf, d, lane);
                process(Rc, c + 1);
            }
        }
    }
}

__device__ __forceinline__ void rwkv_post_phase(const Ctx& p, int l) {
    const bf16_t* z = (const bf16_t*)(PWS + WS_BIG); const bf16_t* yy = (const bf16_t*)(PWS + WS_YY);
    const unsigned short* gg = (const unsigned short*)(PWS + WS_GG); const float* cb = (const float*)(PWS + WS_CB);
    bf16_t* O = (bf16_t*)(PWS + WS_XN);
    const float* mup = PIN(8) + l * 1408 + 768; const float* mun = PIN(9) + l * 1408 + 768;
    const float* lw_ = PIN(18) + l * 384; const float* lb_ = PIN(19) + l * 384;
    const int lane = TIDX & 63, gw = BIDX * 8 + (TIDX >> 6), nw = GDIM * 8;
    float mp_[6], mn_[6], lwv[6], lbv[6];
#pragma unroll
    for (int h = 0; h < 6; ++h) { mp_[h] = mup[h * 64 + lane]; mn_[h] = mun[h * 64 + lane]; lwv[h] = lw_[h * 64 + lane]; lbv[h] = lb_[h * 64 + lane]; }
    for (int tok = gw; tok < MTOK; tok += nw) {
        const int t = tok & (SEQ - 1), bb_ = tok >> 13;
        float y[6], vc[6], vp[6], vn[6], c0[6], c1[6], gv[6];
#pragma unroll
        for (int h = 0; h < 6; ++h) {
            const int col = h * 64 + lane;
            const size_t yo = ((size_t)((bb_ * 6 + h) * 2 + (lane >> 5)) * SEQ + t) * 32 + (lane & 31);
            y[h] = bf2f(yy[yo]) + bf2f(yy[yo + (size_t)8 * 6 * 2 * SEQ * 32]);
            const bf16_t* zc = z + (size_t)tok * 2816 + 768 + col;
            vc[h] = bf2f(zc[0]); vp[h] = (t > 0) ? bf2f(zc[-2816]) : 0.f; vn[h] = (t < SEQ - 1) ? bf2f(zc[2816]) : 0.f;
            c0[h] = cb[(size_t)(bb_ * 6 + h) * SEQ + t]; c1[h] = cb[(size_t)((8 + bb_) * 6 + h) * SEQ + t];
            gv[h] = f16bits2f(gg[(size_t)tok * 384 + col]);
        }
        float m_[6], q_[6], t_[6];
#pragma unroll
        for (int h = 0; h < 6; ++h) m_[h] = row16_sum(y[h]);
#pragma unroll
        for (int h = 0; h < 6; ++h) t_[h] = shx(m_[h], 16, lane);
#pragma unroll
        for (int h = 0; h < 6; ++h) m_[h] += t_[h];
#pragma unroll
        for (int h = 0; h < 6; ++h) t_[h] = shx(m_[h], 32, lane);
#pragma unroll
        for (int h = 0; h < 6; ++h) { m_[h] = (m_[h] + t_[h]) * (1.f / 64.f); const float dv = y[h] - m_[h]; q_[h] = row16_sum(dv * dv); }
#pragma unroll
        for (int h = 0; h < 6; ++h) t_[h] = shx(q_[h], 16, lane);
#pragma unroll
        for (int h = 0; h < 6; ++h) q_[h] += t_[h];
#pragma unroll
        for (int h = 0; h < 6; ++h) t_[h] = shx(q_[h], 32, lane);
#pragma unroll
        for (int h = 0; h < 6; ++h) q_[h] = (q_[h] + t_[h]) * (1.f / 64.f);
#pragma unroll
        for (int h = 0; h < 6; ++h) {
            const float dv = y[h] - m_[h], var = q_[h];
            const float yn = dv * rsqrtf(var + 64e-5f);
            const float v = vc[h] + mp_[h] * (vp[h] - vc[h]) + mn_[h] * (vn[h] - vc[h]);
            const float o = (yn * lwv[h] + lbv[h] + (c0[h] + c1[h]) * v) * gv[h];
            const unsigned ob = pk2(o, 0.f);
            wt2(&O[(size_t)tok * 1024 + h * 64 + lane], (unsigned short)(ob & 0xffffu));
        }
    }
}

struct AttnPre { u32x4 k[6]; u32x4 v[6]; bf16x8 q[2]; };
__device__ __forceinline__ void attn_issue(AttnPre& P, const bf16_t* zb, int h, int sp, int step, int tid, int lane) {
    const int pi = step >> 3, rnd = step & 7, dsh = 2 * pi, dm1 = (1 << dsh) - 1, n = SEQ >> dsh;
    int tt = tid & 255; LAUNDER(tt);
    const int s = tid >> 8, uidx = rnd * 2 + s, r = uidx & dm1, lb = uidx >> dsh, i = sp * (16 >> dsh) + lb, jbase = 64 * (i - 1);
#pragma unroll
    for (int it = 0; it < 6; ++it) {
        const int cid = tt + 256 * it, row = cid >> 3, part = cid & 7, jj = jbase + row; const bool ok = (jj >= 0 && jj < n);
        u32x4 v = {0u, 0u, 0u, 0u};
        if (ok) v = *(const u32x4*)(zb + (size_t)(r + (jj << dsh)) * 2816 + 1792 + h * 64 + part * 8);
        P.k[it] = v;
    }
#pragma unroll
    for (int it = 0; it < 3; ++it) {
        const int cid = tt + 256 * it, rp = cid % 96, part = cid / 96;
#pragma unroll
        for (int hh = 0; hh < 2; ++hh) { const int jj = jbase + 2 * rp + hh; const bool ok = (jj >= 0 && jj < n);
            u32x4 v = {0u, 0u, 0u, 0u};
            if (ok) v = *(const u32x4*)(zb + (size_t)(r + (jj << dsh)) * 2816 + 2176 + h * 64 + part * 8);
            P.v[it * 2 + hh] = v; }
    }
    {
        const int wid = tid >> 6, sl = wid >> 2, wq = wid & 3, fr = lane & 15, fq = lane >> 4;
        const int u2 = rnd * 2 + sl, r2 = u2 & dm1, lb2 = u2 >> dsh, i2 = sp * (16 >> dsh) + lb2, posq = r2 + ((64 * i2 + wq * 16 + fr) << dsh);
#pragma unroll
        for (int ks = 0; ks < 2; ++ks) P.q[ks] = *(const bf16x8*)(zb + (size_t)posq * 2816 + 1408 + h * 64 + ks * 32 + fq * 8);
    }
}
__device__ __forceinline__ void attn_item(const Ctx& p, int item, LAS unsigned char* lds) {
    const int sp = item & 7, h = (item >> 3) % 6, b = item / 48;
    const int tid = TIDX, wid = tid >> 6, lane = tid & 63, sl = wid >> 2, wq = wid & 3;
    LAS bf16_t* Ks = (LAS bf16_t*)lds;
    LAS bf16_t* Vt = Ks + 2 * 192 * 80;
    const bf16_t* zb = (const bf16_t*)(PWS + WS_BIG) + (size_t)b * SEQ * 2816;
    bf16_t* O = (bf16_t*)(PWS + WS_XN); float* lsebuf = (float*)(PWS + WS_LSE);
    const float slope = (h == 0) ? 0.25f : (h == 1) ? 0.0625f : (h == 2) ? 0.015625f : (h == 3) ? 0.00390625f : (h == 4) ? 0.5f : 0.125f;
    AttnPre P;
    attn_issue(P, zb, h, sp, 0, tid, lane);
#pragma unroll 1
    for (int step = 0; step < 24; ++step) {
        const int pi = step >> 3, rnd = step & 7, dsh = 2 * pi, dm1 = (1 << dsh) - 1, n = SEQ >> dsh;
        __syncthreads();
        {
            int tt = tid & 255; LAUNDER(tt);
            const int s = tid >> 8;
#pragma unroll
            for (int it = 0; it < 6; ++it) { const int cid = tt + 256 * it, row = cid >> 3, part = cid & 7; *(LAS u32x4*)(Ks + (s * 192 + row) * 80 + part * 8) = P.k[it]; }
#pragma unroll
            for (int it = 0; it < 3; ++it) { const int cid = tt + 256 * it, rp = cid % 96, part = cid / 96; const u32x4 a = P.v[it * 2], c = P.v[it * 2 + 1];
#pragma unroll
                for (int e = 0; e < 4; ++e) {
                    *(LAS unsigned*)(Vt + (s * 64 + part * 8 + 2 * e) * 200 + 2 * rp) = (a[e] & 0xffffu) | (c[e] << 16);
                    *(LAS unsigned*)(Vt + (s * 64 + part * 8 + 2 * e + 1) * 200 + 2 * rp) = (a[e] >> 16) | (c[e] & 0xffff0000u);
                } }
        }
        const bf16x8 qf0 = P.q[0], qf1 = P.q[1];
        if (step + 1 < 24) attn_issue(P, zb, h, sp, step + 1, tid, lane);
        __syncthreads();
        {
            const int uidx = rnd * 2 + sl, r = uidx & dm1, lb = uidx >> dsh, i = sp * (16 >> dsh) + lb;
            int fr = lane & 15, fq = lane >> 4; LAUNDER(fr); LAUNDER(fq);
            const int qi = wq * 16 + fr, posq = r + ((64 * i + qi) << dsh); const size_t tokq = (size_t)b * SEQ + posq;
            bf16_t* op = O + tokq * 1024 + 384 + h * 64 + fq * 4; float* lp = lsebuf + (size_t)(b * 6 + h) * SEQ + posq;
            float lprev = 0.f; unsigned long long pq[4] = {0ull, 0ull, 0ull, 0ull};
            if (pi > 0) { lprev = __hip_atomic_load(lp, __ATOMIC_RELAXED, __HIP_MEMORY_SCOPE_AGENT);
#pragma unroll
                for (int dt = 0; dt < 4; ++dt) pq[dt] = __hip_atomic_load((const unsigned long long*)(op + dt * 16), __ATOMIC_RELAXED, __HIP_MEMORY_SCOPE_AGENT); }
            f32x4 sacc[12];
#pragma unroll
            for (int kt = 0; kt < 12; ++kt) { f32x4 acc = {0.f, 0.f, 0.f, 0.f};
                acc = mfma16(*(const LAS bf16x8*)(Ks + (sl * 192 + kt * 16 + fr) * 80 + fq * 8), qf0, acc);
                acc = mfma16(*(const LAS bf16x8*)(Ks + (sl * 192 + kt * 16 + fr) * 80 + 32 + fq * 8), qf1, acc);
                sacc[kt] = acc; }
            const float basef = (float)(fq * 4 - 64 - qi), sd2 = slope * (float)(1 << dsh) * 1.44269504f;
            const bool edge = (i == 0) || (64 * (i + 2) > n);
            float mx = -1e30f;
#pragma unroll
            for (int kt = 0; kt < 12; ++kt)
#pragma unroll
                for (int jj = 0; jj < 4; ++jj) { const float ar = fabsf((float)(kt * 16 + jj) + basef); bool ok = ar <= 64.f;
                    if (edge) { const int jk = 64 * (i - 1) + kt * 16 + fq * 4 + jj; ok = ok && (jk >= 0) && (jk < n); }
                    const float lg = ok ? fmaf(sacc[kt][jj], 0.125f * 1.44269504f, -sd2 * ar) : -1e30f; sacc[kt][jj] = lg; mx = fmaxf(mx, lg); }
            mx = fmaxf(mx, shx(mx, 16, lane)); mx = fmaxf(mx, shx(mx, 32, lane));
            float lsum = 0.f;
#pragma unroll
            for (int kt = 0; kt < 12; ++kt)
#pragma unroll
                for (int jj = 0; jj < 4; ++jj) { const float pv = __builtin_amdgcn_exp2f(sacc[kt][jj] - mx); sacc[kt][jj] = pv; lsum += pv; }
            lsum += shx(lsum, 16, lane); lsum += shx(lsum, 32, lane);
            f32x4 oacc[4];
#pragma unroll
            for (int dt = 0; dt < 4; ++dt) oacc[dt] = (f32x4){0.f, 0.f, 0.f, 0.f};
#pragma unroll
            for (int kk = 0; kk < 6; ++kk) {
                union { uint4 u; bf16x8 v; } pf; pf.u.x = pk2(sacc[2 * kk][0], sacc[2 * kk][1]); pf.u.y = pk2(sacc[2 * kk][2], sacc[2 * kk][3]); pf.u.z = pk2(sacc[2 * kk + 1][0], sacc[2 * kk + 1][1]); pf.u.w = pk2(sacc[2 * kk + 1][2], sacc[2 * kk + 1][3]);
#pragma unroll
                for (int dt = 0; dt < 4; ++dt) {
                    const LAS bf16_t* vp = Vt + (sl * 64 + dt * 16 + fr) * 200 + kk * 32 + fq * 4;
                    union { u32x2 h[2]; bf16x8 v; } vf; vf.h[0] = *(const LAS u32x2*)vp; vf.h[1] = *(const LAS u32x2*)(vp + 16);
                    oacc[dt] = mfma16(vf.v, pf.v, oacc[dt]);
                }
            }
            const float inv = __builtin_amdgcn_rcpf(lsum); float lse = mx * 0.69314718f + __logf(lsum);
            float wn = inv, wp = 0.f;
            if (pi > 0) { const float L = fmaxf(lprev, lse); const float ep = __expf(lprev - L), en = __expf(lse - L); const float den = __builtin_amdgcn_rcpf(ep + en);
                wp = ep * den; wn = en * den * inv; lse = L + __logf(ep + en); }
#pragma unroll
            for (int dt = 0; dt < 4; ++dt) {
                float o0 = oacc[dt][0] * wn, o1 = oacc[dt][1] * wn, o2 = oacc[dt][2] * wn, o3 = oacc[dt][3] * wn;
                if (pi > 0) { const unsigned px = (unsigned)pq[dt], py = (unsigned)(pq[dt] >> 32);
                    o0 += wp * __uint_as_float(px << 16); o1 += wp * __uint_as_float(px & 0xffff0000u); o2 += wp * __uint_as_float(py << 16); o3 += wp * __uint_as_float(py & 0xffff0000u); }
                uint2 ov; ov.x = pk2(o0, o1); ov.y = pk2(o2, o3); wt8u(op + dt * 16, ov);
            }
            if (fq == 0) wt4(lp, __float_as_uint(lse));
        }
    }
}
#ifndef DUP_MASK
#define DUP_MASK 7
#endif

__device__ __forceinline__ void zero_cols(const Ctx& p, bf16_t* O, int c0, int ncols) {
    const int per = ncols >> 3; const size_t total = (size_t)MTOK * per;
    for (size_t i = (size_t)BIDX * 512 + TIDX; i < total; i += (size_t)GDIM * 512) { const size_t row = i / per; const int pc = (int)(i % per); *(uint4*)(O + row * 1024 + c0 + pc * 8) = make_uint4(0u, 0u, 0u, 0u); }
}
__device__ __forceinline__ void mixer_phase(const Ctx& p, int l, LAS unsigned char* lds, int rep = 0) {
    unsigned* ctr = (unsigned*)(PWS + WS_CTR) + l + 2 * rep;
    LAS int* sitem = (LAS int*)(lds + 131072);
    for (;;) {
        __syncthreads();
        if (TIDX == 0) *sitem = (int)atomicAdd(ctr, 1u);
        __syncthreads();
        const int item = __builtin_amdgcn_readfirstlane(*sitem);
        if (item >= 192 + 384 + 2048) break;
        if (item < 192) {
#if EN_RWKV
            if (!rep || (DUP_MASK & 1)) rwkv_scan_item(p, l, item, lds);
#endif
        } else if (item < 576) {
#if EN_ATTN
            if (!rep || (DUP_MASK & 2)) attn_item(p, item - 192, lds);
#endif
        } else {
#if EN_S5
            if (!rep || (DUP_MASK & 4)) s5_passC_item(p, l, item - 576, lds);
#endif
        }
    }
}
constexpr int NPH = 25;
__device__ __forceinline__ void run_phase(const Ctx& p, int ph, LAS unsigned char* lds) {
    bf16_t* XN = (bf16_t*)(PWS + WS_XN); bf16_t* BIG = (bf16_t*)(PWS + WS_BIG);
    if (ph == 0) {
#ifdef DUP_W
        weights_phase(p, lds);
#endif
        weights_phase(p, lds);
        if (BIDX == 0 && TIDX < 128) ((unsigned*)(PWS + WS_CTR))[TIDX] = 0u;
        norm_phase(p, PIN(0), PIN(1), XN, nullptr);
        return;
    }
    const int l = (ph - 1) / 12, k = (ph - 1) % 12;
    const unsigned char* wl = PWS + WS_WB + (size_t)l * WL_SIZE;
    switch (k) {
    case 0: case 9: {
#if EN_FFN
        EpiSwiGLU E; E.wv = p.wv; E.O = BIG;
#ifdef DUP_GU
        for (int rep = 0; rep < 2; ++rep)
#endif
        gemm_run(p, lds, XN, (const bf16_t*)(wl + (k == 0 ? WL_GU1 : WL_GU2)), 5632, 1024, E);
#endif
    } break;
    case 1: case 10: {
        const float* hin = (l == 0 && k == 1) ? PIN(0) : POUT;
#if EN_FFN
        EpiResid E; E.wv = p.wv; E.hin = hin; E.hout = POUT; E.alpha = 0.5f; gemm_run(p, lds, BIG, (const bf16_t*)(wl + (k == 1 ? WL_D1 : WL_D2)), 1024, 2816, E);
#else
        if (l == 0 && k == 1) { for (size_t i = (size_t)BIDX * 512 + TIDX; i < (size_t)MTOK * 256; i += (size_t)GDIM * 512) ((float4*)POUT)[i] = ((const float4*)hin)[i]; }
#endif
    } break;
    case 2: norm_phase(p, POUT, PIN(5) + l * 1024, XN, nullptr);
#ifdef DUP_NORM
        norm_phase(p, POUT, PIN(5) + l * 1024, XN, nullptr); norm_phase(p, POUT, PIN(5) + l * 1024, XN, nullptr); norm_phase(p, POUT, PIN(5) + l * 1024, XN, nullptr);
#endif
        break;
    case 3: { EpiZ E; E.wv = p.wv; E.O = BIG; gemm_run(p, lds, XN, (const bf16_t*)(wl + WL_IN), 2816, 1024, E); } break;
    case 4: {
#if EN_RWKV
        rwkv_prep_phase(p, l);
#ifdef DUP_PREP
        rwkv_prep_phase(p, l);
#endif
#endif
#if EN_S5
        for (int item = BIDX; item < 2048; item += GDIM) s5_passA_item(p, l, item, lds);
#ifdef DUP_PASSA
        for (int item = BIDX; item < 2048; item += GDIM) s5_passA_item(p, l, item, lds);
#endif
#endif
    } break;
    case 5: mixer_phase(p, l, lds); break;
    case 6: {
#if EN_S5
        { EpiGLU E; E.wv = p.wv; E.O = XN; E.bias = PIN(29) + l * 512; gemm_run(p, lds, (const bf16_t*)(PWS + WS_YPRE), (const bf16_t*)(wl + WL_GLU), 512, 256, E); }
#else
        zero_cols(p, XN, 768, 256);
#endif
#if EN_RWKV
        rwkv_post_phase(p, l);
#ifdef DUP_POST
        rwkv_post_phase(p, l);
#endif
#else
        zero_cols(p, XN, 0, 384);
#endif
#if !EN_ATTN
        zero_cols(p, XN, 384, 384);
#endif
    } break;
    case 7: { EpiResid E; E.wv = p.wv; E.hin = POUT; E.hout = POUT; E.alpha = 1.0f; gemm_run(p, lds, XN, (const bf16_t*)(wl + WL_OUT), 1024, 1024, E); } break;
    case 8: norm_phase(p, POUT, PIN(30) + l * 1024, XN, nullptr); break;
    case 11: if (l == 0) norm_phase(p, POUT, PIN(1) + 1024, XN, nullptr); else norm_phase(p, POUT, PIN(34), nullptr, POUT); break;
    }
}

__global__ void __launch_bounds__(512, 2) mega(Params kp, int ph_lo, int ph_hi) {
    extern __shared__ __attribute__((aligned(16))) unsigned char shm[];
    LAS unsigned char* lds = (LAS unsigned char*)shm;
    cg::grid_group grid = cg::this_grid();
    LAS unsigned long long* tab = (LAS unsigned long long*)(lds + 131072 + 64);
    if (threadIdx.x == 0) {
#pragma unroll
        for (int i = 0; i < 35; ++i) tab[i] = (unsigned long long)kp.in[i];
        tab[35] = (unsigned long long)kp.out; tab[36] = (unsigned long long)kp.ws;
    }
    __syncthreads();
    Ctx p; p.tab = tab; p.wv = __builtin_amdgcn_readfirstlane((int)(threadIdx.x >> 6));
    unsigned* bar = (unsigned*)(PWS + WS_BAR);
    unsigned nbar = 0;
    for (int ph = ph_lo; ph < ph_hi; ++ph) {
        run_phase(p, ph, lds);
        if (ph + 1 < ph_hi) {
#ifdef CG_ONLY
#ifdef HARDEN
            __builtin_amdgcn_fence(__ATOMIC_RELEASE, "agent");
#endif
            asm volatile("s_waitcnt vmcnt(0) lgkmcnt(0)" ::: "memory");
            grid.sync();
#ifdef HARDEN
            __builtin_amdgcn_fence(__ATOMIC_ACQUIRE, "agent");
            asm volatile("s_waitcnt vmcnt(0)" ::: "memory");
            __syncthreads();
#endif
#ifdef DUP_MIX
            if (ph > 0 && (ph - 1) % 12 == 5) { mixer_phase(p, (ph - 1) / 12, lds, 1); grid.sync(); }
#endif
#else
            if (ph == ph_lo) {
                grid.sync();
            } else {
                ++nbar;
                asm volatile("s_waitcnt vmcnt(0) lgkmcnt(0)" ::: "memory");
                __syncthreads();
                if (threadIdx.x == 0) {
                    const unsigned target = nbar * (unsigned)gridDim.x;
                    __builtin_amdgcn_fence(__ATOMIC_RELEASE, "agent");
                    asm volatile("s_waitcnt vmcnt(0)" ::: "memory");
                    __hip_atomic_fetch_add(bar, 1u, __ATOMIC_RELAXED, __HIP_MEMORY_SCOPE_AGENT);
                    while (__hip_atomic_load(bar, __ATOMIC_RELAXED, __HIP_MEMORY_SCOPE_AGENT) < target) __builtin_amdgcn_s_sleep(1);
                    __builtin_amdgcn_fence(__ATOMIC_ACQUIRE, "agent");
                    asm volatile("s_waitcnt vmcnt(0)" ::: "memory");
                    __hip_atomic_fetch_add(bar + 64, 1u, __ATOMIC_RELAXED, __HIP_MEMORY_SCOPE_AGENT);
                    while (__hip_atomic_load(bar + 64, __ATOMIC_RELAXED, __HIP_MEMORY_SCOPE_AGENT) < target) __builtin_amdgcn_s_sleep(1);
                }
                __syncthreads();
            }
#endif
        }
    }
}

#ifndef SPLIT_LAUNCH
#define SPLIT_LAUNCH 0
#endif
extern "C" void kernel_launch(void* const* d_in, const int* in_sizes, int n_in, void* d_out, int out_size, void* d_ws, size_t ws_size, hipStream_t stream) {
    static int grid = 0;
    if (grid == 0) {
        if (n_in != 35 || out_size != MTOK * 1024 || ws_size < WS_END) { fprintf(stderr, "kernel_launch: unexpected shapes (n_in %d out %d ws %zu need %zu)\n", n_in, out_size, ws_size, (size_t)WS_END); grid = -1; return; }
        int dev = 0, cus = 0, per_cu = 0;
        if (hipGetDevice(&dev) != hipSuccess || hipDeviceGetAttribute(&cus, hipDeviceAttributeMultiprocessorCount, dev) != hipSuccess) { grid = -1; return; }
        if (hipFuncSetAttribute((const void*)mega, hipFuncAttributeMaxDynamicSharedMemorySize, LDS_BYTES) != hipSuccess) { fprintf(stderr, "kernel_launch: hipFuncSetAttribute failed\n"); grid = -1; return; }
        if (hipOccupancyMaxActiveBlocksPerMultiprocessor(&per_cu, (const void*)mega, 512, LDS_BYTES) != hipSuccess || per_cu < 1) { fprintf(stderr, "kernel_launch: occupancy query says %d\n", per_cu); per_cu = 1; }
        (void)hipGetLastError();
        grid = cus;
    }
    if (grid < 0) return;
    Params p{};
    for (int i = 0; i < 35; ++i) p.in[i] = (const float*)d_in[i];
    p.out = (float*)d_out; p.ws = (unsigned char*)d_ws;
#if SPLIT_LAUNCH
    for (int ph = 0; ph < NPH; ++ph) { int lo = ph, hi = ph + 1; void* args[] = {&p, &lo, &hi};
        hipError_t e = hipLaunchCooperativeKernel((const void*)mega, dim3(grid), dim3(512), args, LDS_BYTES, stream);
        if (e != hipSuccess) { fprintf(stderr, "launch failed: %s\n", hipGetErrorString(e)); return; } }
#else
    int lo = 0, hi = NPH; void* args[] = {&p, &lo, &hi};
    hipError_t e = hipLaunchCooperativeKernel((const void*)mega, dim3(grid), dim3(512), args, LDS_BYTES, stream);
    if (e != hipSuccess) fprintf(stderr, "cooperative launch failed: %s (grid %d)\n", hipGetErrorString(e), grid);
#endif
}
```

```cpp
#include <hip/hip_cooperative_groups.h>
#include <cstdio>
#include <hip/hip_runtime.h>
__device__ __forceinline__ int tid_from(int wv) { unsigned m = ~0u; asm volatile("" : "+s"(m), "+s"(wv)); return wv * 64 + (int)__builtin_amdgcn_mbcnt_hi(m, __builtin_amdgcn_mbcnt_lo(m, 0u)); }
#define TIDX (tid_from(p.wv))
__device__ __forceinline__ int bid_() { int b = blockIdx.x; asm volatile("" : "+s"(b)); return b; }
__device__ __forceinline__ int gdim_() { int b = gridDim.x; asm volatile("" : "+s"(b)); return b; }
#define BIDX (bid_())
#define GDIM (gdim_())
#define CG_ONLY 1
#include <hip/hip_runtime.h>
namespace pg8 {
#define PG8_LAS __attribute__((address_space(3)))
typedef unsigned short bf16_t;
typedef short bf16x8 __attribute__((ext_vector_type(8)));
typedef float f32x4 __attribute__((ext_vector_type(4)));
typedef unsigned u32x4 __attribute__((ext_vector_type(4)));
constexpr int BM = 256, BK = 64, HALF = 128, HTB = HALF * BK * 2  , STAGE_BYTES = 8 * HTB, NXCD = 8, WGM = 8;

__host__ __device__ __forceinline__ int lds_byte(int r, int c) { const int st = (r >> 4) * 2 + (c >> 5), rr = r & 15, cc = c & 31, ob = rr * 64 + cc * 2; return st * 1024 + (ob ^ (((ob >> 9) & 1) << 5)); }
__host__ __device__ __forceinline__ void stage_rc(int b, int& R, int& C) { const int st = b / 1024, sb = b % 1024, swz = sb ^ (((sb >> 9) & 1) << 5); R = (st >> 1) * 16 + swz / 64; C = (st & 1) * 32 + (swz % 64) / 2; }
__host__ __device__ __forceinline__ int perm32(int rho) { const int n = rho >> 4, i = rho & 15; return 8 * (i >> 2) + 4 * n + (i & 3); }

struct Unit { int pm, pn; };
struct Gemm { const bf16_t* A; const bf16_t* Bt; int M, N, K; };

struct StaticOrder {
    int nM, nN, nwg, G, c;
    __host__ __device__ void init(int M, int N, int G_, int c_) { nM = M / BM; nN = N / BM; nwg = nM * nN; G = G_; c = c_; }
    __host__ __device__ bool next(int i, Unit& u) const {
        const long L = (long)i * G + c; if (L >= nwg) return false;
        int wgid = (int)L; { const int q = nwg / NXCD, r = nwg % NXCD, xcd = wgid % NXCD, off = wgid / NXCD; wgid = (xcd < r ? xcd * (q + 1) : r * (q + 1) + (xcd - r) * q) + off; }
        const int nig = WGM * nN, gid = wgid / nig, fm = gid * WGM, gsz = (nM - fm) < WGM ? (nM - fm) : WGM;
        u.pm = fm + ((wgid % nig) % gsz); u.pn = (wgid % nig) / gsz; return true;
    }
    __device__ __forceinline__ void a_ready(const Unit&) const {}
    __device__ __forceinline__ void done(const Unit&) const {}
};
__device__ __forceinline__ unsigned cvt_pk_bf16(float lo, float hi) { unsigned r; asm volatile("v_cvt_pk_bf16_f32 %0, %1, %2" : "=v"(r) : "v"(lo), "v"(hi)); return r; }
template <class Epi, class Sched, bool STAMP = false>
__device__ __forceinline__ void gemm_phase(PG8_LAS unsigned char* lds, const Gemm g, const Sched& S, const Epi& E, unsigned long long* stamps, const int tid_in) {
    const int tid = tid_in, wid = __builtin_amdgcn_readfirstlane(tid >> 6), lane = tid & 63, wr = wid >> 2, wc = wid & 3, fr = lane & 15, fq = lane >> 4;
    const int K = g.K, nt = K / BK;
    int ts_lo = 0, ts_hi = 0, nts = 0; const unsigned long long rt_entry = STAMP ? (unsigned long long)wall_clock64() : 0ull;
#define PG8_STAMP() do { if (STAMP && wid == 0 && nts < 64) { const unsigned long long _c = (unsigned long long)clock64(); \
        ts_lo = (lane == nts) ? (int)(unsigned)_c : ts_lo; ts_hi = (lane == nts) ? (int)(unsigned)(_c >> 32) : ts_hi; ++nts; } } while (0)
    PG8_STAMP();
    unsigned voffA[2], voffB[2];
#pragma unroll
    for (int i = 0; i < 2; ++i) { int R, C; stage_rc(tid * 16 + i * 8192, R, C); const int Rb = Epi::PERM ? ((R & ~31) + perm32(R & 31)) : R;
        voffA[i] = (unsigned)(R * K + C) * 2u; voffB[i] = (unsigned)(Rb * K + C) * 2u; }
    const size_t kstep = (size_t)(BK * 2);
    const size_t hstep = (size_t)HALF * K * 2;
    const size_t tstep = 2 * hstep;
    const unsigned ldsw = (unsigned)wid * 1024u;
    const int aoff = lds_byte(wr * 64 + fr, fq * 8), boff = lds_byte(wc * 32 + fr, fq * 8);
#define PG8_SA(b, h) (((b) * 2 + (h)) * HTB)
#define PG8_SB(b, h) ((4 + (b) * 2 + (h)) * HTB)
#define PG8_STAGE(bufoff, gbase, voff) do { _Pragma("unroll") for (int _i = 0; _i < 2; ++_i) \
        __builtin_amdgcn_global_load_lds((const unsigned*)((const char*)(gbase) + (voff)[_i]), (PG8_LAS unsigned*)(lds + (bufoff) + ldsw + _i * 8192), 16, 0, 0); } while (0)
#define PG8_LDA(dst, b, h) do { _Pragma("unroll") for (int m = 0; m < 4; ++m) _Pragma("unroll") for (int k = 0; k < 2; ++k) dst[m][k] = *(const PG8_LAS bf16x8*)(lds + PG8_SA(b, h) + aoff + m * 2048 + k * 1024); } while (0)
#define PG8_LDB(dst, b, h) do { _Pragma("unroll") for (int n = 0; n < 2; ++n) _Pragma("unroll") for (int k = 0; k < 2; ++k) dst[n][k] = *(const PG8_LAS bf16x8*)(lds + PG8_SB(b, h) + boff + n * 2048 + k * 1024); } while (0)
#define PG8_MMA(ai, bj, At, Bt) do { __builtin_amdgcn_s_setprio(1); _Pragma("unroll") for (int m = 0; m < 4; ++m) _Pragma("unroll") for (int n = 0; n < 2; ++n) _Pragma("unroll") for (int k = 0; k < 2; ++k) \
        acc[ai][bj][m][n] = __builtin_amdgcn_mfma_f32_16x16x32_bf16(Bt[n][k], At[m][k], acc[ai][bj][m][n], 0, 0, 0); __builtin_amdgcn_s_setprio(0); } while (0)
#define PG8_WAIT_V(n) asm volatile("s_waitcnt vmcnt(" #n ")" ::: "memory")
#define PG8_WAIT_L(n) asm volatile("s_waitcnt lgkmcnt(" #n ")" ::: "memory")
#define PG8_BAR __builtin_amdgcn_s_barrier()
#define PG8_SCHED __builtin_amdgcn_sched_barrier(0)
    Unit cur, nxt; int ui = 0;
    if (!S.next(0, cur)) return;
    f32x4 acc[2][2][4][2];
#pragma unroll
    for (int a = 0; a < 2; ++a)
#pragma unroll
        for (int b = 0; b < 2; ++b)
#pragma unroll
            for (int m = 0; m < 4; ++m)
#pragma unroll
                for (int n = 0; n < 2; ++n) acc[a][b][m][n] = (f32x4){0.f, 0.f, 0.f, 0.f};
    bf16x8 At[4][2], B0[2][2], B1[2][2];
    const char* cA = (const char*)g.A + (size_t)cur.pm * tstep; const char* cB = (const char*)g.Bt + (size_t)cur.pn * tstep;
    S.a_ready(cur);
    PG8_STAGE(PG8_SB(0, 0), cB, voffB); PG8_STAGE(PG8_SA(0, 0), cA, voffA); PG8_STAGE(PG8_SB(0, 1), cB + hstep, voffB); PG8_STAGE(PG8_SA(0, 1), cA + hstep, voffA);
    if (wr == 1) PG8_BAR;
    PG8_WAIT_V(4); PG8_BAR;
    PG8_STAGE(PG8_SB(1, 0), cB + kstep, voffB); PG8_STAGE(PG8_SA(1, 0), cA + kstep, voffA); PG8_STAGE(PG8_SB(1, 1), cB + hstep + kstep, voffB);
    PG8_WAIT_V(6); PG8_BAR;
    PG8_STAMP();
    for (;;) {
        const bool has_next = S.next(ui + 1, nxt);
        const char* nA = has_next ? (const char*)g.A + (size_t)nxt.pm * tstep : cA; const char* nB = has_next ? (const char*)g.Bt + (size_t)nxt.pn * tstep : cB;
        for (int t = 0; t < nt; t += 2) {
            const bool last = (t == nt - 2);
            const char* a1 = cA + (size_t)(t + 1) * kstep;
            const char* a2 = last ? nA : cA + (size_t)(t + 2) * kstep; const char* b2 = last ? nB : cB + (size_t)(t + 2) * kstep;
            const char* a3 = a2 + kstep; const char* b3 = b2 + kstep;
            if (last && has_next) S.a_ready(nxt);
            PG8_LDB(B0, 0, 0); PG8_SCHED; PG8_LDA(At, 0, 0); PG8_STAGE(PG8_SA(1, 1), a1 + hstep, voffA);
            PG8_WAIT_L(8); PG8_BAR; PG8_WAIT_L(0); PG8_MMA(0, 0, At, B0); PG8_BAR; PG8_SCHED;
            PG8_LDB(B1, 0, 1); PG8_STAGE(PG8_SB(0, 0), b2, voffB);
            PG8_BAR; PG8_WAIT_L(0); PG8_MMA(0, 1, At, B1); PG8_BAR;
            PG8_LDA(At, 0, 1); PG8_STAGE(PG8_SA(0, 0), a2, voffA);
            PG8_BAR; PG8_WAIT_L(0); PG8_MMA(1, 0, At, B0); PG8_BAR; PG8_SCHED;
            PG8_STAGE(PG8_SB(0, 1), b2 + hstep, voffB);
            PG8_WAIT_V(6); PG8_BAR; PG8_MMA(1, 1, At, B1); PG8_BAR;
            PG8_LDB(B0, 1, 0); PG8_SCHED; PG8_LDA(At, 1, 0); PG8_STAGE(PG8_SA(0, 1), a2 + hstep, voffA);
            PG8_WAIT_L(8); PG8_BAR; PG8_WAIT_L(0); PG8_MMA(0, 0, At, B0); PG8_BAR; PG8_SCHED;
            PG8_LDB(B1, 1, 1); PG8_STAGE(PG8_SB(1, 0), b3, voffB);
            PG8_BAR; PG8_WAIT_L(0); PG8_MMA(0, 1, At, B1); PG8_BAR;
            PG8_LDA(At, 1, 1); PG8_STAGE(PG8_SA(1, 0), a3, voffA);
            PG8_BAR; PG8_WAIT_L(0); PG8_MMA(1, 0, At, B0); PG8_BAR; PG8_SCHED;
            PG8_STAGE(PG8_SB(1, 1), b3 + hstep, voffB);
            PG8_WAIT_V(6); PG8_BAR; PG8_MMA(1, 1, At, B1); PG8_BAR;
        }
        PG8_STAMP();
        if constexpr (!Epi::AFTER_DRAIN) { E(acc, cur, wr, wc, fr, fq); S.done(cur); }
        PG8_STAMP();
        if (!has_next) break;
#pragma unroll
        for (int a = 0; a < 2; ++a)
#pragma unroll
            for (int b = 0; b < 2; ++b)
#pragma unroll
                for (int m = 0; m < 4; ++m)
#pragma unroll
                    for (int n = 0; n < 2; ++n) acc[a][b][m][n] = (f32x4){0.f, 0.f, 0.f, 0.f};
        cur = nxt; cA = nA; cB = nB; ++ui;
    }
    PG8_WAIT_V(0);
    if (wr == 0) PG8_BAR;
    PG8_BAR;
    if constexpr (Epi::AFTER_DRAIN) { E.fused(acc, cur, wr, wc, fr, fq, lds, wid, lane); S.done(cur); }
    PG8_STAMP();
    if (STAMP && wid == 0) { stamps[lane] = lane < nts ? (((unsigned long long)(unsigned)ts_hi << 32) | (unsigned)ts_lo) : 0ull;
        if (lane == 62) stamps[62] = rt_entry; if (lane == 63) stamps[63] = (unsigned long long)wall_clock64(); }
#undef PG8_STAMP
#undef PG8_SA
#undef PG8_SB
#undef PG8_STAGE
#undef PG8_LDA
#undef PG8_LDB
#undef PG8_MMA
#undef PG8_WAIT_V
#undef PG8_WAIT_L
#undef PG8_BAR
#undef PG8_SCHED
}
}

#include <cstdio>
#include <ctime>
#include <cstdlib>
#include <cstring>
#include <cmath>
#include <vector>
#include <algorithm>

namespace cg = cooperative_groups;
using pg8::bf16_t; using pg8::bf16x8; using pg8::f32x4;
typedef _Float16 f16_t;
typedef short bf16x4 __attribute__((ext_vector_type(4)));
typedef unsigned u32x4 __attribute__((ext_vector_type(4)));
typedef unsigned u32x2 __attribute__((ext_vector_type(2)));
#define LAS __attribute__((address_space(3)))

#ifndef EN_RWKV
#define EN_RWKV 1
#endif
#ifndef EN_ATTN
#define EN_ATTN 1
#endif
#ifndef EN_S5
#define EN_S5 1
#endif
#ifndef EN_FFN
#define EN_FFN 1
#endif

constexpr int MTOK = 65536, SEQ = 8192;
constexpr int LDS_BYTES = 131072 + 512;
constexpr size_t WL_GU1 = 0, WL_D1 = WL_GU1 + 11534336, WL_IN = WL_D1 + 5767168, WL_OUT = WL_IN + 5767168, WL_GU2 = WL_OUT + 2097152,
                 WL_D2 = WL_GU2 + 11534336, WL_GLU = WL_D2 + 5767168, WL_W2 = WL_GLU + 262144, WL_A2 = WL_W2 + 98304, WL_G2 = WL_A2 + 98304, WL_SIZE = WL_G2 + 98304;
constexpr size_t WS_WB = 0, WS_XN = WS_WB + 2 * WL_SIZE, WS_BIG = WS_XN + 134217728, WS_LAM = WS_BIG + 369098752, WS_AA = WS_LAM + 100663296,
                 WS_GG = WS_AA + 100663296, WS_YY = WS_GG + 50331648, WS_YPRE = WS_YY + 100663296, WS_LSE = WS_YPRE + 33554432, WS_CB = WS_LSE + 1572864,
                 WS_S5E = WS_CB + 3145728, WS_CTR = WS_S5E + 8388608, WS_BAR = WS_CTR + 256, WS_END = WS_BAR + 16384;

struct Params { const float* in[35]; float* out; unsigned char* ws; };
struct Ctx { LAS const unsigned long long* tab; int wv; };
template <class T> __device__ __forceinline__ T* ldsptr(LAS const unsigned long long* tab, int i) {
    unsigned a_; asm volatile("s_mov_b32 %0, 0x20040" : "=s"(a_)); a_ += (unsigned)i * 8u;
    const unsigned long long v = *(LAS const unsigned long long*)a_; const unsigned lo = __builtin_amdgcn_readfirstlane((unsigned)v), hi = __builtin_amdgcn_readfirstlane((unsigned)(v >> 32));
    unsigned long long r = ((unsigned long long)hi << 32) | lo; asm volatile("" : "+s"(r));
    return (T*)(__attribute__((address_space(1))) T*)r; }
#define PWS (ldsptr<unsigned char>(p.tab, 36))
#define POUT (ldsptr<float>(p.tab, 35))
#define PIN(i) (ldsptr<const float>(p.tab, i))

__device__ __forceinline__ float bf2f(unsigned short b) { return __uint_as_float(((unsigned)b) << 16); }
typedef float f32v2_ __attribute__((ext_vector_type(2)));
typedef __bf16 bf16v2_ __attribute__((ext_vector_type(2)));
__device__ __forceinline__ unsigned pk2a(float lo, float hi) { return pg8::cvt_pk_bf16(lo, hi); }
__device__ __forceinline__ unsigned pk2(float lo, float hi) { return pg8::cvt_pk_bf16(lo, hi); }
#ifdef PK2_BUILTIN
__device__ __forceinline__ unsigned pk2m(float lo, float hi) { const f32v2_ f = {lo, hi}; const bf16v2_ r = __builtin_convertvector(f, bf16v2_); return __builtin_bit_cast(unsigned, r); }
#else
__device__ __forceinline__ unsigned pk2m(float lo, float hi) { return pg8::cvt_pk_bf16(lo, hi); }
#endif
#ifdef WT_STORES
__device__ __forceinline__ void wt8(void* p, unsigned long long v) { __hip_atomic_store((unsigned long long*)p, v, __ATOMIC_RELAXED, __HIP_MEMORY_SCOPE_AGENT); }
__device__ __forceinline__ void wt4(void* p, unsigned v) { __hip_atomic_store((unsigned*)p, v, __ATOMIC_RELAXED, __HIP_MEMORY_SCOPE_AGENT); }
__device__ __forceinline__ void wt2(void* p, unsigned short v) { __hip_atomic_store((unsigned short*)p, v, __ATOMIC_RELAXED, __HIP_MEMORY_SCOPE_AGENT); }
#else
__device__ __forceinline__ void wt8(void* p, unsigned long long v) { *(unsigned long long*)p = v; }
__device__ __forceinline__ void wt4(void* p, unsigned v) { *(unsigned*)p = v; }
__device__ __forceinline__ void wt2(void* p, unsigned short v) { *(unsigned short*)p = v; }
#endif
#if defined(WT_STORES) && defined(WT_ASM16)
__device__ __forceinline__ void wt16(void* p, uint4 v) {
    u32x4 d = {v.x, v.y, v.z, v.w};
    asm volatile("global_store_dwordx4 %0, %1, off sc1\n\ts_nop 1" :: "v"(p), "v"(d) : "memory"); }
#elif defined(WT_STORES)
__device__ __forceinline__ void wt16(void* p, uint4 v) {
    u32x4 d = {v.x, v.y, v.z, v.w}; __builtin_nontemporal_store(d, (u32x4*)p); }
#else
__device__ __forceinline__ void wt16(void* p, uint4 v) { *(uint4*)p = v; }
#endif
__device__ __forceinline__ void wt8u(void* p, uint2 v) { wt8(p, ((unsigned long long)v.y << 32) | v.x); }
__device__ __forceinline__ void wt16f(void* p, f32x4 v) { uint4 u; u.x = __float_as_uint(v[0]); u.y = __float_as_uint(v[1]); u.z = __float_as_uint(v[2]); u.w = __float_as_uint(v[3]); wt16(p, u); }
__device__ __forceinline__ float shx(float v, int o, int lane) { return __builtin_bit_cast(float, __builtin_amdgcn_ds_bpermute((lane ^ o) << 2, __builtin_bit_cast(int, v))); }
#define LAUNDER(x) asm volatile("" : "+v"(x))
__device__ __forceinline__ float dpp_ror_add(float x, const int ctrl_unused) { return x; }
#define DPP_ROR_ADD(x, N) ((x) + __builtin_bit_cast(float, __builtin_amdgcn_update_dpp(0, __builtin_bit_cast(int, (x)), 0x120 + (N), 0xf, 0xf, false)))
__device__ __forceinline__ float row16_sum(float x) {
    x = DPP_ROR_ADD(x, 8); x = DPP_ROR_ADD(x, 4); x = DPP_ROR_ADD(x, 2); x = DPP_ROR_ADD(x, 1); return x;
}
__device__ __forceinline__ float wave_sum(float v, int lane) {
    v = row16_sum(v); v += shx(v, 16, lane); v += shx(v, 32, lane); return v;
}
__device__ __forceinline__ float sigmoidf_(float x) { return __builtin_amdgcn_rcpf(1.f + __expf(-x)); }
__device__ __forceinline__ float tanhf_(float x) { const float e = __expf(2.f * x); return 1.f - 2.f * __builtin_amdgcn_rcpf(e + 1.f); }
__device__ __forceinline__ f32x4 mfma16(bf16x8 a, bf16x8 b, f32x4 c) { return __builtin_amdgcn_mfma_f32_16x16x32_bf16(a, b, c, 0, 0, 0); }

template <class F> __device__ __forceinline__ void prep_t(const Ctx& p, LAS unsigned char* lds, bf16_t* dst, int N, int K, F rowp) {
    LAS float* T = (LAS float*)lds;
    const int tid = TIDX, ntn = N >> 6, ntk = K >> 6, total = ntn * ntk;
    for (int t = BIDX; t < total; t += GDIM) {
        const int n0 = (t % ntn) << 6, k0 = (t / ntn) << 6;
        __syncthreads();
        { const int k = tid >> 3, c8 = (tid & 7) << 3; const float* s = rowp(n0, k0 + k) + c8;
          const f32x4 a = *(const f32x4*)s, c = *(const f32x4*)(s + 4);
#pragma unroll
          for (int e = 0; e < 4; ++e) { T[k * 65 + c8 + e] = a[e]; T[k * 65 + c8 + 4 + e] = c[e]; } }
        __syncthreads();
        { const int n = tid >> 3, k8 = (tid & 7) << 3; float v[8];
#pragma unroll
          for (int e = 0; e < 8; ++e) v[e] = T[(k8 + e) * 65 + n];
          uint4 o; o.x = pk2a(v[0], v[1]); o.y = pk2a(v[2], v[3]); o.z = pk2a(v[4], v[5]); o.w = pk2a(v[6], v[7]);
          wt16(dst + (size_t)(n0 + n) * K + k0 + k8, o); }
    }
}
__device__ __forceinline__ void weights_phase(const Ctx& p, LAS unsigned char* lds) {
    for (int l = 0; l < 2; ++l) {
        unsigned char* wl = PWS + WS_WB + (size_t)l * WL_SIZE;
        for (int f = 0; f < 2; ++f) {
            const float* wg = PIN(f ? 31 : 2) + (size_t)l * 1024 * 2816; const float* wu = PIN(f ? 32 : 3) + (size_t)l * 1024 * 2816; const float* wd = PIN(f ? 33 : 4) + (size_t)l * 2816 * 1024;
            prep_t(p, lds, (bf16_t*)(wl + (f ? WL_GU2 : WL_GU1)), 5632, 1024, [=](int n0, int k) { const int t = n0 >> 8, i = n0 & 255; return ((i < 128) ? wg + t * 128 + i : wu + t * 128 + i - 128) + (size_t)k * 2816; });
            prep_t(p, lds, (bf16_t*)(wl + (f ? WL_D2 : WL_D1)), 1024, 2816, [=](int n0, int k) { return wd + (size_t)k * 1024 + n0; });
        }
        { const float* w = PIN(6) + (size_t)l * 1024 * 2816; prep_t(p, lds, (bf16_t*)(wl + WL_IN), 2816, 1024, [=](int n0, int k) { return w + (size_t)k * 2816 + n0; }); }
        { const float* w = PIN(7) + (size_t)l * 1024 * 1024; prep_t(p, lds, (bf16_t*)(wl + WL_OUT), 1024, 1024, [=](int n0, int k) { return w + (size_t)k * 1024 + n0; }); }
        { const float* w = PIN(28) + (size_t)l * 256 * 512; prep_t(p, lds, (bf16_t*)(wl + WL_GLU), 512, 256, [=](int n0, int k) { const int t = n0 >> 8, i = n0 & 255; return w + (size_t)k * 512 + ((i < 128) ? t * 128 + i : 256 + t * 128 + i - 128); }); }
        { const float* w = PIN(11) + (size_t)l * 2 * 64 * 384; prep_t(p, lds, (bf16_t*)(wl + WL_W2), 768, 64, [=](int n0, int k) { const int d = n0 / 384, c = n0 % 384; return w + (size_t)(d * 64 + k) * 384 + c; }); }
        { const float* w = PIN(13) + (size_t)l * 2 * 64 * 384; prep_t(p, lds, (bf16_t*)(wl + WL_A2), 768, 64, [=](int n0, int k) { const int d = n0 / 384, c = n0 % 384; return w + (size_t)(d * 64 + k) * 384 + c; }); }
        { const float* w = PIN(14) + (size_t)l * 128 * 384; prep_t(p, lds, (bf16_t*)(wl + WL_G2), 384, 128, [=](int n0, int k) { return w + (size_t)k * 384 + n0; }); }
    }
}

__device__ __forceinline__ void norm_phase(const Ctx& p, const float* hin, const float* g, bf16_t* xn, float* fout) {
    const int lane = TIDX & 63, wave = BIDX * 8 + (TIDX >> 6), nw = GDIM * 8;
    float4 gv[4];
#pragma unroll
    for (int i = 0; i < 4; ++i) gv[i] = *(const float4*)(g + lane * 4 + 256 * i);
    for (int row = wave; row < MTOK; row += nw) {
        const float* pr = hin + (size_t)row * 1024;
        float4 v[4]; float ss = 0.f;
#pragma unroll
        for (int i = 0; i < 4; ++i) { v[i] = *(const float4*)(pr + lane * 4 + 256 * i); ss += v[i].x * v[i].x + v[i].y * v[i].y + v[i].z * v[i].z + v[i].w * v[i].w; }
        ss = wave_sum(ss, lane);
        const float rs = rsqrtf(ss * (1.f / 1024.f) + 1e-6f);
        if (xn) {
#pragma unroll
            for (int i = 0; i < 4; ++i) { uint2 o; o.x = pk2a(v[i].x * rs * gv[i].x, v[i].y * rs * gv[i].y); o.y = pk2a(v[i].z * rs * gv[i].z, v[i].w * rs * gv[i].w); wt8u(xn + (size_t)row * 1024 + lane * 4 + 256 * i, o); }
        } else {
#pragma unroll
            for (int i = 0; i < 4; ++i) { float4 o; o.x = v[i].x * rs * gv[i].x; o.y = v[i].y * rs * gv[i].y; o.z = v[i].z * rs * gv[i].z; o.w = v[i].w * rs * gv[i].w; wt16f(fout + (size_t)row * 1024 + lane * 4 + 256 * i, (f32x4){o.x, o.y, o.z, o.w}); }
        }
    }
}

struct EpiSwiGLU { int wv; static constexpr bool PERM = true, AFTER_DRAIN = false; bf16_t* O;
    __device__ __forceinline__ void operator()(const f32x4 (&acc)[2][2][4][2], const pg8::Unit& u, int wr, int wc, int fr_, int fq_) const {
        const int ln_ = tid_from(wv) & 63, fr = ln_ & 15, fq = ln_ >> 4;
        const int row0 = u.pm * 256 + wr * 64 + fr, col0 = u.pn * 128 + wc * 32 + 8 * fq;
#pragma unroll
        for (int ai = 0; ai < 2; ++ai)
#pragma unroll
            for (int m = 0; m < 4; ++m) {
                float r[8];
#pragma unroll
                for (int n = 0; n < 2; ++n)
#pragma unroll
                    for (int j = 0; j < 4; ++j) { const float g = acc[ai][0][m][n][j], uu = acc[ai][1][m][n][j]; r[n * 4 + j] = g * sigmoidf_(g) * uu; }
                uint4 o; o.x = pk2a(r[0], r[1]); o.y = pk2a(r[2], r[3]); o.z = pk2a(r[4], r[5]); o.w = pk2a(r[6], r[7]);
                wt16(O + (size_t)(row0 + ai * 128 + m * 16) * 2816 + col0, o);
            }
    }
};
struct EpiResid { int wv; static constexpr bool PERM = false, AFTER_DRAIN = false; const float* hin; float* hout; float alpha;
    __device__ __forceinline__ void operator()(const f32x4 (&acc)[2][2][4][2], const pg8::Unit& u, int wr, int wc, int fr_, int fq_) const {
        const int ln_ = tid_from(wv) & 63, fr = ln_ & 15, fq = ln_ >> 4;
        const int row0 = u.pm * 256 + wr * 64 + fr, col0 = u.pn * 256 + wc * 32 + 4 * fq;
#pragma unroll
        for (int ai = 0; ai < 2; ++ai)
#pragma unroll
            for (int m = 0; m < 4; ++m) { const size_t ro = (size_t)(row0 + ai * 128 + m * 16) * 1024 + col0;
#pragma unroll
                for (int bj = 0; bj < 2; ++bj)
#pragma unroll
                    for (int n = 0; n < 2; ++n) { const f32x4 hv = *(const f32x4*)(hin + ro + bj * 128 + n * 16); wt16f(hout + ro + bj * 128 + n * 16, hv + alpha * acc[ai][bj][m][n]); } }
    }
};
struct EpiZ { int wv; static constexpr bool PERM = true, AFTER_DRAIN = false; bf16_t* O;
    __device__ __forceinline__ void operator()(const f32x4 (&acc)[2][2][4][2], const pg8::Unit& u, int wr, int wc, int fr_, int fq_) const {
        const int ln_ = tid_from(wv) & 63, fr = ln_ & 15, fq = ln_ >> 4;
        const int row0 = u.pm * 256 + wr * 64 + fr, col0 = u.pn * 256 + wc * 32 + 8 * fq;
#pragma unroll
        for (int ai = 0; ai < 2; ++ai)
#pragma unroll
            for (int m = 0; m < 4; ++m)
#pragma unroll
                for (int bj = 0; bj < 2; ++bj) { const f32x4 a = acc[ai][bj][m][0], b = acc[ai][bj][m][1];
                    uint4 o; o.x = pk2a(a[0], a[1]); o.y = pk2a(a[2], a[3]); o.z = pk2a(b[0], b[1]); o.w = pk2a(b[2], b[3]);
                    wt16(O + (size_t)(row0 + ai * 128 + m * 16) * 2816 + col0 + bj * 128, o); }
    }
};
struct EpiGLU { int wv; static constexpr bool PERM = true, AFTER_DRAIN = false; bf16_t* O; const float* bias;
    __device__ __forceinline__ void operator()(const f32x4 (&acc)[2][2][4][2], const pg8::Unit& u, int wr, int wc, int fr_, int fq_) const {
        const int ln_ = tid_from(wv) & 63, fr = ln_ & 15, fq = ln_ >> 4;
        const int row0 = u.pm * 256 + wr * 64 + fr, cw = u.pn * 128 + wc * 32 + 8 * fq;
        const f32x4 bv0 = *(const f32x4*)(bias + cw), bv1 = *(const f32x4*)(bias + cw + 4), bg0 = *(const f32x4*)(bias + 256 + cw), bg1 = *(const f32x4*)(bias + 256 + cw + 4);
#pragma unroll
        for (int ai = 0; ai < 2; ++ai)
#pragma unroll
            for (int m = 0; m < 4; ++m) {
                const f32x4 v0 = acc[ai][0][m][0] + bv0, v1 = acc[ai][0][m][1] + bv1, g0 = acc[ai][1][m][0] + bg0, g1 = acc[ai][1][m][1] + bg1;
                uint4 o; o.x = pk2a(v0[0] * sigmoidf_(g0[0]), v0[1] * sigmoidf_(g0[1])); o.y = pk2a(v0[2] * sigmoidf_(g0[2]), v0[3] * sigmoidf_(g0[3]));
                o.z = pk2a(v1[0] * sigmoidf_(g1[0]), v1[1] * sigmoidf_(g1[1])); o.w = pk2a(v1[2] * sigmoidf_(g1[2]), v1[3] * sigmoidf_(g1[3]));
                wt16(O + (size_t)(row0 + ai * 128 + m * 16) * 1024 + 768 + cw, o);
            }
    }
};
template <class Epi> __device__ __forceinline__ void gemm_run(const Ctx& p, LAS unsigned char* lds, const bf16_t* A, const bf16_t* Bt, int N, int K, const Epi& E) {
    asm volatile("" : "+s"(N), "+s"(K));
    pg8::Gemm g; g.A = A; g.Bt = Bt; g.M = MTOK; g.N = N; g.K = K;
    pg8::StaticOrder S; S.init(MTOK, N, (int)GDIM, (int)BIDX);
    pg8::gemm_phase<Epi, pg8::StaticOrder, false>(lds, g, S, E, nullptr, TIDX);
}

__device__ __forceinline__ void rwkv_prep_phase(const Ctx& p, int l) {
    const bf16_t* z = (const bf16_t*)(PWS + WS_BIG);
    const unsigned char* wl = PWS + WS_WB + (size_t)l * WL_SIZE;
    const bf16_t* w2t = (const bf16_t*)(wl + WL_W2); const bf16_t* a2t = (const bf16_t*)(wl + WL_A2); const bf16_t* g2t = (const bf16_t*)(wl + WL_G2);
    const float* mup = PIN(8) + l * 1408; const float* mun = PIN(9) + l * 1408;
    const float* w0 = PIN(10) + l * 768; const float* a0 = PIN(12) + l * 768;
    f16_t* lam = (f16_t*)(PWS + WS_LAM); f16_t* aa = (f16_t*)(PWS + WS_AA); f16_t* gg = (f16_t*)(PWS + WS_GG);
    const int lane = TIDX & 63, fr = lane & 15, fq = lane >> 4;
    const int gw = BIDX * 8 + (TIDX >> 6), nw = GDIM * 8;
    for (int it = gw; it < MTOK / 32; it += nw) {
        const int m0 = it * 32;
        bf16x8 A[2][8];
#pragma unroll
        for (int sub = 0; sub < 2; ++sub) {
            const int tok = m0 + sub * 16 + fr, t = tok & (SEQ - 1);
            const bf16_t* zc = z + (size_t)tok * 2816;
            const bf16_t* zp = (t > 0) ? zc - 2816 : zc; const bf16_t* zn = (t < SEQ - 1) ? zc + 2816 : zc;
            const float fp = (t > 0) ? 1.f : 0.f, fn = (t < SEQ - 1) ? 1.f : 0.f;
#pragma unroll
            for (int ks = 0; ks < 8; ++ks) {
                const int col = 1152 + ks * 32 + fq * 8;
                const bf16x8 c8 = *(const bf16x8*)(zc + col), p8 = *(const bf16x8*)(zp + col), n8 = *(const bf16x8*)(zn + col);
#ifdef VEC_MU
                const f32x4 mpa = *(const f32x4*)(mup + col), mpb = *(const f32x4*)(mup + col + 4), mna = *(const f32x4*)(mun + col), mnb = *(const f32x4*)(mun + col + 4);
#endif
                float r[8];
#pragma unroll
                for (int e = 0; e < 8; ++e) {
                    const float x = bf2f((unsigned short)c8[e]), xp = fp * bf2f((unsigned short)p8[e]), xn = fn * bf2f((unsigned short)n8[e]);
#ifdef VEC_MU
                    const float xm = x + (e < 4 ? mpa[e & 3] : mpb[e & 3]) * (xp - x) + (e < 4 ? mna[e & 3] : mnb[e & 3]) * (xn - x);
#else
                    const float xm = x + mup[col + e] * (xp - x) + mun[col + e] * (xn - x);
#endif
                    r[e] = (ks < 2) ? tanhf_(xm) : ((ks < 4) ? xm : sigmoidf_(xm));
                }
                union { uint4 u; bf16x8 v; } cv; cv.u.x = pk2(r[0], r[1]); cv.u.y = pk2(r[2], r[3]); cv.u.z = pk2(r[4], r[5]); cv.u.w = pk2(r[6], r[7]);
                A[sub][ks] = cv.v;
            }
        }
#pragma unroll 1
        for (int nt = 0; nt < 48; ++nt) {
            const bf16x8 b0 = *(const bf16x8*)(w2t + (nt * 16 + fr) * 64 + fq * 8), b1 = *(const bf16x8*)(w2t + (nt * 16 + fr) * 64 + 32 + fq * 8);
            const bf16x8 c0 = *(const bf16x8*)(a2t + (nt * 16 + fr) * 64 + fq * 8), c1 = *(const bf16x8*)(a2t + (nt * 16 + fr) * 64 + 32 + fq * 8);
            const int n0 = nt * 16 + fq * 4;
            const f32x4 w0v = *(const f32x4*)(w0 + n0), a0v = *(const f32x4*)(a0 + n0);
#pragma unroll
            for (int sub = 0; sub < 2; ++sub) {
                const int tok = m0 + sub * 16 + fr;
                f32x4 acc = {0.f, 0.f, 0.f, 0.f}; acc = mfma16(b0, A[sub][0], acc); acc = mfma16(b1, A[sub][1], acc);
                f32x4 aca = {0.f, 0.f, 0.f, 0.f}; aca = mfma16(c0, A[sub][2], aca); aca = mfma16(c1, A[sub][3], aca);
                union { f16_t h[4]; uint2 u; } o1, o2;
#pragma unroll
                for (int j = 0; j < 4; ++j) { o1.h[j] = (f16_t)(0.60653066f * sigmoidf_(w0v[j] + acc[j])); o2.h[j] = (f16_t)sigmoidf_(a0v[j] + aca[j]); }
                wt8u(lam + (size_t)tok * 768 + n0, o1.u); wt8u(aa + (size_t)tok * 768 + n0, o2.u);
            }
        }
#pragma unroll 1
        for (int nt = 0; nt < 24; ++nt) {
            bf16x8 bb[4];
#pragma unroll
            for (int ks = 0; ks < 4; ++ks) bb[ks] = *(const bf16x8*)(g2t + (nt * 16 + fr) * 128 + ks * 32 + fq * 8);
            const int n0 = nt * 16 + fq * 4;
#pragma unroll
            for (int sub = 0; sub < 2; ++sub) {
                const int tok = m0 + sub * 16 + fr;
                f32x4 acc = {0.f, 0.f, 0.f, 0.f};
#pragma unroll
                for (int ks = 0; ks < 4; ++ks) acc = mfma16(bb[ks], A[sub][4 + ks], acc);
                union { f16_t h[4]; uint2 u; } o1;
#pragma unroll
                for (int j = 0; j < 4; ++j) o1.h[j] = (f16_t)acc[j];
                wt8u(gg + (size_t)tok * 384 + n0, o1.u);
            }
        }
    }
}

typedef float f32x2_ __attribute__((ext_vector_type(2)));
struct S5Lane { float lbr, lbi; f32x2_ b2[16]; };
__device__ __forceinline__ void s5_lane_params(const Ctx& p, int l, int d, int g, int pp, S5Lane& q) {
    const int idx = ((l * 2 + d) * 16 + g) * 64 + pp;
    const float are = PIN(20)[idx], aim = PIN(21)[idx], st = __expf(PIN(22)[(l * 2 + d) * 16 + g]);
    const float er = __expf(are * st), ang = aim * st;
    const float kf = rintf(ang * 0.15915494309f); float rr = fmaf(-kf, 6.2831855f, ang); rr = fmaf(-kf, -1.7484555e-7f, rr);
    float sn, cs; __sincosf(rr, &sn, &cs);
    q.lbr = er * cs; q.lbi = er * sn;
    const float nr = q.lbr - 1.f, ni = q.lbi, den = __builtin_amdgcn_rcpf(are * are + aim * aim);
    const float zr = (nr * are + ni * aim) * den, zi = (ni * are - nr * aim) * den;
    const float* br = PIN(23) + ((size_t)(l * 16 + g) * 64 + pp) * 16; const float* bi = PIN(24) + ((size_t)(l * 16 + g) * 64 + pp) * 16;
#pragma unroll
    for (int c = 0; c < 16; ++c) { const float x = br[c], y = bi[c]; q.b2[c] = (f32x2_){zr * x - zi * y, zr * y + zi * x}; }
}
__device__ __forceinline__ void s5_stage_u(const Ctx& p, int b, int c, int gq, LAS float* uf) {
    const bf16_t* z = (const bf16_t*)(PWS + WS_BIG);
#pragma unroll
    for (int i = 0; i < 2; ++i) {
        const int e = TIDX + 512 * i, t = e >> 3, part = e & 7;
        const bf16x8 v = *(const bf16x8*)(z + (size_t)(b * SEQ + c * 128 + t) * 2816 + 2560 + gq * 64 + part * 8);
#pragma unroll
        for (int k = 0; k < 8; ++k) uf[t * 64 + part * 8 + k] = bf2f((unsigned short)v[k]);
    }
}
__device__ __forceinline__ void s5_step(const S5Lane& q, const LAS float* urow, float& hr, float& hi) {
    f32x2_ bu0 = {0.f, 0.f}, bu1 = {0.f, 0.f};
#pragma unroll
    for (int c4 = 0; c4 < 4; ++c4) { const f32x4 u = *(const LAS f32x4*)(urow + c4 * 4);
        bu0 += q.b2[c4 * 4 + 0] * (f32x2_){u[0], u[0]}; bu1 += q.b2[c4 * 4 + 1] * (f32x2_){u[1], u[1]};
        bu0 += q.b2[c4 * 4 + 2] * (f32x2_){u[2], u[2]}; bu1 += q.b2[c4 * 4 + 3] * (f32x2_){u[3], u[3]}; }
    const f32x2_ bu = bu0 + bu1;
    const float nr = q.lbr * hr - q.lbi * hi + bu[0], ni = q.lbr * hi + q.lbi * hr + bu[1]; hr = nr; hi = ni;
}
__device__ __forceinline__ void s5_passA_item(const Ctx& p, int l, int item, LAS unsigned char* lds) {
    const int gq = item & 3, c = (item >> 2) & 63, b = item >> 8;
    const int wid = TIDX >> 6, lane = TIDX & 63, gi = wid >> 1, d = wid & 1, g = gq * 4 + gi;
    LAS float* uf = (LAS float*)lds;
    __syncthreads();
    s5_stage_u(p, b, c, gq, uf);
    S5Lane q; s5_lane_params(p, l, d, g, lane, q);
    __syncthreads();
    float hr = 0.f, hi = 0.f;
    for (int s = 0; s < 128; ++s) { const int ti = d ? 127 - s : s; s5_step(q, uf + ti * 64 + gi * 16, hr, hi); }
    float2* E = (float2*)(PWS + WS_S5E);
    wt8(&E[((size_t)((b * 16 + g) * 2 + d) * 64 + c) * 64 + lane], ((unsigned long long)__float_as_uint(hi) << 32) | __float_as_uint(hr));
}
__device__ __forceinline__ void s5_passC_item(const Ctx& p, int l, int item, LAS unsigned char* lds) {
    const int gq = item & 3, c = (item >> 2) & 63, b = item >> 8;
    const int tid = TIDX, wid = tid >> 6, lane = tid & 63, gi = wid >> 1, d = wid & 1, g = gq * 4 + gi, fr = lane & 15, fq = lane >> 4;
    LAS float* uf = (LAS float*)lds;
    LAS bf16_t* hs = (LAS bf16_t*)(lds + 32768) + wid * 16 * 136;
    LAS float* yl = (LAS float*)(lds + 32768 + 34816);
    __syncthreads();
    s5_stage_u(p, b, c, gq, uf);
    S5Lane q; s5_lane_params(p, l, d, g, lane, q);
    bf16x8 Cf[4];
    {
        const float* cre = PIN(25) + ((size_t)((l * 2 + d) * 16 + g) * 16 + fr) * 64; const float* cim = PIN(26) + ((size_t)((l * 2 + d) * 16 + g) * 16 + fr) * 64;
#pragma unroll
        for (int ks = 0; ks < 4; ++ks) { const int q0 = ks * 32 + fq * 8; float r[8];
#pragma unroll
            for (int e = 0; e < 8; ++e) r[e] = (q0 < 64) ? cre[q0 + e] : -cim[q0 - 64 + e];
            union { uint4 u; bf16x8 v; } cv; cv.u.x = pk2(r[0], r[1]); cv.u.y = pk2(r[2], r[3]); cv.u.z = pk2(r[4], r[5]); cv.u.w = pk2(r[6], r[7]); Cf[ks] = cv.v; }
    }
    float hr = 0.f, hi = 0.f;
    {
        float tr = q.lbr, ti = q.lbi;
#pragma unroll
        for (int k = 0; k < 7; ++k) { const float a = tr * tr - ti * ti, bq = 2.f * tr * ti; tr = a; ti = bq; }
        const float2* E = (const float2*)(PWS + WS_S5E) + ((size_t)((b * 16 + g) * 2 + d) * 64) * 64 + lane;
        if (d == 0) { for (int cc = 0; cc < c; ++cc) { const float2 e = E[(size_t)cc * 64]; const float nr = tr * hr - ti * hi + e.x, ni = tr * hi + ti * hr + e.y; hr = nr; hi = ni; } }
        else { for (int cc = 63; cc > c; --cc) { const float2 e = E[(size_t)cc * 64]; const float nr = tr * hr - ti * hi + e.x, ni = tr * hi + ti * hr + e.y; hr = nr; hi = ni; } }
    }
    __syncthreads();
    {
        const float* dsk = PIN(27) + l * 256 + gq * 64;
        for (int e = tid; e < 128 * 64; e += 512) { const int t = e >> 6, ch = e & 63; yl[((ch >> 4) * 128 + t) * 17 + (ch & 15)] = dsk[ch] * uf[e]; }
    }
    for (int sub = 0; sub < 8; ++sub) {
        for (int s16 = 0; s16 < 16; ++s16) {
            const int s = sub * 16 + s16, ti = d ? 127 - s : s;
            s5_step(q, uf + ti * 64 + gi * 16, hr, hi);
            const unsigned pk = pk2(hr, hi);
            hs[(ti & 15) * 136 + lane] = (bf16_t)(pk & 0xffffu); hs[(ti & 15) * 136 + 64 + lane] = (bf16_t)(pk >> 16);
        }
        __syncthreads();
        {
            f32x4 acc = {0.f, 0.f, 0.f, 0.f};
#pragma unroll
            for (int ks = 0; ks < 4; ++ks) { const bf16x8 af = *(const LAS bf16x8*)(hs + fr * 136 + ks * 32 + fq * 8); acc = mfma16(Cf[ks], af, acc); }
            const int tile = d ? 7 - sub : sub;
            LAS float* yp = yl + (gi * 128 + tile * 16 + fr) * 17 + fq * 4;
#pragma unroll
            for (int j = 0; j < 4; ++j) yp[j] += acc[j];
        }
        __syncthreads();
    }
    {
        bf16_t* yo = (bf16_t*)(PWS + WS_YPRE);
        const int t = tid >> 2, g4 = tid & 3;
        float r[16];
#pragma unroll
        for (int k = 0; k < 16; ++k) { const float x = yl[(g4 * 128 + t) * 17 + k]; r[k] = 0.5f * x * (1.f + tanhf_(0.7978845608f * (x + 0.044715f * x * x * x))); }
        uint4 o0, o1; o0.x = pk2(r[0], r[1]); o0.y = pk2(r[2], r[3]); o0.z = pk2(r[4], r[5]); o0.w = pk2(r[6], r[7]); o1.x = pk2(r[8], r[9]); o1.y = pk2(r[10], r[11]); o1.z = pk2(r[12], r[13]); o1.w = pk2(r[14], r[15]);
        bf16_t* dst = yo + (size_t)(b * SEQ + c * 128 + t) * 256 + gq * 64 + g4 * 16;
        wt16(dst, o0); wt16(dst + 8, o1);
    }
}

constexpr int SC_T = 32, SC_ROW = 352;
struct ScanRaw { unsigned zr[10], zk[10], zv[10], ar[8], lr[8]; };
__device__ __forceinline__ void scan_load_raw(ScanRaw& R, const bf16_t* zb, const unsigned short* ab, const unsigned short* lb, int tlo, int h, int hf, int d, int lane) {
#pragma unroll
    for (int r = 0; r < 10; ++r) {
        int tok = tlo - 1 + r; tok = tok < 0 ? 0 : (tok > SEQ - 1 ? SEQ - 1 : tok);
        const bf16_t* zp = zb + (size_t)tok * 2816 + h * 64;
        R.zr[r] = zp[lane]; R.zk[r] = zp[384 + lane]; R.zv[r] = zp[768 + hf * 32 + (lane & 31)];
    }
#pragma unroll
    for (int i = 0; i < 8; ++i) { const size_t o = (size_t)(tlo + i) * 768 + d * 384 + h * 64 + lane; R.ar[i] = ab[o]; R.lr[i] = lb[o]; }
}
__device__ __forceinline__ float row16_sum_asm(float x) {
    asm volatile("s_nop 1\n\tv_add_f32_dpp %0, %0, %0 row_ror:8 row_mask:0xf bank_mask:0xf\n\ts_nop 1\n\tv_add_f32_dpp %0, %0, %0 row_ror:4 row_mask:0xf bank_mask:0xf\n\ts_nop 1\n\tv_add_f32_dpp %0, %0, %0 row_ror:2 row_mask:0xf bank_mask:0xf\n\ts_nop 1\n\tv_add_f32_dpp %0, %0, %0 row_ror:1 row_mask:0xf bank_mask:0xf" : "+v"(x));
    return x; }
#define DPP_ADD(x, CTRL) ((x) + __builtin_bit_cast(float, __builtin_amdgcn_update_dpp(0, __builtin_bit_cast(int, (x)), (CTRL), 0xf, 0xf, false)))
__device__ __forceinline__ float red8(float x) {
    x = DPP_ADD(x, 0x141); x = DPP_ADD(x, 0x1B); x = DPP_ADD(x, 0xB1); return x;
}
__device__ __forceinline__ float dot4(f32x4 a, f32x4 b) { return a[0] * b[0] + a[1] * b[1] + a[2] * b[2] + a[3] * b[3]; }
typedef float f32p __attribute__((ext_vector_type(2)));
__device__ __forceinline__ float dot8(f32x4 sa, f32x4 sb, f32x4 a, f32x4 b) {
    f32p acc = __builtin_shufflevector(sa, sa, 0, 1) * __builtin_shufflevector(a, a, 0, 1);
    acc += __builtin_shufflevector(sa, sa, 2, 3) * __builtin_shufflevector(a, a, 2, 3);
    acc += __builtin_shufflevector(sb, sb, 0, 1) * __builtin_shufflevector(b, b, 0, 1);
    acc += __builtin_shufflevector(sb, sb, 2, 3) * __builtin_shufflevector(b, b, 2, 3);
    return acc[0] + acc[1];
}
__device__ __forceinline__ float f16bits2f(unsigned u) { union { unsigned short s; f16_t h; } c; c.s = (unsigned short)u; return (float)c.h; }
__device__ __forceinline__ void rwkv_scan_item(const Ctx& p, int l, int item, LAS unsigned char* lds) {
    const int chain = item >> 1, hf = item & 1, d = chain & 1, h = (chain >> 1) % 6, b = chain / 12;
    const int tid = TIDX, wid = __builtin_amdgcn_readfirstlane(tid >> 6), lane = tid & 63;
    LAS float* buf = (LAS float*)lds;
    const bf16_t* zb = (const bf16_t*)(PWS + WS_BIG) + (size_t)b * SEQ * 2816;
    __syncthreads();
    if (wid < 4) {
        const int j = lane & 7, rg = lane >> 3, row = wid * 8 + rg;
        bf16_t* yy = (bf16_t*)(PWS + WS_YY) + ((size_t)(((d * 8 + b) * 6 + h) * 2 + hf) * SEQ) * 32 + row;
        f32x4 Sa = {0.f, 0.f, 0.f, 0.f}, Sb = Sa; float ys = 0.f;
        __builtin_amdgcn_s_setprio(3);
        for (int c = 0; c < SEQ / SC_T; ++c) {
            __syncthreads();
            const LAS float* bb = buf + (c & 1) * SC_T * SC_ROW + 8 * j;
            const LAS float* vb = buf + (c & 1) * SC_T * SC_ROW + 320 + row;
            struct Ops { f32x4 wa, wb, na, nb, aa, ab, da, db, ra, rb; float v; };
            auto ld = [&](Ops& o, int s) {
                const LAS float* st = bb + s * SC_ROW;
                o.wa = *(const LAS f32x4*)(st); o.wb = *(const LAS f32x4*)(st + 4); o.na = *(const LAS f32x4*)(st + 64); o.nb = *(const LAS f32x4*)(st + 68); o.aa = *(const LAS f32x4*)(st + 128); o.ab = *(const LAS f32x4*)(st + 132);
                o.da = *(const LAS f32x4*)(st + 192); o.db = *(const LAS f32x4*)(st + 196); o.ra = *(const LAS f32x4*)(st + 256); o.rb = *(const LAS f32x4*)(st + 260);
                o.v = vb[s * SC_ROW];
            };
            auto stepf = [&](const Ops& o, int s) {
                float sa = dot8(Sa, Sb, o.na, o.nb);
                const f32x4 ta = Sa * o.wa + o.v * o.da, tb = Sb * o.wb + o.v * o.db;
                sa = red8(sa);
                Sa = ta + sa * o.aa; Sb = tb + sa * o.ab;
                float y = dot8(Sa, Sb, o.ra, o.rb);
                y = red8(y);
                if (j == (s & 7)) ys = y;
                if ((s & 7) == 7) {
                    const int sidx = c * SC_T + (s & ~7) + j, t = d ? SEQ - 1 - sidx : sidx;
                    wt2(&yy[(size_t)t * 32], (unsigned short)(pk2(ys, 0.f) & 0xffffu));
                }
            };
            Ops A, B;
            ld(A, 0);
#pragma unroll 4
            for (int s = 0; s < SC_T; s += 2) {
                ld(B, s + 1);
                stepf(A, s);
                if (s + 2 < SC_T) ld(A, s + 2);
                stepf(B, s + 1);
            }
        }
        __builtin_amdgcn_s_setprio(0);
    } else {
        const int lw = wid - 4;
        const unsigned short* ab = (const unsigned short*)(PWS + WS_AA) + (size_t)b * SEQ * 768;
        const unsigned short* lb = (const unsigned short*)(PWS + WS_LAM) + (size_t)b * SEQ * 768;
        float* cb = (float*)(PWS + WS_CB);
        const float* mup = PIN(8) + l * 1408; const float* mun = PIN(9) + l * 1408;
        const int cr = h * 64 + lane, cv = 768 + h * 64 + hf * 32 + (lane & 31);
        const float mpr = mup[cr], mnr = mun[cr], mpk = mup[384 + cr], mnk = mun[384 + cr], mpv = mup[cv], mnv = mun[cv];
        const float kkc = PIN(15)[l * 384 + cr], kac = PIN(16)[l * 384 + cr], rkc = PIN(17)[l * 384 + cr];
        ScanRaw Rc, Rn;
        auto tlo_of = [&](int c) { const int s0 = c * SC_T + lw * 8; return d ? SEQ - 1 - (s0 + 7) : s0; };
        auto process = [&](const ScanRaw& R, int c) {
            const int tlo = tlo_of(c);
            LAS float* nb = buf + (c & 1) * SC_T * SC_ROW;
            float fr_[10], fk_[10], fv_[10];
#pragma unroll
            for (int r = 0; r < 10; ++r) { const int tok = tlo - 1 + r; const float ok = (tok >= 0 && tok < SEQ) ? 1.f : 0.f;
                fr_[r] = ok * bf2f((unsigned short)R.zr[r]); fk_[r] = ok * bf2f((unsigned short)R.zk[r]); fv_[r] = ok * bf2f((unsigned short)R.zv[r]); }
            float r_[8], k_[8], v_[8], a_[8], w_[8], kk_[8], kd_[8], ss_[8], cb_[8];
#pragma unroll
            for (int i = 0; i < 8; ++i) {
                r_[i] = fr_[i + 1] + mpr * (fr_[i] - fr_[i + 1]) + mnr * (fr_[i + 2] - fr_[i + 1]);
                k_[i] = fk_[i + 1] + mpk * (fk_[i] - fk_[i + 1]) + mnk * (fk_[i + 2] - fk_[i + 1]);
                v_[i] = fv_[i + 1] + mpv * (fv_[i] - fv_[i + 1]) + mnv * (fv_[i + 2] - fv_[i + 1]);
                a_[i] = f16bits2f(R.ar[i]); w_[i] = __expf(-f16bits2f(R.lr[i]));
                kk_[i] = k_[i] * kkc; kd_[i] = k_[i] * (1.f + (a_[i] - 1.f) * kac);
                ss_[i] = row16_sum(kk_[i] * kk_[i]); cb_[i] = (hf == 0) ? row16_sum(r_[i] * kd_[i] * rkc) : 0.f;
            }
            {
                float t1[8], t2[8];
#pragma unroll
                for (int i = 0; i < 8; ++i) { t1[i] = shx(ss_[i], 16, lane); if (hf == 0) t2[i] = shx(cb_[i], 16, lane); }
#pragma unroll
                for (int i = 0; i < 8; ++i) { ss_[i] += t1[i]; if (hf == 0) cb_[i] += t2[i]; }
#pragma unroll
                for (int i = 0; i < 8; ++i) { t1[i] = shx(ss_[i], 32, lane); if (hf == 0) t2[i] = shx(cb_[i], 32, lane); }
#pragma unroll
                for (int i = 0; i < 8; ++i) { ss_[i] += t1[i]; if (hf == 0) cb_[i] += t2[i]; }
            }
#pragma unroll
            for (int i = 0; i < 8; ++i) {
                const float kh = kk_[i] * rsqrtf(ss_[i] + 1e-12f);
                const int slot = lw * 8 + (d ? 7 - i : i);
                LAS float* st = nb + slot * SC_ROW;
                st[lane] = w_[i]; st[64 + lane] = -kh; st[128 + lane] = kh * a_[i]; st[192 + lane] = kd_[i]; st[256 + lane] = r_[i]; if (lane < 32) st[320 + lane] = v_[i];
                if (hf == 0 && lane == 0) wt4(&cb[(size_t)((d * 8 + b) * 6 + h) * SEQ + tlo + i], __float_as_uint(cb_[i]));
            }
        };
        scan_load_raw(Rc, zb, ab, lb, tlo_of(0), h, hf, d, lane);
        scan_load_raw(Rn, zb, ab, lb, tlo_of(1), h, hf, d, lane);
        process(Rc, 0);
        for (int c = 0; c < SEQ / SC_T; ++c) {
            __syncthreads();
            if (c + 1 < SEQ / SC_T) {
                Rc = Rn;
                if (c + 2 < SEQ / SC_T) scan_load_raw(Rn, zb, ab, lb, tlo_of(c + 2), h, hf, d, lane);
                process(Rc, c + 1);
            }
        }
    }
}

__device__ __forceinline__ void rwkv_post_phase(const Ctx& p, int l) {
    const bf16_t* z = (const bf16_t*)(PWS + WS_BIG); const bf16_t* yy = (const bf16_t*)(PWS + WS_YY);
    const unsigned short* gg = (const unsigned short*)(PWS + WS_GG); const float* cb = (const float*)(PWS + WS_CB);
    bf16_t* O = (bf16_t*)(PWS + WS_XN);
    const float* mup = PIN(8) + l * 1408 + 768; const float* mun = PIN(9) + l * 1408 + 768;
    const float* lw_ = PIN(18) + l * 384; const float* lb_ = PIN(19) + l * 384;
    const int lane = TIDX & 63, gw = BIDX * 8 + (TIDX >> 6), nw = GDIM * 8;
    const int sub = lane >> 5, c2 = (lane & 31) * 2;
    float mp_[3][2], mn_[3][2], lwv[3][2], lbv[3][2];
#pragma unroll
    for (int k = 0; k < 3; ++k)
#pragma unroll
        for (int e = 0; e < 2; ++e) { const int col = (2 * k + sub) * 64 + c2 + e; mp_[k][e] = mup[col]; mn_[k][e] = mun[col]; lwv[k][e] = lw_[col]; lbv[k][e] = lb_[col]; }
    for (int tok = gw; tok < MTOK; tok += nw) {
        const int t = tok & (SEQ - 1), bb_ = tok >> 13;
        float y[3][2], vc[3][2], vp[3][2], vn[3][2], c0[3], c1[3], gv[3][2];
#pragma unroll
        for (int k = 0; k < 3; ++k) {
            const int h = 2 * k + sub, col = h * 64 + c2;
            const size_t yo = ((size_t)((bb_ * 6 + h) * 2 + (c2 >> 5)) * SEQ + t) * 32 + (c2 & 31);
            const unsigned u0 = *(const unsigned*)(yy + yo), u1 = *(const unsigned*)(yy + yo + (size_t)8 * 6 * 2 * SEQ * 32);
            y[k][0] = __uint_as_float(u0 << 16) + __uint_as_float(u1 << 16); y[k][1] = __uint_as_float(u0 & 0xffff0000u) + __uint_as_float(u1 & 0xffff0000u);
            const bf16_t* zc = z + (size_t)tok * 2816 + 768 + col;
            const unsigned uc = *(const unsigned*)zc, up = (t > 0) ? *(const unsigned*)(zc - 2816) : 0u, un = (t < SEQ - 1) ? *(const unsigned*)(zc + 2816) : 0u;
            vc[k][0] = __uint_as_float(uc << 16); vc[k][1] = __uint_as_float(uc & 0xffff0000u);
            vp[k][0] = __uint_as_float(up << 16); vp[k][1] = __uint_as_float(up & 0xffff0000u);
            vn[k][0] = __uint_as_float(un << 16); vn[k][1] = __uint_as_float(un & 0xffff0000u);
            c0[k] = cb[(size_t)(bb_ * 6 + h) * SEQ + t]; c1[k] = cb[(size_t)((8 + bb_) * 6 + h) * SEQ + t];
            const unsigned ug = *(const unsigned*)(gg + (size_t)tok * 384 + col);
            gv[k][0] = f16bits2f(ug & 0xffffu); gv[k][1] = f16bits2f(ug >> 16);
        }
        float m_[3], q_[3], t_[3];
#pragma unroll
        for (int k = 0; k < 3; ++k) m_[k] = row16_sum(y[k][0] + y[k][1]);
#pragma unroll
        for (int k = 0; k < 3; ++k) t_[k] = shx(m_[k], 16, lane);
#pragma unroll
        for (int k = 0; k < 3; ++k) { m_[k] = (m_[k] + t_[k]) * (1.f / 64.f); const float d0 = y[k][0] - m_[k], d1 = y[k][1] - m_[k]; q_[k] = row16_sum(d0 * d0 + d1 * d1); }
#pragma unroll
        for (int k = 0; k < 3; ++k) t_[k] = shx(q_[k], 16, lane);
#pragma unroll
        for (int k = 0; k < 3; ++k) {
            const float var = (q_[k] + t_[k]) * (1.f / 64.f), rs = rsqrtf(var + 64e-5f), cc = c0[k] + c1[k];
            float o[2];
#pragma unroll
            for (int e = 0; e < 2; ++e) {
                const float v = vc[k][e] + mp_[k][e] * (vp[k][e] - vc[k][e]) + mn_[k][e] * (vn[k][e] - vc[k][e]);
                o[e] = ((y[k][e] - m_[k]) * rs * lwv[k][e] + lbv[k][e] + cc * v) * gv[k][e];
            }
            wt4(&O[(size_t)tok * 1024 + (2 * k + sub) * 64 + c2], pk2(o[0], o[1]));
        }
    }
}

struct AttnPre { u32x4 k[6]; u32x4 v[6]; bf16x8 q[2]; };
__device__ __forceinline__ void attn_issue(AttnPre& P, const bf16_t* zb, int h, int sp, int step, int tid, int lane) {
    const int pi = step >> 3, rnd = step & 7, dsh = 2 * pi, dm1 = (1 << dsh) - 1, n = SEQ >> dsh;
    int tt = tid & 255; LAUNDER(tt);
    const int s = tid >> 8, uidx = rnd * 2 + s, r = uidx & dm1, lb = uidx >> dsh, i = sp * (16 >> dsh) + lb, jbase = 64 * (i - 1);
#pragma unroll
    for (int it = 0; it < 6; ++it) {
        const int cid = tt + 256 * it, row = cid >> 3, part = cid & 7, jj = jbase + row; const bool ok = (jj >= 0 && jj < n);
        u32x4 v = {0u, 0u, 0u, 0u};
        if (ok) v = *(const u32x4*)(zb + (size_t)(r + (jj << dsh)) * 2816 + 1792 + h * 64 + part * 8);
        P.k[it] = v;
    }
#pragma unroll
    for (int it = 0; it < 3; ++it) {
        const int cid = tt + 256 * it, rp = cid % 96, part = cid / 96;
#pragma unroll
        for (int hh = 0; hh < 2; ++hh) { const int jj = jbase + 2 * rp + hh; const bool ok = (jj >= 0 && jj < n);
            u32x4 v = {0u, 0u, 0u, 0u};
            if (ok) v = *(const u32x4*)(zb + (size_t)(r + (jj << dsh)) * 2816 + 2176 + h * 64 + part * 8);
            P.v[it * 2 + hh] = v; }
    }
    {
        const int wid = tid >> 6, sl = wid >> 2, wq = wid & 3, fr = lane & 15, fq = lane >> 4;
        const int u2 = rnd * 2 + sl, r2 = u2 & dm1, lb2 = u2 >> dsh, i2 = sp * (16 >> dsh) + lb2, posq = r2 + ((64 * i2 + wq * 16 + fr) << dsh);
#pragma unroll
        for (int ks = 0; ks < 2; ++ks) P.q[ks] = *(const bf16x8*)(zb + (size_t)posq * 2816 + 1408 + h * 64 + ks * 32 + fq * 8);
    }
}
__device__ __forceinline__ void attn_item(const Ctx& p, int item, LAS unsigned char* lds) {
    const int sp = item & 7, h = (item >> 3) % 6, b = item / 48;
    const int tid = TIDX, wid = tid >> 6, lane = tid & 63, sl = wid >> 2, wq = wid & 3;
    LAS bf16_t* Ks = (LAS bf16_t*)lds;
    LAS bf16_t* Vt = Ks + 2 * 192 * 80;
    const bf16_t* zb = (const bf16_t*)(PWS + WS_BIG) + (size_t)b * SEQ * 2816;
    bf16_t* O = (bf16_t*)(PWS + WS_XN); float* lsebuf = (float*)(PWS + WS_LSE);
    const float slope = (h == 0) ? 0.25f : (h == 1) ? 0.0625f : (h == 2) ? 0.015625f : (h == 3) ? 0.00390625f : (h == 4) ? 0.5f : 0.125f;
    AttnPre P;
    attn_issue(P, zb, h, sp, 0, tid, lane);
#pragma unroll 1
    for (int step = 0; step < 24; ++step) {
        const int pi = step >> 3, rnd = step & 7, dsh = 2 * pi, dm1 = (1 << dsh) - 1, n = SEQ >> dsh;
        __syncthreads();
        {
            int tt = tid & 255; LAUNDER(tt);
            const int s = tid >> 8;
#pragma unroll
            for (int it = 0; it < 6; ++it) { const int cid = tt + 256 * it, row = cid >> 3, part = cid & 7; *(LAS u32x4*)(Ks + (s * 192 + row) * 80 + part * 8) = P.k[it]; }
#pragma unroll
            for (int it = 0; it < 3; ++it) { const int cid = tt + 256 * it, rp = cid % 96, part = cid / 96; const u32x4 a = P.v[it * 2], c = P.v[it * 2 + 1];
#pragma unroll
                for (int e = 0; e < 4; ++e) {
                    *(LAS unsigned*)(Vt + (s * 64 + part * 8 + 2 * e) * 200 + 2 * rp) = (a[e] & 0xffffu) | (c[e] << 16);
                    *(LAS unsigned*)(Vt + (s * 64 + part * 8 + 2 * e + 1) * 200 + 2 * rp) = (a[e] >> 16) | (c[e] & 0xffff0000u);
                } }
        }
        const bf16x8 qf0 = P.q[0], qf1 = P.q[1];
        if (step + 1 < 24) attn_issue(P, zb, h, sp, step + 1, tid, lane);
        __syncthreads();
        {
            const int uidx = rnd * 2 + sl, r = uidx & dm1, lb = uidx >> dsh, i = sp * (16 >> dsh) + lb;
            int fr = lane & 15, fq = lane >> 4; LAUNDER(fr); LAUNDER(fq);
            const int qi = wq * 16 + fr, posq = r + ((64 * i + qi) << dsh); const size_t tokq = (size_t)b * SEQ + posq;
            bf16_t* op = O + tokq * 1024 + 384 + h * 64 + fq * 4; float* lp = lsebuf + (size_t)(b * 6 + h) * SEQ + posq;
            float lprev = 0.f; unsigned long long pq[4] = {0ull, 0ull, 0ull, 0ull};
            if (pi > 0) { lprev = __hip_atomic_load(lp, __ATOMIC_RELAXED, __HIP_MEMORY_SCOPE_AGENT);
#pragma unroll
                for (int dt = 0; dt < 4; ++dt) pq[dt] = __hip_atomic_load((const unsigned long long*)(op + dt * 16), __ATOMIC_RELAXED, __HIP_MEMORY_SCOPE_AGENT); }
            f32x4 sacc[12];
#pragma unroll
            for (int kt = 0; kt < 12; ++kt) { f32x4 acc = {0.f, 0.f, 0.f, 0.f};
                acc = mfma16(*(const LAS bf16x8*)(Ks + (sl * 192 + kt * 16 + fr) * 80 + fq * 8), qf0, acc);
                acc = mfma16(*(const LAS bf16x8*)(Ks + (sl * 192 + kt * 16 + fr) * 80 + 32 + fq * 8), qf1, acc);
                sacc[kt] = acc; }
            const float basef = (float)(fq * 4 - 64 - qi), sd2 = slope * (float)(1 << dsh) * 1.44269504f;
            const bool edge = (i == 0) || (64 * (i + 2) > n);
            float mx = -1e30f;
#pragma unroll
            for (int kt = 0; kt < 12; ++kt)
#pragma unroll
                for (int jj = 0; jj < 4; ++jj) { const float ar = fabsf((float)(kt * 16 + jj) + basef); bool ok = ar <= 64.f;
                    if (edge) { const int jk = 64 * (i - 1) + kt * 16 + fq * 4 + jj; ok = ok && (jk >= 0) && (jk < n); }
                    const float lg = ok ? fmaf(sacc[kt][jj], 0.125f * 1.44269504f, -sd2 * ar) : -1e30f; sacc[kt][jj] = lg; mx = fmaxf(mx, lg); }
            mx = fmaxf(mx, shx(mx, 16, lane)); mx = fmaxf(mx, shx(mx, 32, lane));
            float lsum = 0.f;
#pragma unroll
            for (int kt = 0; kt < 12; ++kt)
#pragma unroll
                for (int jj = 0; jj < 4; ++jj) { const float pv = __builtin_amdgcn_exp2f(sacc[kt][jj] - mx); sacc[kt][jj] = pv; lsum += pv; }
            lsum += shx(lsum, 16, lane); lsum += shx(lsum, 32, lane);
            f32x4 oacc[4];
#pragma unroll
            for (int dt = 0; dt < 4; ++dt) oacc[dt] = (f32x4){0.f, 0.f, 0.f, 0.f};
#pragma unroll
            for (int kk = 0; kk < 6; ++kk) {
                union { uint4 u; bf16x8 v; } pf; pf.u.x = pk2(sacc[2 * kk][0], sacc[2 * kk][1]); pf.u.y = pk2(sacc[2 * kk][2], sacc[2 * kk][3]); pf.u.z = pk2(sacc[2 * kk + 1][0], sacc[2 * kk + 1][1]); pf.u.w = pk2(sacc[2 * kk + 1][2], sacc[2 * kk + 1][3]);
#pragma unroll
                for (int dt = 0; dt < 4; ++dt) {
                    const LAS bf16_t* vp = Vt + (sl * 64 + dt * 16 + fr) * 200 + kk * 32 + fq * 4;
                    union { u32x2 h[2]; bf16x8 v; } vf; vf.h[0] = *(const LAS u32x2*)vp; vf.h[1] = *(const LAS u32x2*)(vp + 16);
                    oacc[dt] = mfma16(vf.v, pf.v, oacc[dt]);
                }
            }
            const float inv = __builtin_amdgcn_rcpf(lsum); float lse = mx * 0.69314718f + __logf(lsum);
            float wn = inv, wp = 0.f;
            if (pi > 0) { const float L = fmaxf(lprev, lse); const float ep = __expf(lprev - L), en = __expf(lse - L); const float den = __builtin_amdgcn_rcpf(ep + en);
                wp = ep * den; wn = en * den * inv; lse = L + __logf(ep + en); }
#pragma unroll
            for (int dt = 0; dt < 4; ++dt) {
                float o0 = oacc[dt][0] * wn, o1 = oacc[dt][1] * wn, o2 = oacc[dt][2] * wn, o3 = oacc[dt][3] * wn;
                if (pi > 0) { const unsigned px = (unsigned)pq[dt], py = (unsigned)(pq[dt] >> 32);
                    o0 += wp * __uint_as_float(px << 16); o1 += wp * __uint_as_float(px & 0xffff0000u); o2 += wp * __uint_as_float(py << 16); o3 += wp * __uint_as_float(py & 0xffff0000u); }
                uint2 ov; ov.x = pk2(o0, o1); ov.y = pk2(o2, o3); wt8u(op + dt * 16, ov);
            }
            if (fq == 0) wt4(lp, __float_as_uint(lse));
        }
    }
}
#ifndef DUP_MASK
#define DUP_MASK 7
#endif

__device__ __forceinline__ void zero_cols(const Ctx& p, bf16_t* O, int c0, int ncols) {
    const int per = ncols >> 3; const size_t total = (size_t)MTOK * per;
    for (size_t i = (size_t)BIDX * 512 + TIDX; i < total; i += (size_t)GDIM * 512) { const size_t row = i / per; const int pc = (int)(i % per); *(uint4*)(O + row * 1024 + c0 + pc * 8) = make_uint4(0u, 0u, 0u, 0u); }
}
__device__ __forceinline__ void mixer_phase(const Ctx& p, int l, LAS unsigned char* lds, int rep = 0) {
    unsigned* ctr = (unsigned*)(PWS + WS_CTR) + l + 2 * rep;
    LAS int* sitem = (LAS int*)(lds + 131072);
    for (;;) {
        __syncthreads();
        if (TIDX == 0) *sitem = (int)atomicAdd(ctr, 1u);
        __syncthreads();
        const int item = __builtin_amdgcn_readfirstlane(*sitem);
        if (item >= 192 + 384 + 2048) break;
        if (item < 192) {
#if EN_RWKV
            if (!rep || (DUP_MASK & 1)) rwkv_scan_item(p, l, item, lds);
#endif
        } else if (item < 576) {
#if EN_ATTN
            if (!rep || (DUP_MASK & 2)) attn_item(p, item - 192, lds);
#endif
        } else {
#if EN_S5
            if (!rep || (DUP_MASK & 4)) s5_passC_item(p, l, item - 576, lds);
#endif
        }
    }
}
constexpr int NPH = 25;
__device__ __forceinline__ void run_phase(const Ctx& p, int ph, LAS unsigned char* lds) {
    bf16_t* XN = (bf16_t*)(PWS + WS_XN); bf16_t* BIG = (bf16_t*)(PWS + WS_BIG);
    if (ph == 0) {
#ifdef DUP_W
        weights_phase(p, lds);
#endif
        weights_phase(p, lds);
        if (BIDX == 0 && TIDX < 128) ((unsigned*)(PWS + WS_CTR))[TIDX] = 0u;
        norm_phase(p, PIN(0), PIN(1), XN, nullptr);
        return;
    }
    const int l = (ph - 1) / 12, k = (ph - 1) % 12;
    const unsigned char* wl = PWS + WS_WB + (size_t)l * WL_SIZE;
    switch (k) {
    case 0: case 9: {
#if EN_FFN
        EpiSwiGLU E; E.wv = p.wv; E.O = BIG;
#ifdef DUP_GU
        for (int rep = 0; rep < 2; ++rep)
#endif
        gemm_run(p, lds, XN, (const bf16_t*)(wl + (k == 0 ? WL_GU1 : WL_GU2)), 5632, 1024, E);
#endif
    } break;
    case 1: case 10: {
        const float* hin = (l == 0 && k == 1) ? PIN(0) : POUT;
#if EN_FFN
        EpiResid E; E.wv = p.wv; E.hin = hin; E.hout = POUT; E.alpha = 0.5f; gemm_run(p, lds, BIG, (const bf16_t*)(wl + (k == 1 ? WL_D1 : WL_D2)), 1024, 2816, E);
#else
        if (l == 0 && k == 1) { for (size_t i = (size_t)BIDX * 512 + TIDX; i < (size_t)MTOK * 256; i += (size_t)GDIM * 512) ((float4*)POUT)[i] = ((const float4*)hin)[i]; }
#endif
    } break;
    case 2: norm_phase(p, POUT, PIN(5) + l * 1024, XN, nullptr);
#ifdef DUP_NORM
        norm_phase(p, POUT, PIN(5) + l * 1024, XN, nullptr); norm_phase(p, POUT, PIN(5) + l * 1024, XN, nullptr); norm_phase(p, POUT, PIN(5) + l * 1024, XN, nullptr);
#endif
        break;
    case 3: { EpiZ E; E.wv = p.wv; E.O = BIG; gemm_run(p, lds, XN, (const bf16_t*)(wl + WL_IN), 2816, 1024, E); } break;
    case 4: {
#if EN_RWKV
        rwkv_prep_phase(p, l);
#ifdef DUP_PREP
        rwkv_prep_phase(p, l);
#endif
#endif
#if EN_S5
        for (int item = BIDX; item < 2048; item += GDIM) s5_passA_item(p, l, item, lds);
#ifdef DUP_PASSA
        for (int item = BIDX; item < 2048; item += GDIM) s5_passA_item(p, l, item, lds);
#endif
#endif
    } break;
    case 5: mixer_phase(p, l, lds); break;
    case 6: {
#if EN_S5
        { EpiGLU E; E.wv = p.wv; E.O = XN; E.bias = PIN(29) + l * 512; gemm_run(p, lds, (const bf16_t*)(PWS + WS_YPRE), (const bf16_t*)(wl + WL_GLU), 512, 256, E); }
#else
        zero_cols(p, XN, 768, 256);
#endif
#if EN_RWKV
        rwkv_post_phase(p, l);
#ifdef DUP_POST
        rwkv_post_phase(p, l);
#endif
#else
        zero_cols(p, XN, 0, 384);
#endif
#if !EN_ATTN
        zero_cols(p, XN, 384, 384);
#endif
    } break;
    case 7: { EpiResid E; E.wv = p.wv; E.hin = POUT; E.hout = POUT; E.alpha = 1.0f; gemm_run(p, lds, XN, (const bf16_t*)(wl + WL_OUT), 1024, 1024, E); } break;
    case 8: norm_phase(p, POUT, PIN(30) + l * 1024, XN, nullptr); break;
    case 11: if (l == 0) norm_phase(p, POUT, PIN(1) + 1024, XN, nullptr); else norm_phase(p, POUT, PIN(34), nullptr, POUT); break;
    }
}

__global__ void __launch_bounds__(512, 2) mega(Params kp, int ph_lo, int ph_hi) {
    extern __shared__ __attribute__((aligned(16))) unsigned char shm[];
    LAS unsigned char* lds = (LAS unsigned char*)shm;
    cg::grid_group grid = cg::this_grid();
    LAS unsigned long long* tab = (LAS unsigned long long*)(lds + 131072 + 64);
    if (threadIdx.x == 0) {
#pragma unroll
        for (int i = 0; i < 35; ++i) tab[i] = (unsigned long long)kp.in[i];
        tab[35] = (unsigned long long)kp.out; tab[36] = (unsigned long long)kp.ws;
    }
    __syncthreads();
    Ctx p; p.tab = tab; p.wv = __builtin_amdgcn_readfirstlane((int)(threadIdx.x >> 6));
    unsigned* bar = (unsigned*)(PWS + WS_BAR);
    unsigned nbar = 0;
    for (int ph = ph_lo; ph < ph_hi; ++ph) {
        run_phase(p, ph, lds);
        if (ph + 1 < ph_hi) {
#ifdef CG_ONLY
#ifdef HARDEN
            __builtin_amdgcn_fence(__ATOMIC_RELEASE, "agent");
#endif
            asm volatile("s_waitcnt vmcnt(0) lgkmcnt(0)" ::: "memory");
            grid.sync();
#ifdef HARDEN
            __builtin_amdgcn_fence(__ATOMIC_ACQUIRE, "agent");
            asm volatile("s_waitcnt vmcnt(0)" ::: "memory");
            __syncthreads();
#endif
#ifdef DUP_MIX
            if (ph > 0 && (ph - 1) % 12 == 5) { mixer_phase(p, (ph - 1) / 12, lds, 1); grid.sync(); }
#endif
#else
            if (ph == ph_lo) {
                grid.sync();
            } else {
                ++nbar;
                asm volatile("s_waitcnt vmcnt(0) lgkmcnt(0)" ::: "memory");
                __syncthreads();
                if (threadIdx.x == 0) {
                    const unsigned target = nbar * (unsigned)gridDim.x;
                    __builtin_amdgcn_fence(__ATOMIC_RELEASE, "agent");
                    asm volatile("s_waitcnt vmcnt(0)" ::: "memory");
                    __hip_atomic_fetch_add(bar, 1u, __ATOMIC_RELAXED, __HIP_MEMORY_SCOPE_AGENT);
                    while (__hip_atomic_load(bar, __ATOMIC_RELAXED, __HIP_MEMORY_SCOPE_AGENT) < target) __builtin_amdgcn_s_sleep(1);
                    __builtin_amdgcn_fence(__ATOMIC_ACQUIRE, "agent");
                    asm volatile("s_waitcnt vmcnt(0)" ::: "memory");
                    __hip_atomic_fetch_add(bar + 64, 1u, __ATOMIC_RELAXED, __HIP_MEMORY_SCOPE_AGENT);
                    while (__hip_atomic_load(bar + 64, __ATOMIC_RELAXED, __HIP_MEMORY_SCOPE_AGENT) < target) __builtin_amdgcn_s_sleep(1);
                }
                __syncthreads();
            }
#endif
        }
    }
}

#ifndef SPLIT_LAUNCH
#define SPLIT_LAUNCH 0
#endif
extern "C" void kernel_launch(void* const* d_in, const int* in_sizes, int n_in, void* d_out, int out_size, void* d_ws, size_t ws_size, hipStream_t stream) {
    static int grid = 0;
    if (grid == 0) {
        if (n_in != 35 || out_size != MTOK * 1024 || ws_size < WS_END) { fprintf(stderr, "kernel_launch: unexpected shapes (n_in %d out %d ws %zu need %zu)\n", n_in, out_size, ws_size, (size_t)WS_END); grid = -1; return; }
        int dev = 0, cus = 0, per_cu = 0;
        if (hipGetDevice(&dev) != hipSuccess || hipDeviceGetAttribute(&cus, hipDeviceAttributeMultiprocessorCount, dev) != hipSuccess) { grid = -1; return; }
        if (hipFuncSetAttribute((const void*)mega, hipFuncAttributeMaxDynamicSharedMemorySize, LDS_BYTES) != hipSuccess) { fprintf(stderr, "kernel_launch: hipFuncSetAttribute failed\n"); grid = -1; return; }
        if (hipOccupancyMaxActiveBlocksPerMultiprocessor(&per_cu, (const void*)mega, 512, LDS_BYTES) != hipSuccess || per_cu < 1) { fprintf(stderr, "kernel_launch: occupancy query says %d\n", per_cu); per_cu = 1; }
        (void)hipGetLastError();
        grid = cus;
    }
    if (grid < 0) return;
    Params p{};
    for (int i = 0; i < 35; ++i) p.in[i] = (const float*)d_in[i];
    p.out = (float*)d_out; p.ws = (unsigned char*)d_ws;
#if SPLIT_LAUNCH
    for (int ph = 0; ph < NPH; ++ph) { int lo = ph, hi = ph + 1; void* args[] = {&p, &lo, &hi};
        hipError_t e = hipLaunchCooperativeKernel((const void*)mega, dim3(grid), dim3(512), args, LDS_BYTES, stream);
        if (e != hipSuccess) { fprintf(stderr, "launch failed: %s\n", hipGetErrorString(e)); return; } }
#else
    int lo = 0, hi = NPH; void* args[] = {&p, &lo, &hi};
    hipError_t e = hipLaunchCooperativeKernel((const void*)mega, dim3(grid), dim3(512), args, LDS_BYTES, stream);
    if (e != hipSuccess) fprintf(stderr, "cooperative launch failed: %s (grid %d)\n", hipGetErrorString(e), grid);
#endif
}
```

```cpp
#include <hip/hip_cooperative_groups.h>
#include <cstdio>
#include <hip/hip_runtime.h>
__device__ __forceinline__ int tid_from(int wv) { unsigned m = ~0u; asm volatile("" : "+s"(m), "+s"(wv)); return wv * 64 + (int)__builtin_amdgcn_mbcnt_hi(m, __builtin_amdgcn_mbcnt_lo(m, 0u)); }
#define TIDX (tid_from(p.wv))
__device__ __forceinline__ int bid_() { int b = blockIdx.x; asm volatile("" : "+s"(b)); return b; }
__device__ __forceinline__ int gdim_() { int b = gridDim.x; asm volatile("" : "+s"(b)); return b; }
#define BIDX (bid_())
#define GDIM (gdim_())
#define CG_ONLY 1
#include <hip/hip_runtime.h>
namespace pg8 {
#define PG8_LAS __attribute__((address_space(3)))
typedef unsigned short bf16_t;
typedef short bf16x8 __attribute__((ext_vector_type(8)));
typedef float f32x4 __attribute__((ext_vector_type(4)));
typedef unsigned u32x4 __attribute__((ext_vector_type(4)));
constexpr int BM = 256, BK = 64, HALF = 128, HTB = HALF * BK * 2  , STAGE_BYTES = 8 * HTB, NXCD = 8, WGM = 8;

__host__ __device__ __forceinline__ int lds_byte(int r, int c) { const int st = (r >> 4) * 2 + (c >> 5), rr = r & 15, cc = c & 31, ob = rr * 64 + cc * 2; return st * 1024 + (ob ^ (((ob >> 9) & 1) << 5)); }
__host__ __device__ __forceinline__ void stage_rc(int b, int& R, int& C) { const int st = b / 1024, sb = b % 1024, swz = sb ^ (((sb >> 9) & 1) << 5); R = (st >> 1) * 16 + swz / 64; C = (st & 1) * 32 + (swz % 64) / 2; }
__host__ __device__ __forceinline__ int perm32(int rho) { const int n = rho >> 4, i = rho & 15; return 8 * (i >> 2) + 4 * n + (i & 3); }

struct Unit { int pm, pn; };
struct Gemm { const bf16_t* A; const bf16_t* Bt; int M, N, K; };

struct StaticOrder {
    int nM, nN, nwg, G, c;
    __host__ __device__ void init(int M, int N, int G_, int c_) { nM = M / BM; nN = N / BM; nwg = nM * nN; G = G_; c = c_; }
    __host__ __device__ bool next(int i, Unit& u) const {
        const long L = (long)i * G + c; if (L >= nwg) return false;
        int wgid = (int)L; { const int q = nwg / NXCD, r = nwg % NXCD, xcd = wgid % NXCD, off = wgid / NXCD; wgid = (xcd < r ? xcd * (q + 1) : r * (q + 1) + (xcd - r) * q) + off; }
        const int nig = WGM * nN, gid = wgid / nig, fm = gid * WGM, gsz = (nM - fm) < WGM ? (nM - fm) : WGM;
        u.pm = fm + ((wgid % nig) % gsz); u.pn = (wgid % nig) / gsz; return true;
    }
    __device__ __forceinline__ void a_ready(const Unit&) const {}
    __device__ __forceinline__ void done(const Unit&) const {}
};
__device__ __forceinline__ unsigned cvt_pk_bf16(float lo, float hi) { unsigned r; asm volatile("v_cvt_pk_bf16_f32 %0, %1, %2" : "=v"(r) : "v"(lo), "v"(hi)); return r; }
template <class Epi, class Sched, bool STAMP = false>
__device__ __forceinline__ void gemm_phase(PG8_LAS unsigned char* lds, const Gemm g, const Sched& S, const Epi& E, unsigned long long* stamps, const int tid_in) {
    const int tid = tid_in, wid = __builtin_amdgcn_readfirstlane(tid >> 6), lane = tid & 63, wr = wid >> 2, wc = wid & 3, fr = lane & 15, fq = lane >> 4;
    const int K = g.K, nt = K / BK;
    int ts_lo = 0, ts_hi = 0, nts = 0; const unsigned long long rt_entry = STAMP ? (unsigned long long)wall_clock64() : 0ull;
#define PG8_STAMP() do { if (STAMP && wid == 0 && nts < 64) { const unsigned long long _c = (unsigned long long)clock64(); \
        ts_lo = (lane == nts) ? (int)(unsigned)_c : ts_lo; ts_hi = (lane == nts) ? (int)(unsigned)(_c >> 32) : ts_hi; ++nts; } } while (0)
    PG8_STAMP();
    unsigned voffA[2], voffB[2];
#pragma unroll
    for (int i = 0; i < 2; ++i) { int R, C; stage_rc(tid * 16 + i * 8192, R, C); const int Rb = Epi::PERM ? ((R & ~31) + perm32(R & 31)) : R;
        voffA[i] = (unsigned)(R * K + C) * 2u; voffB[i] = (unsigned)(Rb * K + C) * 2u; }
    const size_t kstep = (size_t)(BK * 2);
    const size_t hstep = (size_t)HALF * K * 2;
    const size_t tstep = 2 * hstep;
    const unsigned ldsw = (unsigned)wid * 1024u;
    const int aoff = lds_byte(wr * 64 + fr, fq * 8), boff = lds_byte(wc * 32 + fr, fq * 8);
#define PG8_SA(b, h) (((b) * 2 + (h)) * HTB)
#define PG8_SB(b, h) ((4 + (b) * 2 + (h)) * HTB)
#define PG8_STAGE(bufoff, gbase, voff) do { _Pragma("unroll") for (int _i = 0; _i < 2; ++_i) \
        __builtin_amdgcn_global_load_lds((const unsigned*)((const char*)(gbase) + (voff)[_i]), (PG8_LAS unsigned*)(lds + (bufoff) + ldsw + _i * 8192), 16, 0, 0); } while (0)
#define PG8_LDA(dst, b, h) do { _Pragma("unroll") for (int m = 0; m < 4; ++m) _Pragma("unroll") for (int k = 0; k < 2; ++k) dst[m][k] = *(const PG8_LAS bf16x8*)(lds + PG8_SA(b, h) + aoff + m * 2048 + k * 1024); } while (0)
#define PG8_LDB(dst, b, h) do { _Pragma("unroll") for (int n = 0; n < 2; ++n) _Pragma("unroll") for (int k = 0; k < 2; ++k) dst[n][k] = *(const PG8_LAS bf16x8*)(lds + PG8_SB(b, h) + boff + n * 2048 + k * 1024); } while (0)
#define PG8_MMA(ai, bj, At, Bt) do { __builtin_amdgcn_s_setprio(1); _Pragma("unroll") for (int m = 0; m < 4; ++m) _Pragma("unroll") for (int n = 0; n < 2; ++n) _Pragma("unroll") for (int k = 0; k < 2; ++k) \
        acc[ai][bj][m][n] = __builtin_amdgcn_mfma_f32_16x16x32_bf16(Bt[n][k], At[m][k], acc[ai][bj][m][n], 0, 0, 0); __builtin_amdgcn_s_setprio(0); } while (0)
#define PG8_WAIT_V(n) asm volatile("s_waitcnt vmcnt(" #n ")" ::: "memory")
#define PG8_WAIT_L(n) asm volatile("s_waitcnt lgkmcnt(" #n ")" ::: "memory")
#define PG8_BAR __builtin_amdgcn_s_barrier()
#define PG8_SCHED __builtin_amdgcn_sched_barrier(0)
    Unit cur, nxt; int ui = 0;
    if (!S.next(0, cur)) return;
    f32x4 acc[2][2][4][2];
#pragma unroll
    for (int a = 0; a < 2; ++a)
#pragma unroll
        for (int b = 0; b < 2; ++b)
#pragma unroll
            for (int m = 0; m < 4; ++m)
#pragma unroll
                for (int n = 0; n < 2; ++n) acc[a][b][m][n] = (f32x4){0.f, 0.f, 0.f, 0.f};
    bf16x8 At[4][2], B0[2][2], B1[2][2];
    const char* cA = (const char*)g.A + (size_t)cur.pm * tstep; const char* cB = (const char*)g.Bt + (size_t)cur.pn * tstep;
    S.a_ready(cur);
    PG8_STAGE(PG8_SB(0, 0), cB, voffB); PG8_STAGE(PG8_SA(0, 0), cA, voffA); PG8_STAGE(PG8_SB(0, 1), cB + hstep, voffB); PG8_STAGE(PG8_SA(0, 1), cA + hstep, voffA);
    if (wr == 1) PG8_BAR;
    PG8_WAIT_V(4); PG8_BAR;
    PG8_STAGE(PG8_SB(1, 0), cB + kstep, voffB); PG8_STAGE(PG8_SA(1, 0), cA + kstep, voffA); PG8_STAGE(PG8_SB(1, 1), cB + hstep + kstep, voffB);
    PG8_WAIT_V(6); PG8_BAR;
    PG8_STAMP();
    for (;;) {
        const bool has_next = S.next(ui + 1, nxt);
        const char* nA = has_next ? (const char*)g.A + (size_t)nxt.pm * tstep : cA; const char* nB = has_next ? (const char*)g.Bt + (size_t)nxt.pn * tstep : cB;
        for (int t = 0; t < nt; t += 2) {
            const bool last = (t == nt - 2);
            const char* a1 = cA + (size_t)(t + 1) * kstep;
            const char* a2 = last ? nA : cA + (size_t)(t + 2) * kstep; const char* b2 = last ? nB : cB + (size_t)(t + 2) * kstep;
            const char* a3 = a2 + kstep; const char* b3 = b2 + kstep;
            if (last && has_next) S.a_ready(nxt);
            PG8_LDB(B0, 0, 0); PG8_SCHED; PG8_LDA(At, 0, 0); PG8_STAGE(PG8_SA(1, 1), a1 + hstep, voffA);
            PG8_WAIT_L(8); PG8_BAR; PG8_WAIT_L(0); PG8_MMA(0, 0, At, B0); PG8_BAR; PG8_SCHED;
            PG8_LDB(B1, 0, 1); PG8_STAGE(PG8_SB(0, 0), b2, voffB);
            PG8_BAR; PG8_WAIT_L(0); PG8_MMA(0, 1, At, B1); PG8_BAR;
            PG8_LDA(At, 0, 1); PG8_STAGE(PG8_SA(0, 0), a2, voffA);
            PG8_BAR; PG8_WAIT_L(0); PG8_MMA(1, 0, At, B0); PG8_BAR; PG8_SCHED;
            PG8_STAGE(PG8_SB(0, 1), b2 + hstep, voffB);
            PG8_WAIT_V(6); PG8_BAR; PG8_MMA(1, 1, At, B1); PG8_BAR;
            PG8_LDB(B0, 1, 0); PG8_SCHED; PG8_LDA(At, 1, 0); PG8_STAGE(PG8_SA(0, 1), a2 + hstep, voffA);
            PG8_WAIT_L(8); PG8_BAR; PG8_WAIT_L(0); PG8_MMA(0, 0, At, B0); PG8_BAR; PG8_SCHED;
            PG8_LDB(B1, 1, 1); PG8_STAGE(PG8_SB(1, 0), b3, voffB);
            PG8_BAR; PG8_WAIT_L(0); PG8_MMA(0, 1, At, B1); PG8_BAR;
            PG8_LDA(At, 1, 1); PG8_STAGE(PG8_SA(1, 0), a3, voffA);
            PG8_BAR; PG8_WAIT_L(0); PG8_MMA(1, 0, At, B0); PG8_BAR; PG8_SCHED;
            PG8_STAGE(PG8_SB(1, 1), b3 + hstep, voffB);
            PG8_WAIT_V(6); PG8_BAR; PG8_MMA(1, 1, At, B1); PG8_BAR;
        }
        PG8_STAMP();
        if constexpr (!Epi::AFTER_DRAIN) { E(acc, cur, wr, wc, fr, fq); S.done(cur); }
        PG8_STAMP();
        if (!has_next) break;
#pragma unroll
        for (int a = 0; a < 2; ++a)
#pragma unroll
            for (int b = 0; b < 2; ++b)
#pragma unroll
                for (int m = 0; m < 4; ++m)
#pragma unroll
                    for (int n = 0; n < 2; ++n) acc[a][b][m][n] = (f32x4){0.f, 0.f, 0.f, 0.f};
        cur = nxt; cA = nA; cB = nB; ++ui;
    }
    PG8_WAIT_V(0);
    if (wr == 0) PG8_BAR;
    PG8_BAR;
    if constexpr (Epi::AFTER_DRAIN) { E.fused(acc, cur, wr, wc, fr, fq, lds, wid, lane); S.done(cur); }
    PG8_STAMP();
    if (STAMP && wid == 0) { stamps[lane] = lane < nts ? (((unsigned long long)(unsigned)ts_hi << 32) | (unsigned)ts_lo) : 0ull;
        if (lane == 62) stamps[62] = rt_entry; if (lane == 63) stamps[63] = (unsigned long long)wall_clock64(); }
#undef PG8_STAMP
#undef PG8_SA
#undef PG8_SB
#undef PG8_STAGE
#undef PG8_LDA
#undef PG8_LDB
#undef PG8_MMA
#undef PG8_WAIT_V
#undef PG8_WAIT_L
#undef PG8_BAR
#undef PG8_SCHED
}
}

#include <cstdio>
#include <ctime>
#include <cstdlib>
#include <cstring>
#include <cmath>
#include <vector>
#include <algorithm>

namespace cg = cooperative_groups;
using pg8::bf16_t; using pg8::bf16x8; using pg8::f32x4;
typedef _Float16 f16_t;
typedef short bf16x4 __attribute__((ext_vector_type(4)));
typedef unsigned u32x4 __attribute__((ext_vector_type(4)));
typedef unsigned u32x2 __attribute__((ext_vector_type(2)));
#define LAS __attribute__((address_space(3)))

#ifndef EN_RWKV
#define EN_RWKV 1
#endif
#ifndef EN_ATTN
#define EN_ATTN 1
#endif
#ifndef EN_S5
#define EN_S5 1
#endif
#ifndef EN_FFN
#define EN_FFN 1
#endif

constexpr int MTOK = 65536, SEQ = 8192;
constexpr int LDS_BYTES = 131072 + 512;
constexpr size_t WL_GU1 = 0, WL_D1 = WL_GU1 + 11534336, WL_IN = WL_D1 + 5767168, WL_OUT = WL_IN + 5767168, WL_GU2 = WL_OUT + 2097152,
                 WL_D2 = WL_GU2 + 11534336, WL_GLU = WL_D2 + 5767168, WL_W2 = WL_GLU + 262144, WL_A2 = WL_W2 + 98304, WL_G2 = WL_A2 + 98304, WL_SIZE = WL_G2 + 98304;
constexpr size_t WS_WB = 0, WS_XN = WS_WB + 2 * WL_SIZE, WS_BIG = WS_XN + 134217728, WS_LAM = WS_BIG + 369098752, WS_AA = WS_LAM + 100663296,
                 WS_GG = WS_AA + 100663296, WS_YY = WS_GG + 50331648, WS_YPRE = WS_YY + 100663296, WS_LSE = WS_YPRE + 33554432, WS_CB = WS_LSE + 1572864,
                 WS_S5E = WS_CB + 3145728, WS_CTR = WS_S5E + 8388608, WS_BAR = WS_CTR + 256, WS_END = WS_BAR + 16384;

struct Params { const float* in[35]; float* out; unsigned char* ws; };
struct Ctx { LAS const unsigned long long* tab; int wv; };
template <class T> __device__ __forceinline__ T* ldsptr(LAS const unsigned long long* tab, int i) {
    unsigned a_; asm volatile("s_mov_b32 %0, 0x20040" : "=s"(a_)); a_ += (unsigned)i * 8u;
    const unsigned long long v = *(LAS const unsigned long long*)a_; const unsigned lo = __builtin_amdgcn_readfirstlane((unsigned)v), hi = __builtin_amdgcn_readfirstlane((unsigned)(v >> 32));
    unsigned long long r = ((unsigned long long)hi << 32) | lo; asm volatile("" : "+s"(r));
    return (T*)(__attribute__((address_space(1))) T*)r; }
#define PWS (ldsptr<unsigned char>(p.tab, 36))
#define POUT (ldsptr<float>(p.tab, 35))
#define PIN(i) (ldsptr<const float>(p.tab, i))

__device__ __forceinline__ float bf2f(unsigned short b) { return __uint_as_float(((unsigned)b) << 16); }
typedef float f32v2_ __attribute__((ext_vector_type(2)));
typedef __bf16 bf16v2_ __attribute__((ext_vector_type(2)));
__device__ __forceinline__ unsigned pk2a(float lo, float hi) { return pg8::cvt_pk_bf16(lo, hi); }
__device__ __forceinline__ unsigned pk2(float lo, float hi) { return pg8::cvt_pk_bf16(lo, hi); }
#ifdef PK2_BUILTIN
__device__ __forceinline__ unsigned pk2m(float lo, float hi) { const f32v2_ f = {lo, hi}; const bf16v2_ r = __builtin_convertvector(f, bf16v2_); return __builtin_bit_cast(unsigned, r); }
#else
__device__ __forceinline__ unsigned pk2m(float lo, float hi) { return pg8::cvt_pk_bf16(lo, hi); }
#endif
#ifdef WT_STORES
__device__ __forceinline__ void wt8(void* p, unsigned long long v) { __hip_atomic_store((unsigned long long*)p, v, __ATOMIC_RELAXED, __HIP_MEMORY_SCOPE_AGENT); }
__device__ __forceinline__ void wt4(void* p, unsigned v) { __hip_atomic_store((unsigned*)p, v, __ATOMIC_RELAXED, __HIP_MEMORY_SCOPE_AGENT); }
__device__ __forceinline__ void wt2(void* p, unsigned short v) { __hip_atomic_store((unsigned short*)p, v, __ATOMIC_RELAXED, __HIP_MEMORY_SCOPE_AGENT); }
#else
__device__ __forceinline__ void wt8(void* p, unsigned long long v) { *(unsigned long long*)p = v; }
__device__ __forceinline__ void wt4(void* p, unsigned v) { *(unsigned*)p = v; }
__device__ __forceinline__ void wt2(void* p, unsigned short v) { *(unsigned short*)p = v; }
#endif
#if defined(WT_STORES) && defined(WT_ASM16)
__device__ __forceinline__ void wt16(void* p, uint4 v) {
    u32x4 d = {v.x, v.y, v.z, v.w};
    asm volatile("global_store_dwordx4 %0, %1, off sc1\n\ts_nop 1" :: "v"(p), "v"(d) : "memory"); }
#elif defined(WT_STORES)
__device__ __forceinline__ void wt16(void* p, uint4 v) {
    u32x4 d = {v.x, v.y, v.z, v.w}; __builtin_nontemporal_store(d, (u32x4*)p); }
#else
__device__ __forceinline__ void wt16(void* p, uint4 v) { *(uint4*)p = v; }
#endif
__device__ __forceinline__ void wt8u(void* p, uint2 v) { wt8(p, ((unsigned long long)v.y << 32) | v.x); }
__device__ __forceinline__ void wt16f(void* p, f32x4 v) { uint4 u; u.x = __float_as_uint(v[0]); u.y = __float_as_uint(v[1]); u.z = __float_as_uint(v[2]); u.w = __float_as_uint(v[3]); wt16(p, u); }
__device__ __forceinline__ float shx(float v, int o, int lane) { return __builtin_bit_cast(float, __builtin_amdgcn_ds_bpermute((lane ^ o) << 2, __builtin_bit_cast(int, v))); }
#define LAUNDER(x) asm volatile("" : "+v"(x))
__device__ __forceinline__ float dpp_ror_add(float x, const int ctrl_unused) { return x; }
#define DPP_ROR_ADD(x, N) ((x) + __builtin_bit_cast(float, __builtin_amdgcn_update_dpp(0, __builtin_bit_cast(int, (x)), 0x120 + (N), 0xf, 0xf, false)))
__device__ __forceinline__ float row16_sum(float x) {
    x = DPP_ROR_ADD(x, 8); x = DPP_ROR_ADD(x, 4); x = DPP_ROR_ADD(x, 2); x = DPP_ROR_ADD(x, 1); return x;
}
__device__ __forceinline__ float wave_sum(float v, int lane) {
    v = row16_sum(v); v += shx(v, 16, lane); v += shx(v, 32, lane); return v;
}
__device__ __forceinline__ float sigmoidf_(float x) { return __builtin_amdgcn_rcpf(1.f + __expf(-x)); }
__device__ __forceinline__ float tanhf_(float x) { const float e = __expf(2.f * x); return 1.f - 2.f * __builtin_amdgcn_rcpf(e + 1.f); }
__device__ __forceinline__ f32x4 mfma16(bf16x8 a, bf16x8 b, f32x4 c) { return __builtin_amdgcn_mfma_f32_16x16x32_bf16(a, b, c, 0, 0, 0); }

template <class F> __device__ __forceinline__ void prep_t(const Ctx& p, LAS unsigned char* lds, bf16_t* dst, int N, int K, F rowp) {
    LAS float* T = (LAS float*)lds;
    const int tid = TIDX, ntn = N >> 6, ntk = K >> 6, total = ntn * ntk;
    for (int t = BIDX; t < total; t += GDIM) {
        const int n0 = (t % ntn) << 6, k0 = (t / ntn) << 6;
        __syncthreads();
        { const int k = tid >> 3, c8 = (tid & 7) << 3; const float* s = rowp(n0, k0 + k) + c8;
          const f32x4 a = *(const f32x4*)s, c = *(const f32x4*)(s + 4);
#pragma unroll
          for (int e = 0; e < 4; ++e) { T[k * 65 + c8 + e] = a[e]; T[k * 65 + c8 + 4 + e] = c[e]; } }
        __syncthreads();
        { const int n = tid >> 3, k8 = (tid & 7) << 3; float v[8];
#pragma unroll
          for (int e = 0; e < 8; ++e) v[e] = T[(k8 + e) * 65 + n];
          uint4 o; o.x = pk2a(v[0], v[1]); o.y = pk2a(v[2], v[3]); o.z = pk2a(v[4], v[5]); o.w = pk2a(v[6], v[7]);
          wt16(dst + (size_t)(n0 + n) * K + k0 + k8, o); }
    }
}
__device__ __forceinline__ void weights_phase(const Ctx& p, LAS unsigned char* lds) {
    for (int l = 0; l < 2; ++l) {
        unsigned char* wl = PWS + WS_WB + (size_t)l * WL_SIZE;
        for (int f = 0; f < 2; ++f) {
            const float* wg = PIN(f ? 31 : 2) + (size_t)l * 1024 * 2816; const float* wu = PIN(f ? 32 : 3) + (size_t)l * 1024 * 2816; const float* wd = PIN(f ? 33 : 4) + (size_t)l * 2816 * 1024;
            prep_t(p, lds, (bf16_t*)(wl + (f ? WL_GU2 : WL_GU1)), 5632, 1024, [=](int n0, int k) { const int t = n0 >> 8, i = n0 & 255; return ((i < 128) ? wg + t * 128 + i : wu + t * 128 + i - 128) + (size_t)k * 2816; });
            prep_t(p, lds, (bf16_t*)(wl + (f ? WL_D2 : WL_D1)), 1024, 2816, [=](int n0, int k) { return wd + (size_t)k * 1024 + n0; });
        }
        { const float* w = PIN(6) + (size_t)l * 1024 * 2816; prep_t(p, lds, (bf16_t*)(wl + WL_IN), 2816, 1024, [=](int n0, int k) { return w + (size_t)k * 2816 + n0; }); }
        { const float* w = PIN(7) + (size_t)l * 1024 * 1024; prep_t(p, lds, (bf16_t*)(wl + WL_OUT), 1024, 1024, [=](int n0, int k) { return w + (size_t)k * 1024 + n0; }); }
        { const float* w = PIN(28) + (size_t)l * 256 * 512; prep_t(p, lds, (bf16_t*)(wl + WL_GLU), 512, 256, [=](int n0, int k) { const int t = n0 >> 8, i = n0 & 255; return w + (size_t)k * 512 + ((i < 128) ? t * 128 + i : 256 + t * 128 + i - 128); }); }
        { const float* w = PIN(11) + (size_t)l * 2 * 64 * 384; prep_t(p, lds, (bf16_t*)(wl + WL_W2), 768, 64, [=](int n0, int k) { const int d = n0 / 384, c = n0 % 384; return w + (size_t)(d * 64 + k) * 384 + c; }); }
        { const float* w = PIN(13) + (size_t)l * 2 * 64 * 384; prep_t(p, lds, (bf16_t*)(wl + WL_A2), 768, 64, [=](int n0, int k) { const int d = n0 / 384, c = n0 % 384; return w + (size_t)(d * 64 + k) * 384 + c; }); }
        { const float* w = PIN(14) + (size_t)l * 128 * 384; prep_t(p, lds, (bf16_t*)(wl + WL_G2), 384, 128, [=](int n0, int k) { return w + (size_t)k * 384 + n0; }); }
    }
}

__device__ __forceinline__ void norm_phase(const Ctx& p, const float* hin, const float* g, bf16_t* xn, float* fout) {
    const int lane = TIDX & 63, wave = BIDX * 8 + (TIDX >> 6), nw = GDIM * 8;
    float4 gv[4];
#pragma unroll
    for (int i = 0; i < 4; ++i) gv[i] = *(const float4*)(g + lane * 4 + 256 * i);
    for (int row = wave; row < MTOK; row += nw) {
        const float* pr = hin + (size_t)row * 1024;
        float4 v[4]; float ss = 0.f;
#pragma unroll
        for (int i = 0; i < 4; ++i) { v[i] = *(const float4*)(pr + lane * 4 + 256 * i); ss += v[i].x * v[i].x + v[i].y * v[i].y + v[i].z * v[i].z + v[i].w * v[i].w; }
        ss = wave_sum(ss, lane);
        const float rs = rsqrtf(ss * (1.f / 1024.f) + 1e-6f);
        if (xn) {
#pragma unroll
            for (int i = 0; i < 4; ++i) { uint2 o; o.x = pk2a(v[i].x * rs * gv[i].x, v[i].y * rs * gv[i].y); o.y = pk2a(v[i].z * rs * gv[i].z, v[i].w * rs * gv[i].w); wt8u(xn + (size_t)row * 1024 + lane * 4 + 256 * i, o); }
        } else {
#pragma unroll
            for (int i = 0; i < 4; ++i) { float4 o; o.x = v[i].x * rs * gv[i].x; o.y = v[i].y * rs * gv[i].y; o.z = v[i].z * rs * gv[i].z; o.w = v[i].w * rs * gv[i].w; wt16f(fout + (size_t)row * 1024 + lane * 4 + 256 * i, (f32x4){o.x, o.y, o.z, o.w}); }
        }
    }
}

struct EpiSwiGLU { int wv; static constexpr bool PERM = true, AFTER_DRAIN = false; bf16_t* O;
    __device__ __forceinline__ void operator()(const f32x4 (&acc)[2][2][4][2], const pg8::Unit& u, int wr, int wc, int fr_, int fq_) const {
        const int ln_ = tid_from(wv) & 63, fr = ln_ & 15, fq = ln_ >> 4;
        const int row0 = u.pm * 256 + wr * 64 + fr, col0 = u.pn * 128 + wc * 32 + 8 * fq;
#pragma unroll
        for (int ai = 0; ai < 2; ++ai)
#pragma unroll
            for (int m = 0; m < 4; ++m) {
                float r[8];
#pragma unroll
                for (int n = 0; n < 2; ++n)
#pragma unroll
                    for (int j = 0; j < 4; ++j) { const float g = acc[ai][0][m][n][j], uu = acc[ai][1][m][n][j]; r[n * 4 + j] = g * sigmoidf_(g) * uu; }
                uint4 o; o.x = pk2a(r[0], r[1]); o.y = pk2a(r[2], r[3]); o.z = pk2a(r[4], r[5]); o.w = pk2a(r[6], r[7]);
                wt16(O + (size_t)(row0 + ai * 128 + m * 16) * 2816 + col0, o);
            }
    }
};
struct EpiResid { int wv; static constexpr bool PERM = false, AFTER_DRAIN = false; const float* hin; float* hout; float alpha;
    __device__ __forceinline__ void operator()(const f32x4 (&acc)[2][2][4][2], const pg8::Unit& u, int wr, int wc, int fr_, int fq_) const {
        const int ln_ = tid_from(wv) & 63, fr = ln_ & 15, fq = ln_ >> 4;
        const int row0 = u.pm * 256 + wr * 64 + fr, col0 = u.pn * 256 + wc * 32 + 4 * fq;
#pragma unroll
        for (int ai = 0; ai < 2; ++ai)
#pragma unroll
            for (int m = 0; m < 4; ++m) { const size_t ro = (size_t)(row0 + ai * 128 + m * 16) * 1024 + col0;
#pragma unroll
                for (int bj = 0; bj < 2; ++bj)
#pragma unroll
                    for (int n = 0; n < 2; ++n) { const f32x4 hv = *(const f32x4*)(hin + ro + bj * 128 + n * 16); wt16f(hout + ro + bj * 128 + n * 16, hv + alpha * acc[ai][bj][m][n]); } }
    }
};
struct EpiZ { int wv; static constexpr bool PERM = true, AFTER_DRAIN = false; bf16_t* O;
    __device__ __forceinline__ void operator()(const f32x4 (&acc)[2][2][4][2], const pg8::Unit& u, int wr, int wc, int fr_, int fq_) const {
        const int ln_ = tid_from(wv) & 63, fr = ln_ & 15, fq = ln_ >> 4;
        const int row0 = u.pm * 256 + wr * 64 + fr, col0 = u.pn * 256 + wc * 32 + 8 * fq;
#pragma unroll
        for (int ai = 0; ai < 2; ++ai)
#pragma unroll
            for (int m = 0; m < 4; ++m)
#pragma unroll
                for (int bj = 0; bj < 2; ++bj) { const f32x4 a = acc[ai][bj][m][0], b = acc[ai][bj][m][1];
                    uint4 o; o.x = pk2a(a[0], a[1]); o.y = pk2a(a[2], a[3]); o.z = pk2a(b[0], b[1]); o.w = pk2a(b[2], b[3]);
                    wt16(O + (size_t)(row0 + ai * 128 + m * 16) * 2816 + col0 + bj * 128, o); }
    }
};
struct EpiGLU { int wv; static constexpr bool PERM = true, AFTER_DRAIN = false; bf16_t* O; const float* bias;
    __device__ __forceinline__ void operator()(const f32x4 (&acc)[2][2][4][2], const pg8::Unit& u, int wr, int wc, int fr_, int fq_) const {
        const int ln_ = tid_from(wv) & 63, fr = ln_ & 15, fq = ln_ >> 4;
        const int row0 = u.pm * 256 + wr * 64 + fr, cw = u.pn * 128 + wc * 32 + 8 * fq;
        const f32x4 bv0 = *(const f32x4*)(bias + cw), bv1 = *(const f32x4*)(bias + cw + 4), bg0 = *(const f32x4*)(bias + 256 + cw), bg1 = *(const f32x4*)(bias + 256 + cw + 4);
#pragma unroll
        for (int ai = 0; ai < 2; ++ai)
#pragma unroll
            for (int m = 0; m < 4; ++m) {
                const f32x4 v0 = acc[ai][0][m][0] + bv0, v1 = acc[ai][0][m][1] + bv1, g0 = acc[ai][1][m][0] + bg0, g1 = acc[ai][1][m][1] + bg1;
                uint4 o; o.x = pk2a(v0[0] * sigmoidf_(g0[0]), v0[1] * sigmoidf_(g0[1])); o.y = pk2a(v0[2] * sigmoidf_(g0[2]), v0[3] * sigmoidf_(g0[3]));
                o.z = pk2a(v1[0] * sigmoidf_(g1[0]), v1[1] * sigmoidf_(g1[1])); o.w = pk2a(v1[2] * sigmoidf_(g1[2]), v1[3] * sigmoidf_(g1[3]));
                wt16(O + (size_t)(row0 + ai * 128 + m * 16) * 1024 + 768 + cw, o);
            }
    }
};
template <class Epi> __device__ __forceinline__ void gemm_run(const Ctx& p, LAS unsigned char* lds, const bf16_t* A, const bf16_t* Bt, int N, int K, const Epi& E) {
    asm volatile("" : "+s"(N), "+s"(K));
    pg8::Gemm g; g.A = A; g.Bt = Bt; g.M = MTOK; g.N = N; g.K = K;
    pg8::StaticOrder S; S.init(MTOK, N, (int)GDIM, (int)BIDX);
    pg8::gemm_phase<Epi, pg8::StaticOrder, false>(lds, g, S, E, nullptr, TIDX);
}

__device__ __forceinline__ void rwkv_prep_phase(const Ctx& p, int l) {
    const bf16_t* z = (const bf16_t*)(PWS + WS_BIG);
    const unsigned char* wl = PWS + WS_WB + (size_t)l * WL_SIZE;
    const bf16_t* w2t = (const bf16_t*)(wl + WL_W2); const bf16_t* a2t = (const bf16_t*)(wl + WL_A2); const bf16_t* g2t = (const bf16_t*)(wl + WL_G2);
    const float* mup = PIN(8) + l * 1408; const float* mun = PIN(9) + l * 1408;
    const float* w0 = PIN(10) + l * 768; const float* a0 = PIN(12) + l * 768;
    f16_t* lam = (f16_t*)(PWS + WS_LAM); f16_t* aa = (f16_t*)(PWS + WS_AA); f16_t* gg = (f16_t*)(PWS + WS_GG);
    const int lane = TIDX & 63, fr = lane & 15, fq = lane >> 4;
    const int gw = BIDX * 8 + (TIDX >> 6), nw = GDIM * 8;
    for (int it = gw; it < MTOK / 32; it += nw) {
        const int m0 = it * 32;
        bf16x8 A[2][8];
#pragma unroll
        for (int sub = 0; sub < 2; ++sub) {
            const int tok = m0 + sub * 16 + fr, t = tok & (SEQ - 1);
            const bf16_t* zc = z + (size_t)tok * 2816;
            const bf16_t* zp = (t > 0) ? zc - 2816 : zc; const bf16_t* zn = (t < SEQ - 1) ? zc + 2816 : zc;
            const float fp = (t > 0) ? 1.f : 0.f, fn = (t < SEQ - 1) ? 1.f : 0.f;
#pragma unroll
            for (int ks = 0; ks < 8; ++ks) {
                const int col = 1152 + ks * 32 + fq * 8;
                const bf16x8 c8 = *(const bf16x8*)(zc + col), p8 = *(const bf16x8*)(zp + col), n8 = *(const bf16x8*)(zn + col);
#ifdef VEC_MU
                const f32x4 mpa = *(const f32x4*)(mup + col), mpb = *(const f32x4*)(mup + col + 4), mna = *(const f32x4*)(mun + col), mnb = *(const f32x4*)(mun + col + 4);
#endif
                float r[8];
#pragma unroll
                for (int e = 0; e < 8; ++e) {
                    const float x = bf2f((unsigned short)c8[e]), xp = fp * bf2f((unsigned short)p8[e]), xn = fn * bf2f((unsigned short)n8[e]);
#ifdef VEC_MU
                    const float xm = x + (e < 4 ? mpa[e & 3] : mpb[e & 3]) * (xp - x) + (e < 4 ? mna[e & 3] : mnb[e & 3]) * (xn - x);
#else
                    const float xm = x + mup[col + e] * (xp - x) + mun[col + e] * (xn - x);
#endif
                    r[e] = (ks < 2) ? tanhf_(xm) : ((ks < 4) ? xm : sigmoidf_(xm));
                }
                union { uint4 u; bf16x8 v; } cv; cv.u.x = pk2(r[0], r[1]); cv.u.y = pk2(r[2], r[3]); cv.u.z = pk2(r[4], r[5]); cv.u.w = pk2(r[6], r[7]);
                A[sub][ks] = cv.v;
            }
        }
#pragma unroll 1
        for (int nt = 0; nt < 48; ++nt) {
            const bf16x8 b0 = *(const bf16x8*)(w2t + (nt * 16 + fr) * 64 + fq * 8), b1 = *(const bf16x8*)(w2t + (nt * 16 + fr) * 64 + 32 + fq * 8);
            const bf16x8 c0 = *(const bf16x8*)(a2t + (nt * 16 + fr) * 64 + fq * 8), c1 = *(const bf16x8*)(a2t + (nt * 16 + fr) * 64 + 32 + fq * 8);
            const int n0 = nt * 16 + fq * 4;
            const f32x4 w0v = *(const f32x4*)(w0 + n0), a0v = *(const f32x4*)(a0 + n0);
#pragma unroll
            for (int sub = 0; sub < 2; ++sub) {
                const int tok = m0 + sub * 16 + fr;
                f32x4 acc = {0.f, 0.f, 0.f, 0.f}; acc = mfma16(b0, A[sub][0], acc); acc = mfma16(b1, A[sub][1], acc);
                f32x4 aca = {0.f, 0.f, 0.f, 0.f}; aca = mfma16(c0, A[sub][2], aca); aca = mfma16(c1, A[sub][3], aca);
                union { f16_t h[4]; uint2 u; } o1, o2;
#pragma unroll
                for (int j = 0; j < 4; ++j) { o1.h[j] = (f16_t)(0.60653066f * sigmoidf_(w0v[j] + acc[j])); o2.h[j] = (f16_t)sigmoidf_(a0v[j] + aca[j]); }
                wt8u(lam + (size_t)tok * 768 + n0, o1.u); wt8u(aa + (size_t)tok * 768 + n0, o2.u);
            }
        }
#pragma unroll 1
        for (int nt = 0; nt < 24; ++nt) {
            bf16x8 bb[4];
#pragma unroll
            for (int ks = 0; ks < 4; ++ks) bb[ks] = *(const bf16x8*)(g2t + (nt * 16 + fr) * 128 + ks * 32 + fq * 8);
            const int n0 = nt * 16 + fq * 4;
#pragma unroll
            for (int sub = 0; sub < 2; ++sub) {
                const int tok = m0 + sub * 16 + fr;
                f32x4 acc = {0.f, 0.f, 0.f, 0.f};
#pragma unroll
                for (int ks = 0; ks < 4; ++ks) acc = mfma16(bb[ks], A[sub][4 + ks], acc);
                union { f16_t h[4]; uint2 u; } o1;
#pragma unroll
                for (int j = 0; j < 4; ++j) o1.h[j] = (f16_t)acc[j];
                wt8u(gg + (size_t)tok * 384 + n0, o1.u);
            }
        }
    }
}

typedef float f32x2_ __attribute__((ext_vector_type(2)));
struct S5Lane { float lbr, lbi; f32x2_ b2[16]; };
__device__ __forceinline__ void s5_lane_params(const Ctx& p, int l, int d, int g, int pp, S5Lane& q) {
    const int idx = ((l * 2 + d) * 16 + g) * 64 + pp;
    const float are = PIN(20)[idx], aim = PIN(21)[idx], st = __expf(PIN(22)[(l * 2 + d) * 16 + g]);
    const float er = __expf(are * st), ang = aim * st;
    const float kf = rintf(ang * 0.15915494309f); float rr = fmaf(-kf, 6.2831855f, ang); rr = fmaf(-kf, -1.7484555e-7f, rr);
    float sn, cs; __sincosf(rr, &sn, &cs);
    q.lbr = er * cs; q.lbi = er * sn;
    const float nr = q.lbr - 1.f, ni = q.lbi, den = __builtin_amdgcn_rcpf(are * are + aim * aim);
    const float zr = (nr * are + ni * aim) * den, zi = (ni * are - nr * aim) * den;
    const float* br = PIN(23) + ((size_t)(l * 16 + g) * 64 + pp) * 16; const float* bi = PIN(24) + ((size_t)(l * 16 + g) * 64 + pp) * 16;
#pragma unroll
    for (int c = 0; c < 16; ++c) { const float x = br[c], y = bi[c]; q.b2[c] = (f32x2_){zr * x - zi * y, zr * y + zi * x}; }
}
__device__ __forceinline__ void s5_stage_u(const Ctx& p, int b, int c, int gq, LAS float* uf) {
    const bf16_t* z = (const bf16_t*)(PWS + WS_BIG);
#pragma unroll
    for (int i = 0; i < 2; ++i) {
        const int e = TIDX + 512 * i, t = e >> 3, part = e & 7;
        const bf16x8 v = *(const bf16x8*)(z + (size_t)(b * SEQ + c * 128 + t) * 2816 + 2560 + gq * 64 + part * 8);
#pragma unroll
        for (int k = 0; k < 8; ++k) uf[t * 64 + part * 8 + k] = bf2f((unsigned short)v[k]);
    }
}
__device__ __forceinline__ void s5_step(const S5Lane& q, const LAS float* urow, float& hr, float& hi) {
    f32x2_ bu0 = {0.f, 0.f}, bu1 = {0.f, 0.f};
#pragma unroll
    for (int c4 = 0; c4 < 4; ++c4) { const f32x4 u = *(const LAS f32x4*)(urow + c4 * 4);
        bu0 += q.b2[c4 * 4 + 0] * (f32x2_){u[0], u[0]}; bu1 += q.b2[c4 * 4 + 1] * (f32x2_){u[1], u[1]};
        bu0 += q.b2[c4 * 4 + 2] * (f32x2_){u[2], u[2]}; bu1 += q.b2[c4 * 4 + 3] * (f32x2_){u[3], u[3]}; }
    const f32x2_ bu = bu0 + bu1;
    const float nr = q.lbr * hr - q.lbi * hi + bu[0], ni = q.lbr * hi + q.lbi * hr + bu[1]; hr = nr; hi = ni;
}
__device__ __forceinline__ void s5_passA_item(const Ctx& p, int l, int item, LAS unsigned char* lds) {
    const int gq = item & 3, c = (item >> 2) & 63, b = item >> 8;
    const int wid = TIDX >> 6, lane = TIDX & 63, gi = wid >> 1, d = wid & 1, g = gq * 4 + gi;
    LAS float* uf = (LAS float*)lds;
    __syncthreads();
    s5_stage_u(p, b, c, gq, uf);
    S5Lane q; s5_lane_params(p, l, d, g, lane, q);
    __syncthreads();
    float hr = 0.f, hi = 0.f;
    for (int s = 0; s < 128; ++s) { const int ti = d ? 127 - s : s; s5_step(q, uf + ti * 64 + gi * 16, hr, hi); }
    float2* E = (float2*)(PWS + WS_S5E);
    wt8(&E[((size_t)((b * 16 + g) * 2 + d) * 64 + c) * 64 + lane], ((unsigned long long)__float_as_uint(hi) << 32) | __float_as_uint(hr));
}
__device__ __forceinline__ void s5_passC_item(const Ctx& p, int l, int item, LAS unsigned char* lds) {
    const int gq = item & 3, c = (item >> 2) & 63, b = item >> 8;
    const int tid = TIDX, wid = tid >> 6, lane = tid & 63, gi = wid >> 1, d = wid & 1, g = gq * 4 + gi, fr = lane & 15, fq = lane >> 4;
    LAS float* uf = (LAS float*)lds;
    LAS bf16_t* hs = (LAS bf16_t*)(lds + 32768) + wid * 16 * 136;
    LAS float* yl = (LAS float*)(lds + 32768 + 34816);
    __syncthreads();
    s5_stage_u(p, b, c, gq, uf);
    S5Lane q; s5_lane_params(p, l, d, g, lane, q);
    bf16x8 Cf[4];
    {
        const float* cre = PIN(25) + ((size_t)((l * 2 + d) * 16 + g) * 16 + fr) * 64; const float* cim = PIN(26) + ((size_t)((l * 2 + d) * 16 + g) * 16 + fr) * 64;
#pragma unroll
        for (int ks = 0; ks < 4; ++ks) { const int q0 = ks * 32 + fq * 8; float r[8];
#pragma unroll
            for (int e = 0; e < 8; ++e) r[e] = (q0 < 64) ? cre[q0 + e] : -cim[q0 - 64 + e];
            union { uint4 u; bf16x8 v; } cv; cv.u.x = pk2(r[0], r[1]); cv.u.y = pk2(r[2], r[3]); cv.u.z = pk2(r[4], r[5]); cv.u.w = pk2(r[6], r[7]); Cf[ks] = cv.v; }
    }
    float hr = 0.f, hi = 0.f;
    {
        float tr = q.lbr, ti = q.lbi;
#pragma unroll
        for (int k = 0; k < 7; ++k) { const float a = tr * tr - ti * ti, bq = 2.f * tr * ti; tr = a; ti = bq; }
        const float2* E = (const float2*)(PWS + WS_S5E) + ((size_t)((b * 16 + g) * 2 + d) * 64) * 64 + lane;
        const int n = d ? 63 - c : c;
        int i = 0;
        for (; i + 8 <= n; i += 8) {
            float2 e[8];
#pragma unroll
            for (int u = 0; u < 8; ++u) { const int cc = d ? 63 - (i + u) : (i + u); e[u] = E[(size_t)cc * 64]; }
#pragma unroll
            for (int u = 0; u < 8; ++u) { const float nr = tr * hr - ti * hi + e[u].x, ni = tr * hi + ti * hr + e[u].y; hr = nr; hi = ni; }
        }
        for (; i < n; ++i) { const int cc = d ? 63 - i : i; const float2 e = E[(size_t)cc * 64]; const float nr = tr * hr - ti * hi + e.x, ni = tr * hi + ti * hr + e.y; hr = nr; hi = ni; }
    }
    __syncthreads();
    {
        const float* dsk = PIN(27) + l * 256 + gq * 64;
        for (int e = tid; e < 128 * 64; e += 512) { const int t = e >> 6, ch = e & 63; yl[((ch >> 4) * 128 + t) * 17 + (ch & 15)] = dsk[ch] * uf[e]; }
    }
    for (int sub = 0; sub < 8; ++sub) {
        for (int s16 = 0; s16 < 16; ++s16) {
            const int s = sub * 16 + s16, ti = d ? 127 - s : s;
            s5_step(q, uf + ti * 64 + gi * 16, hr, hi);
            const unsigned pk = pk2(hr, hi);
            hs[(ti & 15) * 136 + lane] = (bf16_t)(pk & 0xffffu); hs[(ti & 15) * 136 + 64 + lane] = (bf16_t)(pk >> 16);
        }
        __syncthreads();
        {
            f32x4 acc = {0.f, 0.f, 0.f, 0.f};
#pragma unroll
            for (int ks = 0; ks < 4; ++ks) { const bf16x8 af = *(const LAS bf16x8*)(hs + fr * 136 + ks * 32 + fq * 8); acc = mfma16(Cf[ks], af, acc); }
            const int tile = d ? 7 - sub : sub;
            LAS float* yp = yl + (gi * 128 + tile * 16 + fr) * 17 + fq * 4;
#pragma unroll
            for (int j = 0; j < 4; ++j) yp[j] += acc[j];
        }
        __syncthreads();
    }
    {
        bf16_t* yo = (bf16_t*)(PWS + WS_YPRE);
        const int t = tid >> 2, g4 = tid & 3;
        float r[16];
#pragma unroll
        for (int k = 0; k < 16; ++k) { const float x = yl[(g4 * 128 + t) * 17 + k]; r[k] = 0.5f * x * (1.f + tanhf_(0.7978845608f * (x + 0.044715f * x * x * x))); }
        uint4 o0, o1; o0.x = pk2(r[0], r[1]); o0.y = pk2(r[2], r[3]); o0.z = pk2(r[4], r[5]); o0.w = pk2(r[6], r[7]); o1.x = pk2(r[8], r[9]); o1.y = pk2(r[10], r[11]); o1.z = pk2(r[12], r[13]); o1.w = pk2(r[14], r[15]);
        bf16_t* dst = yo + (size_t)(b * SEQ + c * 128 + t) * 256 + gq * 64 + g4 * 16;
        wt16(dst, o0); wt16(dst + 8, o1);
    }
}

constexpr int SC_T = 32, SC_ROW = 352;
struct ScanRaw { unsigned zr[10], zk[10], zv[10], ar[8], lr[8]; };
__device__ __forceinline__ void scan_load_raw(ScanRaw& R, const bf16_t* zb, const unsigned short* ab, const unsigned short* lb, int tlo, int h, int hf, int d, int lane) {
#pragma unroll
    for (int r = 0; r < 10; ++r) {
        int tok = tlo - 1 + r; tok = tok < 0 ? 0 : (tok > SEQ - 1 ? SEQ - 1 : tok);
        const bf16_t* zp = zb + (size_t)tok * 2816 + h * 64;
        R.zr[r] = zp[lane]; R.zk[r] = zp[384 + lane]; R.zv[r] = zp[768 + hf * 32 + (lane & 31)];
    }
#pragma unroll
    for (int i = 0; i < 8; ++i) { const size_t o = (size_t)(tlo + i) * 768 + d * 384 + h * 64 + lane; R.ar[i] = ab[o]; R.lr[i] = lb[o]; }
}
__device__ __forceinline__ float row16_sum_asm(float x) {
    asm volatile("s_nop 1\n\tv_add_f32_dpp %0, %0, %0 row_ror:8 row_mask:0xf bank_mask:0xf\n\ts_nop 1\n\tv_add_f32_dpp %0, %0, %0 row_ror:4 row_mask:0xf bank_mask:0xf\n\ts_nop 1\n\tv_add_f32_dpp %0, %0, %0 row_ror:2 row_mask:0xf bank_mask:0xf\n\ts_nop 1\n\tv_add_f32_dpp %0, %0, %0 row_ror:1 row_mask:0xf bank_mask:0xf" : "+v"(x));
    return x; }
#define DPP_ADD(x, CTRL) ((x) + __builtin_bit_cast(float, __builtin_amdgcn_update_dpp(0, __builtin_bit_cast(int, (x)), (CTRL), 0xf, 0xf, false)))
__device__ __forceinline__ float red8(float x) {
    x = DPP_ADD(x, 0x141); x = DPP_ADD(x, 0x1B); x = DPP_ADD(x, 0xB1); return x;
}
__device__ __forceinline__ float dot4(f32x4 a, f32x4 b) { return a[0] * b[0] + a[1] * b[1] + a[2] * b[2] + a[3] * b[3]; }
typedef float f32p __attribute__((ext_vector_type(2)));
__device__ __forceinline__ float dot8(f32x4 sa, f32x4 sb, f32x4 a, f32x4 b) {
    f32p acc = __builtin_shufflevector(sa, sa, 0, 1) * __builtin_shufflevector(a, a, 0, 1);
    acc += __builtin_shufflevector(sa, sa, 2, 3) * __builtin_shufflevector(a, a, 2, 3);
    acc += __builtin_shufflevector(sb, sb, 0, 1) * __builtin_shufflevector(b, b, 0, 1);
    acc += __builtin_shufflevector(sb, sb, 2, 3) * __builtin_shufflevector(b, b, 2, 3);
    return acc[0] + acc[1];
}
__device__ __forceinline__ float f16bits2f(unsigned u) { union { unsigned short s; f16_t h; } c; c.s = (unsigned short)u; return (float)c.h; }
__device__ __forceinline__ void rwkv_scan_item(const Ctx& p, int l, int item, LAS unsigned char* lds) {
    const int chain = item >> 1, hf = item & 1, d = chain & 1, h = (chain >> 1) % 6, b = chain / 12;
    const int tid = TIDX, wid = __builtin_amdgcn_readfirstlane(tid >> 6), lane = tid & 63;
    LAS float* buf = (LAS float*)lds;
    const bf16_t* zb = (const bf16_t*)(PWS + WS_BIG) + (size_t)b * SEQ * 2816;
    __syncthreads();
    if (wid < 4) {
        const int j = lane & 7, rg = lane >> 3, row = wid * 8 + rg;
        bf16_t* yy = (bf16_t*)(PWS + WS_YY) + ((size_t)(((d * 8 + b) * 6 + h) * 2 + hf) * SEQ) * 32 + row;
        f32x4 Sa = {0.f, 0.f, 0.f, 0.f}, Sb = Sa; float ys = 0.f;
        __builtin_amdgcn_s_setprio(3);
        for (int c = 0; c < SEQ / SC_T; ++c) {
            __syncthreads();
            const LAS float* bb = buf + (c & 1) * SC_T * SC_ROW + 8 * j;
            const LAS float* vb = buf + (c & 1) * SC_T * SC_ROW + 320 + row;
            struct Ops { f32x4 wa, wb, na, nb, aa, ab, da, db, ra, rb; float v; };
            auto ld = [&](Ops& o, int s) {
                const LAS float* st = bb + s * SC_ROW;
                o.wa = *(const LAS f32x4*)(st); o.wb = *(const LAS f32x4*)(st + 4); o.na = *(const LAS f32x4*)(st + 64); o.nb = *(const LAS f32x4*)(st + 68); o.aa = *(const LAS f32x4*)(st + 128); o.ab = *(const LAS f32x4*)(st + 132);
                o.da = *(const LAS f32x4*)(st + 192); o.db = *(const LAS f32x4*)(st + 196); o.ra = *(const LAS f32x4*)(st + 256); o.rb = *(const LAS f32x4*)(st + 260);
                o.v = vb[s * SC_ROW];
            };
            auto stepf = [&](const Ops& o, int s) {
                float sa = dot8(Sa, Sb, o.na, o.nb);
                const f32x4 ta = Sa * o.wa + o.v * o.da, tb = Sb * o.wb + o.v * o.db;
                sa = red8(sa);
                Sa = ta + sa * o.aa; Sb = tb + sa * o.ab;
                float y = dot8(Sa, Sb, o.ra, o.rb);
                y = red8(y);
                if (j == (s & 7)) ys = y;
                if ((s & 7) == 7) {
                    const int sidx = c * SC_T + (s & ~7) + j, t = d ? SEQ - 1 - sidx : sidx;
                    wt2(&yy[(size_t)t * 32], (unsigned short)(pk2(ys, 0.f) & 0xffffu));
                }
            };
            Ops A, B;
            ld(A, 0);
#pragma unroll 4
            for (int s = 0; s < SC_T; s += 2) {
                ld(B, s + 1);
                stepf(A, s);
                if (s + 2 < SC_T) ld(A, s + 2);
                stepf(B, s + 1);
            }
        }
        __builtin_amdgcn_s_setprio(0);
    } else {
        const int lw = wid - 4;
        const unsigned short* ab = (const unsigned short*)(PWS + WS_AA) + (size_t)b * SEQ * 768;
        const unsigned short* lb = (const unsigned short*)(PWS + WS_LAM) + (size_t)b * SEQ * 768;
        float* cb = (float*)(PWS + WS_CB);
        const float* mup = PIN(8) + l * 1408; const float* mun = PIN(9) + l * 1408;
        const int cr = h * 64 + lane, cv = 768 + h * 64 + hf * 32 + (lane & 31);
        const float mpr = mup[cr], mnr = mun[cr], mpk = mup[384 + cr], mnk = mun[384 + cr], mpv = mup[cv], mnv = mun[cv];
        const float kkc = PIN(15)[l * 384 + cr], kac = PIN(16)[l * 384 + cr], rkc = PIN(17)[l * 384 + cr];
        ScanRaw Rc, Rn;
        auto tlo_of = [&](int c) { const int s0 = c * SC_T + lw * 8; return d ? SEQ - 1 - (s0 + 7) : s0; };
        auto process = [&](const ScanRaw& R, int c) {
            const int tlo = tlo_of(c);
            LAS float* nb = buf + (c & 1) * SC_T * SC_ROW;
            float fr_[10], fk_[10], fv_[10];
#pragma unroll
            for (int r = 0; r < 10; ++r) { const int tok = tlo - 1 + r; const float ok = (tok >= 0 && tok < SEQ) ? 1.f : 0.f;
                fr_[r] = ok * bf2f((unsigned short)R.zr[r]); fk_[r] = ok * bf2f((unsigned short)R.zk[r]); fv_[r] = ok * bf2f((unsigned short)R.zv[r]); }
            float r_[8], k_[8], v_[8], a_[8], w_[8], kk_[8], kd_[8], ss_[8], cb_[8];
#pragma unroll
            for (int i = 0; i < 8; ++i) {
                r_[i] = fr_[i + 1] + mpr * (fr_[i] - fr_[i + 1]) + mnr * (fr_[i + 2] - fr_[i + 1]);
                k_[i] = fk_[i + 1] + mpk * (fk_[i] - fk_[i + 1]) + mnk * (fk_[i + 2] - fk_[i + 1]);
                v_[i] = fv_[i + 1] + mpv * (fv_[i] - fv_[i + 1]) + mnv * (fv_[i + 2] - fv_[i + 1]);
                a_[i] = f16bits2f(R.ar[i]); w_[i] = __expf(-f16bits2f(R.lr[i]));
                kk_[i] = k_[i] * kkc; kd_[i] = k_[i] * (1.f + (a_[i] - 1.f) * kac);
                ss_[i] = row16_sum(kk_[i] * kk_[i]); cb_[i] = (hf == 0) ? row16_sum(r_[i] * kd_[i] * rkc) : 0.f;
            }
            {
                float t1[8], t2[8];
#pragma unroll
                for (int i = 0; i < 8; ++i) { t1[i] = shx(ss_[i], 16, lane); if (hf == 0) t2[i] = shx(cb_[i], 16, lane); }
#pragma unroll
                for (int i = 0; i < 8; ++i) { ss_[i] += t1[i]; if (hf == 0) cb_[i] += t2[i]; }
#pragma unroll
                for (int i = 0; i < 8; ++i) { t1[i] = shx(ss_[i], 32, lane); if (hf == 0) t2[i] = shx(cb_[i], 32, lane); }
#pragma unroll
                for (int i = 0; i < 8; ++i) { ss_[i] += t1[i]; if (hf == 0) cb_[i] += t2[i]; }
            }
#pragma unroll
            for (int i = 0; i < 8; ++i) {
                const float kh = kk_[i] * rsqrtf(ss_[i] + 1e-12f);
                const int slot = lw * 8 + (d ? 7 - i : i);
                LAS float* st = nb + slot * SC_ROW;
                st[lane] = w_[i]; st[64 + lane] = -kh; st[128 + lane] = kh * a_[i]; st[192 + lane] = kd_[i]; st[256 + lane] = r_[i]; if (lane < 32) st[320 + lane] = v_[i];
                if (hf == 0 && lane == 0) wt4(&cb[(size_t)((d * 8 + b) * 6 + h) * SEQ + tlo + i], __float_as_uint(cb_[i]));
            }
        };
        scan_load_raw(Rc, zb, ab, lb, tlo_of(0), h, hf, d, lane);
        scan_load_raw(Rn, zb, ab, lb, tlo_of(1), h, hf, d, lane);
        process(Rc, 0);
        for (int c = 0; c < SEQ / SC_T; ++c) {
            __syncthreads();
            if (c + 1 < SEQ / SC_T) {
                Rc = Rn;
                if (c + 2 < SEQ / SC_T) scan_load_raw(Rn, zb, ab, lb, tlo_of(c + 2), h, hf, d, lane);
                process(Rc, c + 1);
            }
        }
    }
}

__device__ __forceinline__ void rwkv_post_phase(const Ctx& p, int l) {
    const bf16_t* z = (const bf16_t*)(PWS + WS_BIG); const bf16_t* yy = (const bf16_t*)(PWS + WS_YY);
    const unsigned short* gg = (const unsigned short*)(PWS + WS_GG); const float* cb = (const float*)(PWS + WS_CB);
    bf16_t* O = (bf16_t*)(PWS + WS_XN);
    const float* mup = PIN(8) + l * 1408 + 768; const float* mun = PIN(9) + l * 1408 + 768;
    const float* lw_ = PIN(18) + l * 384; const float* lb_ = PIN(19) + l * 384;
    const int lane = TIDX & 63, gw = BIDX * 8 + (TIDX >> 6), nw = GDIM * 8;
    const int sub = lane >> 5, c2 = (lane & 31) * 2;
    float mp_[3][2], mn_[3][2], lwv[3][2], lbv[3][2];
#pragma unroll
    for (int k = 0; k < 3; ++k)
#pragma unroll
        for (int e = 0; e < 2; ++e) { const int col = (2 * k + sub) * 64 + c2 + e; mp_[k][e] = mup[col]; mn_[k][e] = mun[col]; lwv[k][e] = lw_[col]; lbv[k][e] = lb_[col]; }
    for (int tok = gw; tok < MTOK; tok += nw) {
        const int t = tok & (SEQ - 1), bb_ = tok >> 13;
        float y[3][2], vc[3][2], vp[3][2], vn[3][2], c0[3], c1[3], gv[3][2];
#pragma unroll
        for (int k = 0; k < 3; ++k) {
            const int h = 2 * k + sub, col = h * 64 + c2;
            const size_t yo = ((size_t)((bb_ * 6 + h) * 2 + (c2 >> 5)) * SEQ + t) * 32 + (c2 & 31);
            const unsigned u0 = *(const unsigned*)(yy + yo), u1 = *(const unsigned*)(yy + yo + (size_t)8 * 6 * 2 * SEQ * 32);
            y[k][0] = __uint_as_float(u0 << 16) + __uint_as_float(u1 << 16); y[k][1] = __uint_as_float(u0 & 0xffff0000u) + __uint_as_float(u1 & 0xffff0000u);
            const bf16_t* zc = z + (size_t)tok * 2816 + 768 + col;
            const unsigned uc = *(const unsigned*)zc, up = (t > 0) ? *(const unsigned*)(zc - 2816) : 0u, un = (t < SEQ - 1) ? *(const unsigned*)(zc + 2816) : 0u;
            vc[k][0] = __uint_as_float(uc << 16); vc[k][1] = __uint_as_float(uc & 0xffff0000u);
            vp[k][0] = __uint_as_float(up << 16); vp[k][1] = __uint_as_float(up & 0xffff0000u);
            vn[k][0] = __uint_as_float(un << 16); vn[k][1] = __uint_as_float(un & 0xffff0000u);
            c0[k] = cb[(size_t)(bb_ * 6 + h) * SEQ + t]; c1[k] = cb[(size_t)((8 + bb_) * 6 + h) * SEQ + t];
            const unsigned ug = *(const unsigned*)(gg + (size_t)tok * 384 + col);
            gv[k][0] = f16bits2f(ug & 0xffffu); gv[k][1] = f16bits2f(ug >> 16);
        }
        float m_[3], q_[3], t_[3];
#pragma unroll
        for (int k = 0; k < 3; ++k) m_[k] = row16_sum(y[k][0] + y[k][1]);
#pragma unroll
        for (int k = 0; k < 3; ++k) t_[k] = shx(m_[k], 16, lane);
#pragma unroll
        for (int k = 0; k < 3; ++k) { m_[k] = (m_[k] + t_[k]) * (1.f / 64.f); const float d0 = y[k][0] - m_[k], d1 = y[k][1] - m_[k]; q_[k] = row16_sum(d0 * d0 + d1 * d1); }
#pragma unroll
        for (int k = 0; k < 3; ++k) t_[k] = shx(q_[k], 16, lane);
#pragma unroll
        for (int k = 0; k < 3; ++k) {
            const float var = (q_[k] + t_[k]) * (1.f / 64.f), rs = rsqrtf(var + 64e-5f), cc = c0[k] + c1[k];
            float o[2];
#pragma unroll
            for (int e = 0; e < 2; ++e) {
                const float v = vc[k][e] + mp_[k][e] * (vp[k][e] - vc[k][e]) + mn_[k][e] * (vn[k][e] - vc[k][e]);
                o[e] = ((y[k][e] - m_[k]) * rs * lwv[k][e] + lbv[k][e] + cc * v) * gv[k][e];
            }
            wt4(&O[(size_t)tok * 1024 + (2 * k + sub) * 64 + c2], pk2(o[0], o[1]));
        }
    }
}

struct AttnPre { u32x4 k[6]; u32x4 v[6]; bf16x8 q[2]; };
__device__ __forceinline__ void attn_issue(AttnPre& P, const bf16_t* zb, int h, int sp, int step, int tid, int lane) {
    const int pi = step >> 3, rnd = step & 7, dsh = 2 * pi, dm1 = (1 << dsh) - 1, n = SEQ >> dsh;
    int tt = tid & 255; LAUNDER(tt);
    const int s = tid >> 8, uidx = rnd * 2 + s, r = uidx & dm1, lb = uidx >> dsh, i = sp * (16 >> dsh) + lb, jbase = 64 * (i - 1);
#pragma unroll
    for (int it = 0; it < 6; ++it) {
        const int cid = tt + 256 * it, row = cid >> 3, part = cid & 7, jj = jbase + row; const bool ok = (jj >= 0 && jj < n);
        u32x4 v = {0u, 0u, 0u, 0u};
        if (ok) v = *(const u32x4*)(zb + (size_t)(r + (jj << dsh)) * 2816 + 1792 + h * 64 + part * 8);
        P.k[it] = v;
    }
#pragma unroll
    for (int it = 0; it < 3; ++it) {
        const int cid = tt + 256 * it, rp = cid % 96, part = cid / 96;
#pragma unroll
        for (int hh = 0; hh < 2; ++hh) { const int jj = jbase + 2 * rp + hh; const bool ok = (jj >= 0 && jj < n);
            u32x4 v = {0u, 0u, 0u, 0u};
            if (ok) v = *(const u32x4*)(zb + (size_t)(r + (jj << dsh)) * 2816 + 2176 + h * 64 + part * 8);
            P.v[it * 2 + hh] = v; }
    }
    {
        const int wid = tid >> 6, sl = wid >> 2, wq = wid & 3, fr = lane & 15, fq = lane >> 4;
        const int u2 = rnd * 2 + sl, r2 = u2 & dm1, lb2 = u2 >> dsh, i2 = sp * (16 >> dsh) + lb2, posq = r2 + ((64 * i2 + wq * 16 + fr) << dsh);
#pragma unroll
        for (int ks = 0; ks < 2; ++ks) P.q[ks] = *(const bf16x8*)(zb + (size_t)posq * 2816 + 1408 + h * 64 + ks * 32 + fq * 8);
    }
}
__device__ __forceinline__ void attn_item(const Ctx& p, int item, LAS unsigned char* lds) {
    const int sp = item & 7, h = (item >> 3) % 6, b = item / 48;
    const int tid = TIDX, wid = tid >> 6, lane = tid & 63, sl = wid >> 2, wq = wid & 3;
    LAS bf16_t* Ks = (LAS bf16_t*)lds;
    LAS bf16_t* Vt = Ks + 2 * 192 * 80;
    const bf16_t* zb = (const bf16_t*)(PWS + WS_BIG) + (size_t)b * SEQ * 2816;
    bf16_t* O = (bf16_t*)(PWS + WS_XN); float* lsebuf = (float*)(PWS + WS_LSE);
    const float slope = (h == 0) ? 0.25f : (h == 1) ? 0.0625f : (h == 2) ? 0.015625f : (h == 3) ? 0.00390625f : (h == 4) ? 0.5f : 0.125f;
    AttnPre P;
    attn_issue(P, zb, h, sp, 0, tid, lane);
#pragma unroll 1
    for (int step = 0; step < 24; ++step) {
        const int pi = step >> 3, rnd = step & 7, dsh = 2 * pi, dm1 = (1 << dsh) - 1, n = SEQ >> dsh;
        __syncthreads();
        {
            int tt = tid & 255; LAUNDER(tt);
            const int s = tid >> 8;
#pragma unroll
            for (int it = 0; it < 6; ++it) { const int cid = tt + 256 * it, row = cid >> 3, part = cid & 7; *(LAS u32x4*)(Ks + (s * 192 + row) * 80 + part * 8) = P.k[it]; }
#pragma unroll
            for (int it = 0; it < 3; ++it) { const int cid = tt + 256 * it, rp = cid % 96, part = cid / 96; const u32x4 a = P.v[it * 2], c = P.v[it * 2 + 1];
#pragma unroll
                for (int e = 0; e < 4; ++e) {
                    *(LAS unsigned*)(Vt + (s * 64 + part * 8 + 2 * e) * 200 + 2 * rp) = (a[e] & 0xffffu) | (c[e] << 16);
                    *(LAS unsigned*)(Vt + (s * 64 + part * 8 + 2 * e + 1) * 200 + 2 * rp) = (a[e] >> 16) | (c[e] & 0xffff0000u);
                } }
        }
        const bf16x8 qf0 = P.q[0], qf1 = P.q[1];
        if (step + 1 < 24) attn_issue(P, zb, h, sp, step + 1, tid, lane);
        __syncthreads();
        {
            const int uidx = rnd * 2 + sl, r = uidx & dm1, lb = uidx >> dsh, i = sp * (16 >> dsh) + lb;
            int fr = lane & 15, fq = lane >> 4; LAUNDER(fr); LAUNDER(fq);
            const int qi = wq * 16 + fr, posq = r + ((64 * i + qi) << dsh); const size_t tokq = (size_t)b * SEQ + posq;
            bf16_t* op = O + tokq * 1024 + 384 + h * 64 + fq * 4; float* lp = lsebuf + (size_t)(b * 6 + h) * SEQ + posq;
            float lprev = 0.f; unsigned long long pq[4] = {0ull, 0ull, 0ull, 0ull};
            if (pi > 0) { lprev = __hip_atomic_load(lp, __ATOMIC_RELAXED, __HIP_MEMORY_SCOPE_AGENT);
#pragma unroll
                for (int dt = 0; dt < 4; ++dt) pq[dt] = __hip_atomic_load((const unsigned long long*)(op + dt * 16), __ATOMIC_RELAXED, __HIP_MEMORY_SCOPE_AGENT); }
            f32x4 sacc[12];
#pragma unroll
            for (int kt = 0; kt < 12; ++kt) { f32x4 acc = {0.f, 0.f, 0.f, 0.f};
                acc = mfma16(*(const LAS bf16x8*)(Ks + (sl * 192 + kt * 16 + fr) * 80 + fq * 8), qf0, acc);
                acc = mfma16(*(const LAS bf16x8*)(Ks + (sl * 192 + kt * 16 + fr) * 80 + 32 + fq * 8), qf1, acc);
                sacc[kt] = acc; }
            const float basef = (float)(fq * 4 - 64 - qi), sd2 = slope * (float)(1 << dsh) * 1.44269504f;
            const bool edge = (i == 0) || (64 * (i + 2) > n);
            float mx = -1e30f;
#pragma unroll
            for (int kt = 0; kt < 12; ++kt)
#pragma unroll
                for (int jj = 0; jj < 4; ++jj) { const float ar = fabsf((float)(kt * 16 + jj) + basef); bool ok = ar <= 64.f;
                    if (edge) { const int jk = 64 * (i - 1) + kt * 16 + fq * 4 + jj; ok = ok && (jk >= 0) && (jk < n); }
                    const float lg = ok ? fmaf(sacc[kt][jj], 0.125f * 1.44269504f, -sd2 * ar) : -1e30f; sacc[kt][jj] = lg; mx = fmaxf(mx, lg); }
            mx = fmaxf(mx, shx(mx, 16, lane)); mx = fmaxf(mx, shx(mx, 32, lane));
            float lsum = 0.f;
#pragma unroll
            for (int kt = 0; kt < 12; ++kt)
#pragma unroll
                for (int jj = 0; jj < 4; ++jj) { const float pv = __builtin_amdgcn_exp2f(sacc[kt][jj] - mx); sacc[kt][jj] = pv; lsum += pv; }
            lsum += shx(lsum, 16, lane); lsum += shx(lsum, 32, lane);
            f32x4 oacc[4];
#pragma unroll
            for (int dt = 0; dt < 4; ++dt) oacc[dt] = (f32x4){0.f, 0.f, 0.f, 0.f};
#pragma unroll
            for (int kk = 0; kk < 6; ++kk) {
                union { uint4 u; bf16x8 v; } pf; pf.u.x = pk2(sacc[2 * kk][0], sacc[2 * kk][1]); pf.u.y = pk2(sacc[2 * kk][2], sacc[2 * kk][3]); pf.u.z = pk2(sacc[2 * kk + 1][0], sacc[2 * kk + 1][1]); pf.u.w = pk2(sacc[2 * kk + 1][2], sacc[2 * kk + 1][3]);
#pragma unroll
                for (int dt = 0; dt < 4; ++dt) {
                    const LAS bf16_t* vp = Vt + (sl * 64 + dt * 16 + fr) * 200 + kk * 32 + fq * 4;
                    union { u32x2 h[2]; bf16x8 v; } vf; vf.h[0] = *(const LAS u32x2*)vp; vf.h[1] = *(const LAS u32x2*)(vp + 16);
                    oacc[dt] = mfma16(vf.v, pf.v, oacc[dt]);
                }
            }
            const float inv = __builtin_amdgcn_rcpf(lsum); float lse = mx * 0.69314718f + __logf(lsum);
            float wn = inv, wp = 0.f;
            if (pi > 0) { const float L = fmaxf(lprev, lse); const float ep = __expf(lprev - L), en = __expf(lse - L); const float den = __builtin_amdgcn_rcpf(ep + en);
                wp = ep * den; wn = en * den * inv; lse = L + __logf(ep + en); }
#pragma unroll
            for (int dt = 0; dt < 4; ++dt) {
                float o0 = oacc[dt][0] * wn, o1 = oacc[dt][1] * wn, o2 = oacc[dt][2] * wn, o3 = oacc[dt][3] * wn;
                if (pi > 0) { const unsigned px = (unsigned)pq[dt], py = (unsigned)(pq[dt] >> 32);
                    o0 += wp * __uint_as_float(px << 16); o1 += wp * __uint_as_float(px & 0xffff0000u); o2 += wp * __uint_as_float(py << 16); o3 += wp * __uint_as_float(py & 0xffff0000u); }
                uint2 ov; ov.x = pk2(o0, o1); ov.y = pk2(o2, o3); wt8u(op + dt * 16, ov);
            }
            if (fq == 0) wt4(lp, __float_as_uint(lse));
        }
    }
}
#ifndef DUP_MASK
#define DUP_MASK 7
#endif

__device__ __forceinline__ void zero_cols(const Ctx& p, bf16_t* O, int c0, int ncols) {
    const int per = ncols >> 3; const size_t total = (size_t)MTOK * per;
    for (size_t i = (size_t)BIDX * 512 + TIDX; i < total; i += (size_t)GDIM * 512) { const size_t row = i / per; const int pc = (int)(i % per); *(uint4*)(O + row * 1024 + c0 + pc * 8) = make_uint4(0u, 0u, 0u, 0u); }
}
__device__ __forceinline__ void mixer_phase(const Ctx& p, int l, LAS unsigned char* lds, int rep = 0) {
    unsigned* ctr = (unsigned*)(PWS + WS_CTR) + l + 2 * rep;
    LAS int* sitem = (LAS int*)(lds + 131072);
    for (;;) {
        __syncthreads();
        if (TIDX == 0) *sitem = (int)atomicAdd(ctr, 1u);
        __syncthreads();
        const int item = __builtin_amdgcn_readfirstlane(*sitem);
        if (item >= 192 + 384 + 2048) break;
        if (item < 192) {
#if EN_RWKV
            if (!rep || (DUP_MASK & 1)) rwkv_scan_item(p, l, item, lds);
#endif
        } else if (item < 576) {
#if EN_ATTN
            if (!rep || (DUP_MASK & 2)) attn_item(p, item - 192, lds);
#endif
        } else {
#if EN_S5
            if (!rep || (DUP_MASK & 4)) s5_passC_item(p, l, item - 576, lds);
#endif
        }
    }
}
constexpr int NPH = 25;
__device__ __forceinline__ void run_phase(const Ctx& p, int ph, LAS unsigned char* lds) {
    bf16_t* XN = (bf16_t*)(PWS + WS_XN); bf16_t* BIG = (bf16_t*)(PWS + WS_BIG);
    if (ph == 0) {
#ifdef DUP_W
        weights_phase(p, lds);
#endif
        weights_phase(p, lds);
        if (BIDX == 0 && TIDX < 128) ((unsigned*)(PWS + WS_CTR))[TIDX] = 0u;
        norm_phase(p, PIN(0), PIN(1), XN, nullptr);
        return;
    }
    const int l = (ph - 1) / 12, k = (ph - 1) % 12;
    const unsigned char* wl = PWS + WS_WB + (size_t)l * WL_SIZE;
    switch (k) {
    case 0: case 9: {
#if EN_FFN
        EpiSwiGLU E; E.wv = p.wv; E.O = BIG;
#ifdef DUP_GU
        for (int rep = 0; rep < 2; ++rep)
#endif
        gemm_run(p, lds, XN, (const bf16_t*)(wl + (k == 0 ? WL_GU1 : WL_GU2)), 5632, 1024, E);
#endif
    } break;
    case 1: case 10: {
        const float* hin = (l == 0 && k == 1) ? PIN(0) : POUT;
#if EN_FFN
        EpiResid E; E.wv = p.wv; E.hin = hin; E.hout = POUT; E.alpha = 0.5f; gemm_run(p, lds, BIG, (const bf16_t*)(wl + (k == 1 ? WL_D1 : WL_D2)), 1024, 2816, E);
#else
        if (l == 0 && k == 1) { for (size_t i = (size_t)BIDX * 512 + TIDX; i < (size_t)MTOK * 256; i += (size_t)GDIM * 512) ((float4*)POUT)[i] = ((const float4*)hin)[i]; }
#endif
    } break;
    case 2: norm_phase(p, POUT, PIN(5) + l * 1024, XN, nullptr);
#ifdef DUP_NORM
        norm_phase(p, POUT, PIN(5) + l * 1024, XN, nullptr); norm_phase(p, POUT, PIN(5) + l * 1024, XN, nullptr); norm_phase(p, POUT, PIN(5) + l * 1024, XN, nullptr);
#endif
        break;
    case 3: { EpiZ E; E.wv = p.wv; E.O = BIG; gemm_run(p, lds, XN, (const bf16_t*)(wl + WL_IN), 2816, 1024, E); } break;
    case 4: {
#if EN_RWKV
        rwkv_prep_phase(p, l);
#ifdef DUP_PREP
        rwkv_prep_phase(p, l);
#endif
#endif
#if EN_S5
        for (int item = BIDX; item < 2048; item += GDIM) s5_passA_item(p, l, item, lds);
#ifdef DUP_PASSA
        for (int item = BIDX; item < 2048; item += GDIM) s5_passA_item(p, l, item, lds);
#endif
#endif
    } break;
    case 5: mixer_phase(p, l, lds); break;
    case 6: {
#if EN_S5
        { EpiGLU E; E.wv = p.wv; E.O = XN; E.bias = PIN(29) + l * 512; gemm_run(p, lds, (const bf16_t*)(PWS + WS_YPRE), (const bf16_t*)(wl + WL_GLU), 512, 256, E); }
#else
        zero_cols(p, XN, 768, 256);
#endif
#if EN_RWKV
        rwkv_post_phase(p, l);
#ifdef DUP_POST
        rwkv_post_phase(p, l);
#endif
#else
        zero_cols(p, XN, 0, 384);
#endif
#if !EN_ATTN
        zero_cols(p, XN, 384, 384);
#endif
    } break;
    case 7: { EpiResid E; E.wv = p.wv; E.hin = POUT; E.hout = POUT; E.alpha = 1.0f; gemm_run(p, lds, XN, (const bf16_t*)(wl + WL_OUT), 1024, 1024, E); } break;
    case 8: norm_phase(p, POUT, PIN(30) + l * 1024, XN, nullptr); break;
    case 11: if (l == 0) norm_phase(p, POUT, PIN(1) + 1024, XN, nullptr); else norm_phase(p, POUT, PIN(34), nullptr, POUT); break;
    }
}

__global__ void __launch_bounds__(512, 2) mega(Params kp, int ph_lo, int ph_hi) {
    extern __shared__ __attribute__((aligned(16))) unsigned char shm[];
    LAS unsigned char* lds = (LAS unsigned char*)shm;
    cg::grid_group grid = cg::this_grid();
    LAS unsigned long long* tab = (LAS unsigned long long*)(lds + 131072 + 64);
    if (threadIdx.x == 0) {
#pragma unroll
        for (int i = 0; i < 35; ++i) tab[i] = (unsigned long long)kp.in[i];
        tab[35] = (unsigned long long)kp.out; tab[36] = (unsigned long long)kp.ws;
    }
    __syncthreads();
    Ctx p; p.tab = tab; p.wv = __builtin_amdgcn_readfirstlane((int)(threadIdx.x >> 6));
    unsigned* bar = (unsigned*)(PWS + WS_BAR);
    unsigned nbar = 0;
    for (int ph = ph_lo; ph < ph_hi; ++ph) {
        run_phase(p, ph, lds);
        if (ph + 1 < ph_hi) {
#ifdef CG_ONLY
#ifdef HARDEN
            __builtin_amdgcn_fence(__ATOMIC_RELEASE, "agent");
#endif
            asm volatile("s_waitcnt vmcnt(0) lgkmcnt(0)" ::: "memory");
            grid.sync();
#ifdef HARDEN
            __builtin_amdgcn_fence(__ATOMIC_ACQUIRE, "agent");
            asm volatile("s_waitcnt vmcnt(0)" ::: "memory");
            __syncthreads();
#endif
#ifdef DUP_MIX
            if (ph > 0 && (ph - 1) % 12 == 5) { mixer_phase(p, (ph - 1) / 12, lds, 1); grid.sync(); }
#endif
#else
            if (ph == ph_lo) {
                grid.sync();
            } else {
                ++nbar;
                asm volatile("s_waitcnt vmcnt(0) lgkmcnt(0)" ::: "memory");
                __syncthreads();
                if (threadIdx.x == 0) {
                    const unsigned target = nbar * (unsigned)gridDim.x;
                    __builtin_amdgcn_fence(__ATOMIC_RELEASE, "agent");
                    asm volatile("s_waitcnt vmcnt(0)" ::: "memory");
                    __hip_atomic_fetch_add(bar, 1u, __ATOMIC_RELAXED, __HIP_MEMORY_SCOPE_AGENT);
                    while (__hip_atomic_load(bar, __ATOMIC_RELAXED, __HIP_MEMORY_SCOPE_AGENT) < target) __builtin_amdgcn_s_sleep(1);
                    __builtin_amdgcn_fence(__ATOMIC_ACQUIRE, "agent");
                    asm volatile("s_waitcnt vmcnt(0)" ::: "memory");
                    __hip_atomic_fetch_add(bar + 64, 1u, __ATOMIC_RELAXED, __HIP_MEMORY_SCOPE_AGENT);
                    while (__hip_atomic_load(bar + 64, __ATOMIC_RELAXED, __HIP_MEMORY_SCOPE_AGENT) < target) __builtin_amdgcn_s_sleep(1);
                }
                __syncthreads();
            }
#endif
        }
    }
}

#ifndef SPLIT_LAUNCH
#define SPLIT_LAUNCH 0
#endif
extern "C" void kernel_launch(void* const* d_in, const int* in_sizes, int n_in, void* d_out, int out_size, void* d_ws, size_t ws_size, hipStream_t stream) {
    static int grid = 0;
    if (grid == 0) {
        if (n_in != 35 || out_size != MTOK * 1024 || ws_size < WS_END) { fprintf(stderr, "kernel_launch: unexpected shapes (n_in %d out %d ws %zu need %zu)\n", n_in, out_size, ws_size, (size_t)WS_END); grid = -1; return; }
        int dev = 0, cus = 0, per_cu = 0;
        if (hipGetDevice(&dev) != hipSuccess || hipDeviceGetAttribute(&cus, hipDeviceAttributeMultiprocessorCount, dev) != hipSuccess) { grid = -1; return; }
        if (hipFuncSetAttribute((const void*)mega, hipFuncAttributeMaxDynamicSharedMemorySize, LDS_BYTES) != hipSuccess) { fprintf(stderr, "kernel_launch: hipFuncSetAttribute failed\n"); grid = -1; return; }
        if (hipOccupancyMaxActiveBlocksPerMultiprocessor(&per_cu, (const void*)mega, 512, LDS_BYTES) != hipSuccess || per_cu < 1) { fprintf(stderr, "kernel_launch: occupancy query says %d\n", per_cu); per_cu = 1; }
        (void)hipGetLastError();
        grid = cus;
    }
    if (grid < 0) return;
    Params p{};
    for (int i = 0; i < 35; ++i) p.in[i] = (const float*)d_in[i];
    p.out = (float*)d_out; p.ws = (unsigned char*)d_ws;
#if SPLIT_LAUNCH
    for (int ph = 0; ph < NPH; ++ph) { int lo = ph, hi = ph + 1; void* args[] = {&p, &lo, &hi};
        hipError_t e = hipLaunchCooperativeKernel((const void*)mega, dim3(grid), dim3(512), args, LDS_BYTES, stream);
        if (e != hipSuccess) { fprintf(stderr, "launch failed: %s\n", hipGetErrorString(e)); return; } }
#else
    int lo = 0, hi = NPH; void* args[] = {&p, &lo, &hi};
    hipError_t e = hipLaunchCooperativeKernel((const void*)mega, dim3(grid), dim3(512), args, LDS_BYTES, stream);
    if (e != hipSuccess) fprintf(stderr, "cooperative launch failed: %s (grid %d)\n", hipGetErrorString(e), grid);
#endif
}
```

```cpp
#include <hip/hip_cooperative_groups.h>
#include <cstdio>
#include <hip/hip_runtime.h>
__device__ __forceinline__ int tid_from(int wv) { unsigned m = ~0u; asm volatile("" : "+s"(m), "+s"(wv)); return wv * 64 + (int)__builtin_amdgcn_mbcnt_hi(m, __builtin_amdgcn_mbcnt_lo(m, 0u)); }
#define TIDX (tid_from(p.wv))
__device__ __forceinline__ int bid_() { int b = blockIdx.x; asm volatile("" : "+s"(b)); return b; }
__device__ __forceinline__ int gdim_() { int b = gridDim.x; asm volatile("" : "+s"(b)); return b; }
#define BIDX (bid_())
#define GDIM (gdim_())
#define CG_ONLY 1
#include <hip/hip_runtime.h>
namespace pg8 {
#define PG8_LAS __attribute__((address_space(3)))
typedef unsigned short bf16_t;
typedef short bf16x8 __attribute__((ext_vector_type(8)));
typedef float f32x4 __attribute__((ext_vector_type(4)));
typedef unsigned u32x4 __attribute__((ext_vector_type(4)));
constexpr int BM = 256, BK = 64, HALF = 128, HTB = HALF * BK * 2  , STAGE_BYTES = 8 * HTB, NXCD = 8, WGM = 8;

__host__ __device__ __forceinline__ int lds_byte(int r, int c) { const int st = (r >> 4) * 2 + (c >> 5), rr = r & 15, cc = c & 31, ob = rr * 64 + cc * 2; return st * 1024 + (ob ^ (((ob >> 9) & 1) << 5)); }
__host__ __device__ __forceinline__ void stage_rc(int b, int& R, int& C) { const int st = b / 1024, sb = b % 1024, swz = sb ^ (((sb >> 9) & 1) << 5); R = (st >> 1) * 16 + swz / 64; C = (st & 1) * 32 + (swz % 64) / 2; }
__host__ __device__ __forceinline__ int perm32(int rho) { const int n = rho >> 4, i = rho & 15; return 8 * (i >> 2) + 4 * n + (i & 3); }

struct Unit { int pm, pn; };
struct Gemm { const bf16_t* A; const bf16_t* Bt; int M, N, K; };

struct StaticOrder {
    int nM, nN, nwg, G, c;
    __host__ __device__ void init(int M, int N, int G_, int c_) { nM = M / BM; nN = N / BM; nwg = nM * nN; G = G_; c = c_; }
    __host__ __device__ bool next(int i, Unit& u) const {
        const long L = (long)i * G + c; if (L >= nwg) return false;
        int wgid = (int)L; { const int q = nwg / NXCD, r = nwg % NXCD, xcd = wgid % NXCD, off = wgid / NXCD; wgid = (xcd < r ? xcd * (q + 1) : r * (q + 1) + (xcd - r) * q) + off; }
        const int nig = WGM * nN, gid = wgid / nig, fm = gid * WGM, gsz = (nM - fm) < WGM ? (nM - fm) : WGM;
        u.pm = fm + ((wgid % nig) % gsz); u.pn = (wgid % nig) / gsz; return true;
    }
    __device__ __forceinline__ void a_ready(const Unit&) const {}
    __device__ __forceinline__ void done(const Unit&) const {}
};
__device__ __forceinline__ unsigned cvt_pk_bf16(float lo, float hi) { unsigned r; asm volatile("v_cvt_pk_bf16_f32 %0, %1, %2" : "=v"(r) : "v"(lo), "v"(hi)); return r; }
template <class Epi, class Sched, bool STAMP = false>
__device__ __forceinline__ void gemm_phase(PG8_LAS unsigned char* lds, const Gemm g, const Sched& S, const Epi& E, unsigned long long* stamps, const int tid_in) {
    const int tid = tid_in, wid = __builtin_amdgcn_readfirstlane(tid >> 6), lane = tid & 63, wr = wid >> 2, wc = wid & 3, fr = lane & 15, fq = lane >> 4;
    const int K = g.K, nt = K / BK;
    int ts_lo = 0, ts_hi = 0, nts = 0; const unsigned long long rt_entry = STAMP ? (unsigned long long)wall_clock64() : 0ull;
#define PG8_STAMP() do { if (STAMP && wid == 0 && nts < 64) { const unsigned long long _c = (unsigned long long)clock64(); \
        ts_lo = (lane == nts) ? (int)(unsigned)_c : ts_lo; ts_hi = (lane == nts) ? (int)(unsigned)(_c >> 32) : ts_hi; ++nts; } } while (0)
    PG8_STAMP();
    unsigned voffA[2], voffB[2];
#pragma unroll
    for (int i = 0; i < 2; ++i) { int R, C; stage_rc(tid * 16 + i * 8192, R, C); const int Rb = Epi::PERM ? ((R & ~31) + perm32(R & 31)) : R;
        voffA[i] = (unsigned)(R * K + C) * 2u; voffB[i] = (unsigned)(Rb * K + C) * 2u; }
    const size_t kstep = (size_t)(BK * 2);
    const size_t hstep = (size_t)HALF * K * 2;
    const size_t tstep = 2 * hstep;
    const unsigned ldsw = (unsigned)wid * 1024u;
    const int aoff = lds_byte(wr * 64 + fr, fq * 8), boff = lds_byte(wc * 32 + fr, fq * 8);
#define PG8_SA(b, h) (((b) * 2 + (h)) * HTB)
#define PG8_SB(b, h) ((4 + (b) * 2 + (h)) * HTB)
#define PG8_STAGE(bufoff, gbase, voff) do { _Pragma("unroll") for (int _i = 0; _i < 2; ++_i) \
        __builtin_amdgcn_global_load_lds((const unsigned*)((const char*)(gbase) + (voff)[_i]), (PG8_LAS unsigned*)(lds + (bufoff) + ldsw + _i * 8192), 16, 0, 0); } while (0)
#define PG8_LDA(dst, b, h) do { _Pragma("unroll") for (int m = 0; m < 4; ++m) _Pragma("unroll") for (int k = 0; k < 2; ++k) dst[m][k] = *(const PG8_LAS bf16x8*)(lds + PG8_SA(b, h) + aoff + m * 2048 + k * 1024); } while (0)
#define PG8_LDB(dst, b, h) do { _Pragma("unroll") for (int n = 0; n < 2; ++n) _Pragma("unroll") for (int k = 0; k < 2; ++k) dst[n][k] = *(const PG8_LAS bf16x8*)(lds + PG8_SB(b, h) + boff + n * 2048 + k * 1024); } while (0)
#define PG8_MMA(ai, bj, At, Bt) do { __builtin_amdgcn_s_setprio(1); _Pragma("unroll") for (int m = 0; m < 4; ++m) _Pragma("unroll") for (int n = 0; n < 2; ++n) _Pragma("unroll") for (int k = 0; k < 2; ++k) \
        acc[ai][bj][m][n] = __builtin_amdgcn_mfma_f32_16x16x32_bf16(Bt[n][k], At[m][k], acc[ai][bj][m][n], 0, 0, 0); __builtin_amdgcn_s_setprio(0); } while (0)
#define PG8_WAIT_V(n) asm volatile("s_waitcnt vmcnt(" #n ")" ::: "memory")
#define PG8_WAIT_L(n) asm volatile("s_waitcnt lgkmcnt(" #n ")" ::: "memory")
#define PG8_BAR __builtin_amdgcn_s_barrier()
#define PG8_SCHED __builtin_amdgcn_sched_barrier(0)
    Unit cur, nxt; int ui = 0;
    if (!S.next(0, cur)) return;
    f32x4 acc[2][2][4][2];
#pragma unroll
    for (int a = 0; a < 2; ++a)
#pragma unroll
        for (int b = 0; b < 2; ++b)
#pragma unroll
            for (int m = 0; m < 4; ++m)
#pragma unroll
                for (int n = 0; n < 2; ++n) acc[a][b][m][n] = (f32x4){0.f, 0.f, 0.f, 0.f};
    bf16x8 At[4][2], B0[2][2], B1[2][2];
    const char* cA = (const char*)g.A + (size_t)cur.pm * tstep; const char* cB = (const char*)g.Bt + (size_t)cur.pn * tstep;
    S.a_ready(cur);
    PG8_STAGE(PG8_SB(0, 0), cB, voffB); PG8_STAGE(PG8_SA(0, 0), cA, voffA); PG8_STAGE(PG8_SB(0, 1), cB + hstep, voffB); PG8_STAGE(PG8_SA(0, 1), cA + hstep, voffA);
    if (wr == 1) PG8_BAR;
    PG8_WAIT_V(4); PG8_BAR;
    PG8_STAGE(PG8_SB(1, 0), cB + kstep, voffB); PG8_STAGE(PG8_SA(1, 0), cA + kstep, voffA); PG8_STAGE(PG8_SB(1, 1), cB + hstep + kstep, voffB);
    PG8_WAIT_V(6); PG8_BAR;
    PG8_STAMP();
    for (;;) {
        const bool has_next = S.next(ui + 1, nxt);
        const char* nA = has_next ? (const char*)g.A + (size_t)nxt.pm * tstep : cA; const char* nB = has_next ? (const char*)g.Bt + (size_t)nxt.pn * tstep : cB;
        for (int t = 0; t < nt; t += 2) {
            const bool last = (t == nt - 2);
            const char* a1 = cA + (size_t)(t + 1) * kstep;
            const char* a2 = last ? nA : cA + (size_t)(t + 2) * kstep; const char* b2 = last ? nB : cB + (size_t)(t + 2) * kstep;
            const char* a3 = a2 + kstep; const char* b3 = b2 + kstep;
            if (last && has_next) S.a_ready(nxt);
            PG8_LDB(B0, 0, 0); PG8_SCHED; PG8_LDA(At, 0, 0); PG8_STAGE(PG8_SA(1, 1), a1 + hstep, voffA);
            PG8_WAIT_L(8); PG8_BAR; PG8_WAIT_L(0); PG8_MMA(0, 0, At, B0); PG8_BAR; PG8_SCHED;
            PG8_LDB(B1, 0, 1); PG8_STAGE(PG8_SB(0, 0), b2, voffB);
            PG8_BAR; PG8_WAIT_L(0); PG8_MMA(0, 1, At, B1); PG8_BAR;
            PG8_LDA(At, 0, 1); PG8_STAGE(PG8_SA(0, 0), a2, voffA);
            PG8_BAR; PG8_WAIT_L(0); PG8_MMA(1, 0, At, B0); PG8_BAR; PG8_SCHED;
            PG8_STAGE(PG8_SB(0, 1), b2 + hstep, voffB);
            PG8_WAIT_V(6); PG8_BAR; PG8_MMA(1, 1, At, B1); PG8_BAR;
            PG8_LDB(B0, 1, 0); PG8_SCHED; PG8_LDA(At, 1, 0); PG8_STAGE(PG8_SA(0, 1), a2 + hstep, voffA);
            PG8_WAIT_L(8); PG8_BAR; PG8_WAIT_L(0); PG8_MMA(0, 0, At, B0); PG8_BAR; PG8_SCHED;
            PG8_LDB(B1, 1, 1); PG8_STAGE(PG8_SB(1, 0), b3, voffB);
            PG8_BAR; PG8_WAIT_L(0); PG8_MMA(0, 1, At, B1); PG8_BAR;
            PG8_LDA(At, 1, 1); PG8_STAGE(PG8_SA(1, 0), a3, voffA);
            PG8_BAR; PG8_WAIT_L(0); PG8_MMA(1, 0, At, B0); PG8_BAR; PG8_SCHED;
            PG8_STAGE(PG8_SB(1, 1), b3 + hstep, voffB);
            PG8_WAIT_V(6); PG8_BAR; PG8_MMA(1, 1, At, B1); PG8_BAR;
        }
        PG8_STAMP();
        if constexpr (!Epi::AFTER_DRAIN) { E(acc, cur, wr, wc, fr, fq); S.done(cur); }
        PG8_STAMP();
        if (!has_next) break;
#pragma unroll
        for (int a = 0; a < 2; ++a)
#pragma unroll
            for (int b = 0; b < 2; ++b)
#pragma unroll
                for (int m = 0; m < 4; ++m)
#pragma unroll
                    for (int n = 0; n < 2; ++n) acc[a][b][m][n] = (f32x4){0.f, 0.f, 0.f, 0.f};
        cur = nxt; cA = nA; cB = nB; ++ui;
    }
    PG8_WAIT_V(0);
    if (wr == 0) PG8_BAR;
    PG8_BAR;
    if constexpr (Epi::AFTER_DRAIN) { E.fused(acc, cur, wr, wc, fr, fq, lds, wid, lane); S.done(cur); }
    PG8_STAMP();
    if (STAMP && wid == 0) { stamps[lane] = lane < nts ? (((unsigned long long)(unsigned)ts_hi << 32) | (unsigned)ts_lo) : 0ull;
        if (lane == 62) stamps[62] = rt_entry; if (lane == 63) stamps[63] = (unsigned long long)wall_clock64(); }
#undef PG8_STAMP
#undef PG8_SA
#undef PG8_SB
#undef PG8_STAGE
#undef PG8_LDA
#undef PG8_LDB
#undef PG8_MMA
#undef PG8_WAIT_V
#undef PG8_WAIT_L
#undef PG8_BAR
#undef PG8_SCHED
}
}

#include <cstdio>
#include <ctime>
#include <cstdlib>
#include <cstring>
#include <cmath>
#include <vector>
#include <algorithm>

namespace cg = cooperative_groups;
using pg8::bf16_t; using pg8::bf16x8; using pg8::f32x4;
typedef _Float16 f16_t;
typedef short bf16x4 __attribute__((ext_vector_type(4)));
typedef unsigned u32x4 __attribute__((ext_vector_type(4)));
typedef unsigned u32x2 __attribute__((ext_vector_type(2)));
#define LAS __attribute__((address_space(3)))

#ifndef EN_RWKV
#define EN_RWKV 1
#endif
#ifndef EN_ATTN
#define EN_ATTN 1
#endif
#ifndef EN_S5
#define EN_S5 1
#endif
#ifndef EN_FFN
#define EN_FFN 1
#endif

constexpr int MTOK = 65536, SEQ = 8192;
constexpr int LDS_BYTES = 131072 + 512;
constexpr size_t WL_GU1 = 0, WL_D1 = WL_GU1 + 11534336, WL_IN = WL_D1 + 5767168, WL_OUT = WL_IN + 5767168, WL_GU2 = WL_OUT + 2097152,
                 WL_D2 = WL_GU2 + 11534336, WL_GLU = WL_D2 + 5767168, WL_W2 = WL_GLU + 262144, WL_A2 = WL_W2 + 98304, WL_G2 = WL_A2 + 98304, WL_SIZE = WL_G2 + 98304;
constexpr size_t WS_WB = 0, WS_XN = WS_WB + 2 * WL_SIZE, WS_BIG = WS_XN + 134217728, WS_LAM = WS_BIG + 369098752, WS_AA = WS_LAM + 100663296,
                 WS_GG = WS_AA + 100663296, WS_YY = WS_GG + 50331648, WS_YPRE = WS_YY + 100663296, WS_LSE = WS_YPRE + 33554432, WS_CB = WS_LSE + 1572864,
                 WS_S5E = WS_CB + 3145728, WS_CTR = WS_S5E + 8388608, WS_BAR = WS_CTR + 256, WS_END = WS_BAR + 16384;

struct Params { const float* in[35]; float* out; unsigned char* ws; };
struct Ctx { LAS const unsigned long long* tab; int wv; };
template <class T> __device__ __forceinline__ T* ldsptr(LAS const unsigned long long* tab, int i) {
    unsigned a_; asm volatile("s_mov_b32 %0, 0x20040" : "=s"(a_)); a_ += (unsigned)i * 8u;
    const unsigned long long v = *(LAS const unsigned long long*)a_; const unsigned lo = __builtin_amdgcn_readfirstlane((unsigned)v), hi = __builtin_amdgcn_readfirstlane((unsigned)(v >> 32));
    unsigned long long r = ((unsigned long long)hi << 32) | lo; asm volatile("" : "+s"(r));
    return (T*)(__attribute__((address_space(1))) T*)r; }
#define PWS (ldsptr<unsigned char>(p.tab, 36))
#define POUT (ldsptr<float>(p.tab, 35))
#define PIN(i) (ldsptr<const float>(p.tab, i))

__device__ __forceinline__ float bf2f(unsigned short b) { return __uint_as_float(((unsigned)b) << 16); }
typedef float f32v2_ __attribute__((ext_vector_type(2)));
typedef __bf16 bf16v2_ __attribute__((ext_vector_type(2)));
__device__ __forceinline__ unsigned pk2a(float lo, float hi) { return pg8::cvt_pk_bf16(lo, hi); }
__device__ __forceinline__ unsigned pk2(float lo, float hi) { return pg8::cvt_pk_bf16(lo, hi); }
#ifdef PK2_BUILTIN
__device__ __forceinline__ unsigned pk2m(float lo, float hi) { const f32v2_ f = {lo, hi}; const bf16v2_ r = __builtin_convertvector(f, bf16v2_); return __builtin_bit_cast(unsigned, r); }
#else
__device__ __forceinline__ unsigned pk2m(float lo, float hi) { return pg8::cvt_pk_bf16(lo, hi); }
#endif
#ifdef WT_STORES
__device__ __forceinline__ void wt8(void* p, unsigned long long v) { __hip_atomic_store((unsigned long long*)p, v, __ATOMIC_RELAXED, __HIP_MEMORY_SCOPE_AGENT); }
__device__ __forceinline__ void wt4(void* p, unsigned v) { __hip_atomic_store((unsigned*)p, v, __ATOMIC_RELAXED, __HIP_MEMORY_SCOPE_AGENT); }
__device__ __forceinline__ void wt2(void* p, unsigned short v) { __hip_atomic_store((unsigned short*)p, v, __ATOMIC_RELAXED, __HIP_MEMORY_SCOPE_AGENT); }
#else
__device__ __forceinline__ void wt8(void* p, unsigned long long v) { *(unsigned long long*)p = v; }
__device__ __forceinline__ void wt4(void* p, unsigned v) { *(unsigned*)p = v; }
__device__ __forceinline__ void wt2(void* p, unsigned short v) { *(unsigned short*)p = v; }
#endif
#if defined(WT_STORES) && defined(WT_ASM16)
__device__ __forceinline__ void wt16(void* p, uint4 v) {
    u32x4 d = {v.x, v.y, v.z, v.w};
    asm volatile("global_store_dwordx4 %0, %1, off sc1\n\ts_nop 1" :: "v"(p), "v"(d) : "memory"); }
#elif defined(WT_STORES)
__device__ __forceinline__ void wt16(void* p, uint4 v) {
    u32x4 d = {v.x, v.y, v.z, v.w}; __builtin_nontemporal_store(d, (u32x4*)p); }
#else
__device__ __forceinline__ void wt16(void* p, uint4 v) { *(uint4*)p = v; }
#endif
__device__ __forceinline__ void wt8u(void* p, uint2 v) { wt8(p, ((unsigned long long)v.y << 32) | v.x); }
__device__ __forceinline__ void wt16f(void* p, f32x4 v) { uint4 u; u.x = __float_as_uint(v[0]); u.y = __float_as_uint(v[1]); u.z = __float_as_uint(v[2]); u.w = __float_as_uint(v[3]); wt16(p, u); }
__device__ __forceinline__ float shx(float v, int o, int lane) { return __builtin_bit_cast(float, __builtin_amdgcn_ds_bpermute((lane ^ o) << 2, __builtin_bit_cast(int, v))); }
#define LAUNDER(x) asm volatile("" : "+v"(x))
__device__ __forceinline__ float dpp_ror_add(float x, const int ctrl_unused) { return x; }
#define DPP_ROR_ADD(x, N) ((x) + __builtin_bit_cast(float, __builtin_amdgcn_update_dpp(0, __builtin_bit_cast(int, (x)), 0x120 + (N), 0xf, 0xf, false)))
__device__ __forceinline__ float row16_sum(float x) {
    x = DPP_ROR_ADD(x, 8); x = DPP_ROR_ADD(x, 4); x = DPP_ROR_ADD(x, 2); x = DPP_ROR_ADD(x, 1); return x;
}
__device__ __forceinline__ float wave_sum(float v, int lane) {
    v = row16_sum(v); v += shx(v, 16, lane); v += shx(v, 32, lane); return v;
}
__device__ __forceinline__ float sigmoidf_(float x) { return __builtin_amdgcn_rcpf(1.f + __expf(-x)); }
__device__ __forceinline__ float tanhf_(float x) { const float e = __expf(2.f * x); return 1.f - 2.f * __builtin_amdgcn_rcpf(e + 1.f); }
__device__ __forceinline__ f32x4 mfma16(bf16x8 a, bf16x8 b, f32x4 c) { return __builtin_amdgcn_mfma_f32_16x16x32_bf16(a, b, c, 0, 0, 0); }

template <class F> __device__ __forceinline__ void prep_t(const Ctx& p, LAS unsigned char* lds, bf16_t* dst, int N, int K, F rowp) {
    LAS float* T = (LAS float*)lds;
    const int tid = TIDX, ntn = N >> 6, ntk = K >> 6, total = ntn * ntk;
    f32x4 pa = {0.f, 0.f, 0.f, 0.f}, pc = pa;
    { const int t = BIDX; if (t < total) { const int n0 = (t % ntn) << 6, k0 = (t / ntn) << 6; const float* s = rowp(n0, k0 + (tid >> 3)) + ((tid & 7) << 3); pa = *(const f32x4*)s; pc = *(const f32x4*)(s + 4); } }
    for (int t = BIDX; t < total; t += GDIM) {
        const int n0 = (t % ntn) << 6, k0 = (t / ntn) << 6;
        __syncthreads();
        { const int k = tid >> 3, c8 = (tid & 7) << 3;
#pragma unroll
          for (int e = 0; e < 4; ++e) { T[k * 65 + c8 + e] = pa[e]; T[k * 65 + c8 + 4 + e] = pc[e]; } }
        { const int tn = t + GDIM; if (tn < total) { const int n1 = (tn % ntn) << 6, k1 = (tn / ntn) << 6; const float* s = rowp(n1, k1 + (tid >> 3)) + ((tid & 7) << 3); pa = *(const f32x4*)s; pc = *(const f32x4*)(s + 4); } }
        __syncthreads();
        { const int n = tid >> 3, k8 = (tid & 7) << 3; float v[8];
#pragma unroll
          for (int e = 0; e < 8; ++e) v[e] = T[(k8 + e) * 65 + n];
          uint4 o; o.x = pk2a(v[0], v[1]); o.y = pk2a(v[2], v[3]); o.z = pk2a(v[4], v[5]); o.w = pk2a(v[6], v[7]);
          wt16(dst + (size_t)(n0 + n) * K + k0 + k8, o); }
    }
}
__device__ __forceinline__ void weights_phase(const Ctx& p, LAS unsigned char* lds) {
    for (int l = 0; l < 2; ++l) {
        unsigned char* wl = PWS + WS_WB + (size_t)l * WL_SIZE;
        for (int f = 0; f < 2; ++f) {
            const float* wg = PIN(f ? 31 : 2) + (size_t)l * 1024 * 2816; const float* wu = PIN(f ? 32 : 3) + (size_t)l * 1024 * 2816; const float* wd = PIN(f ? 33 : 4) + (size_t)l * 2816 * 1024;
            prep_t(p, lds, (bf16_t*)(wl + (f ? WL_GU2 : WL_GU1)), 5632, 1024, [=](int n0, int k) { const int t = n0 >> 8, i = n0 & 255; return ((i < 128) ? wg + t * 128 + i : wu + t * 128 + i - 128) + (size_t)k * 2816; });
            prep_t(p, lds, (bf16_t*)(wl + (f ? WL_D2 : WL_D1)), 1024, 2816, [=](int n0, int k) { return wd + (size_t)k * 1024 + n0; });
        }
        { const float* w = PIN(6) + (size_t)l * 1024 * 2816; prep_t(p, lds, (bf16_t*)(wl + WL_IN), 2816, 1024, [=](int n0, int k) { return w + (size_t)k * 2816 + n0; }); }
        { const float* w = PIN(7) + (size_t)l * 1024 * 1024; prep_t(p, lds, (bf16_t*)(wl + WL_OUT), 1024, 1024, [=](int n0, int k) { return w + (size_t)k * 1024 + n0; }); }
        { const float* w = PIN(28) + (size_t)l * 256 * 512; prep_t(p, lds, (bf16_t*)(wl + WL_GLU), 512, 256, [=](int n0, int k) { const int t = n0 >> 8, i = n0 & 255; return w + (size_t)k * 512 + ((i < 128) ? t * 128 + i : 256 + t * 128 + i - 128); }); }
        { const float* w = PIN(11) + (size_t)l * 2 * 64 * 384; prep_t(p, lds, (bf16_t*)(wl + WL_W2), 768, 64, [=](int n0, int k) { const int d = n0 / 384, c = n0 % 384; return w + (size_t)(d * 64 + k) * 384 + c; }); }
        { const float* w = PIN(13) + (size_t)l * 2 * 64 * 384; prep_t(p, lds, (bf16_t*)(wl + WL_A2), 768, 64, [=](int n0, int k) { const int d = n0 / 384, c = n0 % 384; return w + (size_t)(d * 64 + k) * 384 + c; }); }
        { const float* w = PIN(14) + (size_t)l * 128 * 384; prep_t(p, lds, (bf16_t*)(wl + WL_G2), 384, 128, [=](int n0, int k) { return w + (size_t)k * 384 + n0; }); }
    }
}

__device__ __forceinline__ void norm_phase(const Ctx& p, const float* hin, const float* g, bf16_t* xn, float* fout) {
    const int lane = TIDX & 63, wave = BIDX * 8 + (TIDX >> 6), nw = GDIM * 8;
    float4 gv[4];
#pragma unroll
    for (int i = 0; i < 4; ++i) gv[i] = *(const float4*)(g + lane * 4 + 256 * i);
    for (int row = wave; row < MTOK; row += nw) {
        const float* pr = hin + (size_t)row * 1024;
        float4 v[4]; float ss = 0.f;
#pragma unroll
        for (int i = 0; i < 4; ++i) { v[i] = *(const float4*)(pr + lane * 4 + 256 * i); ss += v[i].x * v[i].x + v[i].y * v[i].y + v[i].z * v[i].z + v[i].w * v[i].w; }
        ss = wave_sum(ss, lane);
        const float rs = rsqrtf(ss * (1.f / 1024.f) + 1e-6f);
        if (xn) {
#pragma unroll
            for (int i = 0; i < 4; ++i) { uint2 o; o.x = pk2a(v[i].x * rs * gv[i].x, v[i].y * rs * gv[i].y); o.y = pk2a(v[i].z * rs * gv[i].z, v[i].w * rs * gv[i].w); wt8u(xn + (size_t)row * 1024 + lane * 4 + 256 * i, o); }
        } else {
#pragma unroll
            for (int i = 0; i < 4; ++i) { float4 o; o.x = v[i].x * rs * gv[i].x; o.y = v[i].y * rs * gv[i].y; o.z = v[i].z * rs * gv[i].z; o.w = v[i].w * rs * gv[i].w; wt16f(fout + (size_t)row * 1024 + lane * 4 + 256 * i, (f32x4){o.x, o.y, o.z, o.w}); }
        }
    }
}

struct EpiSwiGLU { int wv; static constexpr bool PERM = true, AFTER_DRAIN = false; bf16_t* O;
    __device__ __forceinline__ void operator()(const f32x4 (&acc)[2][2][4][2], const pg8::Unit& u, int wr, int wc, int fr_, int fq_) const {
        const int ln_ = tid_from(wv) & 63, fr = ln_ & 15, fq = ln_ >> 4;
        const int row0 = u.pm * 256 + wr * 64 + fr, col0 = u.pn * 128 + wc * 32 + 8 * fq;
#pragma unroll
        for (int ai = 0; ai < 2; ++ai)
#pragma unroll
            for (int m = 0; m < 4; ++m) {
                float r[8];
#pragma unroll
                for (int n = 0; n < 2; ++n)
#pragma unroll
                    for (int j = 0; j < 4; ++j) { const float g = acc[ai][0][m][n][j], uu = acc[ai][1][m][n][j]; r[n * 4 + j] = g * sigmoidf_(g) * uu; }
                uint4 o; o.x = pk2a(r[0], r[1]); o.y = pk2a(r[2], r[3]); o.z = pk2a(r[4], r[5]); o.w = pk2a(r[6], r[7]);
                wt16(O + (size_t)(row0 + ai * 128 + m * 16) * 2816 + col0, o);
            }
    }
};
struct EpiResid { int wv; static constexpr bool PERM = false, AFTER_DRAIN = false; const float* hin; float* hout; float alpha;
    __device__ __forceinline__ void operator()(const f32x4 (&acc)[2][2][4][2], const pg8::Unit& u, int wr, int wc, int fr_, int fq_) const {
        const int ln_ = tid_from(wv) & 63, fr = ln_ & 15, fq = ln_ >> 4;
        const int row0 = u.pm * 256 + wr * 64 + fr, col0 = u.pn * 256 + wc * 32 + 4 * fq;
#pragma unroll
        for (int ai = 0; ai < 2; ++ai)
#pragma unroll
            for (int m = 0; m < 4; ++m) { const size_t ro = (size_t)(row0 + ai * 128 + m * 16) * 1024 + col0;
#pragma unroll
                for (int bj = 0; bj < 2; ++bj)
#pragma unroll
                    for (int n = 0; n < 2; ++n) { const f32x4 hv = *(const f32x4*)(hin + ro + bj * 128 + n * 16); wt16f(hout + ro + bj * 128 + n * 16, hv + alpha * acc[ai][bj][m][n]); } }
    }
};
struct EpiZ { int wv; static constexpr bool PERM = true, AFTER_DRAIN = false; bf16_t* O;
    __device__ __forceinline__ void operator()(const f32x4 (&acc)[2][2][4][2], const pg8::Unit& u, int wr, int wc, int fr_, int fq_) const {
        const int ln_ = tid_from(wv) & 63, fr = ln_ & 15, fq = ln_ >> 4;
        const int row0 = u.pm * 256 + wr * 64 + fr, col0 = u.pn * 256 + wc * 32 + 8 * fq;
#pragma unroll
        for (int ai = 0; ai < 2; ++ai)
#pragma unroll
            for (int m = 0; m < 4; ++m)
#pragma unroll
                for (int bj = 0; bj < 2; ++bj) { const f32x4 a = acc[ai][bj][m][0], b = acc[ai][bj][m][1];
                    uint4 o; o.x = pk2a(a[0], a[1]); o.y = pk2a(a[2], a[3]); o.z = pk2a(b[0], b[1]); o.w = pk2a(b[2], b[3]);
                    wt16(O + (size_t)(row0 + ai * 128 + m * 16) * 2816 + col0 + bj * 128, o); }
    }
};
struct EpiGLU { int wv; static constexpr bool PERM = true, AFTER_DRAIN = false; bf16_t* O; const float* bias;
    __device__ __forceinline__ void operator()(const f32x4 (&acc)[2][2][4][2], const pg8::Unit& u, int wr, int wc, int fr_, int fq_) const {
        const int ln_ = tid_from(wv) & 63, fr = ln_ & 15, fq = ln_ >> 4;
        const int row0 = u.pm * 256 + wr * 64 + fr, cw = u.pn * 128 + wc * 32 + 8 * fq;
        const f32x4 bv0 = *(const f32x4*)(bias + cw), bv1 = *(const f32x4*)(bias + cw + 4), bg0 = *(const f32x4*)(bias + 256 + cw), bg1 = *(const f32x4*)(bias + 256 + cw + 4);
#pragma unroll
        for (int ai = 0; ai < 2; ++ai)
#pragma unroll
            for (int m = 0; m < 4; ++m) {
                const f32x4 v0 = acc[ai][0][m][0] + bv0, v1 = acc[ai][0][m][1] + bv1, g0 = acc[ai][1][m][0] + bg0, g1 = acc[ai][1][m][1] + bg1;
                uint4 o; o.x = pk2a(v0[0] * sigmoidf_(g0[0]), v0[1] * sigmoidf_(g0[1])); o.y = pk2a(v0[2] * sigmoidf_(g0[2]), v0[3] * sigmoidf_(g0[3]));
                o.z = pk2a(v1[0] * sigmoidf_(g1[0]), v1[1] * sigmoidf_(g1[1])); o.w = pk2a(v1[2] * sigmoidf_(g1[2]), v1[3] * sigmoidf_(g1[3]));
                wt16(O + (size_t)(row0 + ai * 128 + m * 16) * 1024 + 768 + cw, o);
            }
    }
};
template <class Epi> __device__ __forceinline__ void gemm_run(const Ctx& p, LAS unsigned char* lds, const bf16_t* A, const bf16_t* Bt, int N, int K, const Epi& E) {
    asm volatile("" : "+s"(N), "+s"(K));
    pg8::Gemm g; g.A = A; g.Bt = Bt; g.M = MTOK; g.N = N; g.K = K;
    pg8::StaticOrder S; S.init(MTOK, N, (int)GDIM, (int)BIDX);
    pg8::gemm_phase<Epi, pg8::StaticOrder, false>(lds, g, S, E, nullptr, TIDX);
}

__device__ __forceinline__ void rwkv_prep_phase(const Ctx& p, int l) {
    const bf16_t* z = (const bf16_t*)(PWS + WS_BIG);
    const unsigned char* wl = PWS + WS_WB + (size_t)l * WL_SIZE;
    const bf16_t* w2t = (const bf16_t*)(wl + WL_W2); const bf16_t* a2t = (const bf16_t*)(wl + WL_A2); const bf16_t* g2t = (const bf16_t*)(wl + WL_G2);
    const float* mup = PIN(8) + l * 1408; const float* mun = PIN(9) + l * 1408;
    const float* w0 = PIN(10) + l * 768; const float* a0 = PIN(12) + l * 768;
    f16_t* lam = (f16_t*)(PWS + WS_LAM); f16_t* aa = (f16_t*)(PWS + WS_AA); f16_t* gg = (f16_t*)(PWS + WS_GG);
    const int lane = TIDX & 63, fr = lane & 15, fq = lane >> 4;
    const int gw = BIDX * 8 + (TIDX >> 6), nw = GDIM * 8;
    for (int it = gw; it < MTOK / 32; it += nw) {
        const int m0 = it * 32;
        bf16x8 A[2][8];
#pragma unroll
        for (int sub = 0; sub < 2; ++sub) {
            const int tok = m0 + sub * 16 + fr, t = tok & (SEQ - 1);
            const bf16_t* zc = z + (size_t)tok * 2816;
            const bf16_t* zp = (t > 0) ? zc - 2816 : zc; const bf16_t* zn = (t < SEQ - 1) ? zc + 2816 : zc;
            const float fp = (t > 0) ? 1.f : 0.f, fn = (t < SEQ - 1) ? 1.f : 0.f;
#pragma unroll
            for (int ks = 0; ks < 8; ++ks) {
                const int col = 1152 + ks * 32 + fq * 8;
                const bf16x8 c8 = *(const bf16x8*)(zc + col), p8 = *(const bf16x8*)(zp + col), n8 = *(const bf16x8*)(zn + col);
#ifdef VEC_MU
                const f32x4 mpa = *(const f32x4*)(mup + col), mpb = *(const f32x4*)(mup + col + 4), mna = *(const f32x4*)(mun + col), mnb = *(const f32x4*)(mun + col + 4);
#endif
                float r[8];
#pragma unroll
                for (int e = 0; e < 8; ++e) {
                    const float x = bf2f((unsigned short)c8[e]), xp = fp * bf2f((unsigned short)p8[e]), xn = fn * bf2f((unsigned short)n8[e]);
#ifdef VEC_MU
                    const float xm = x + (e < 4 ? mpa[e & 3] : mpb[e & 3]) * (xp - x) + (e < 4 ? mna[e & 3] : mnb[e & 3]) * (xn - x);
#else
                    const float xm = x + mup[col + e] * (xp - x) + mun[col + e] * (xn - x);
#endif
                    r[e] = (ks < 2) ? tanhf_(xm) : ((ks < 4) ? xm : sigmoidf_(xm));
                }
                union { uint4 u; bf16x8 v; } cv; cv.u.x = pk2(r[0], r[1]); cv.u.y = pk2(r[2], r[3]); cv.u.z = pk2(r[4], r[5]); cv.u.w = pk2(r[6], r[7]);
                A[sub][ks] = cv.v;
            }
        }
#pragma unroll 1
        for (int nt = 0; nt < 48; ++nt) {
            const bf16x8 b0 = *(const bf16x8*)(w2t + (nt * 16 + fr) * 64 + fq * 8), b1 = *(const bf16x8*)(w2t + (nt * 16 + fr) * 64 + 32 + fq * 8);
            const bf16x8 c0 = *(const bf16x8*)(a2t + (nt * 16 + fr) * 64 + fq * 8), c1 = *(const bf16x8*)(a2t + (nt * 16 + fr) * 64 + 32 + fq * 8);
            const int n0 = nt * 16 + fq * 4;
            const f32x4 w0v = *(const f32x4*)(w0 + n0), a0v = *(const f32x4*)(a0 + n0);
#pragma unroll
            for (int sub = 0; sub < 2; ++sub) {
                const int tok = m0 + sub * 16 + fr;
                f32x4 acc = {0.f, 0.f, 0.f, 0.f}; acc = mfma16(b0, A[sub][0], acc); acc = mfma16(b1, A[sub][1], acc);
                f32x4 aca = {0.f, 0.f, 0.f, 0.f}; aca = mfma16(c0, A[sub][2], aca); aca = mfma16(c1, A[sub][3], aca);
                union { f16_t h[4]; uint2 u; } o1, o2;
#pragma unroll
                for (int j = 0; j < 4; ++j) { o1.h[j] = (f16_t)(0.60653066f * sigmoidf_(w0v[j] + acc[j])); o2.h[j] = (f16_t)sigmoidf_(a0v[j] + aca[j]); }
                wt8u(lam + (size_t)tok * 768 + n0, o1.u); wt8u(aa + (size_t)tok * 768 + n0, o2.u);
            }
        }
#pragma unroll 1
        for (int nt = 0; nt < 24; ++nt) {
            bf16x8 bb[4];
#pragma unroll
            for (int ks = 0; ks < 4; ++ks) bb[ks] = *(const bf16x8*)(g2t + (nt * 16 + fr) * 128 + ks * 32 + fq * 8);
            const int n0 = nt * 16 + fq * 4;
#pragma unroll
            for (int sub = 0; sub < 2; ++sub) {
                const int tok = m0 + sub * 16 + fr;
                f32x4 acc = {0.f, 0.f, 0.f, 0.f};
#pragma unroll
                for (int ks = 0; ks < 4; ++ks) acc = mfma16(bb[ks], A[sub][4 + ks], acc);
                union { f16_t h[4]; uint2 u; } o1;
#pragma unroll
                for (int j = 0; j < 4; ++j) o1.h[j] = (f16_t)acc[j];
                wt8u(gg + (size_t)tok * 384 + n0, o1.u);
            }
        }
    }
}

typedef float f32x2_ __attribute__((ext_vector_type(2)));
struct S5Lane { float lbr, lbi; f32x2_ b2[16]; };
__device__ __forceinline__ void s5_lane_params(const Ctx& p, int l, int d, int g, int pp, S5Lane& q) {
    const int idx = ((l * 2 + d) * 16 + g) * 64 + pp;
    const float are = PIN(20)[idx], aim = PIN(21)[idx], st = __expf(PIN(22)[(l * 2 + d) * 16 + g]);
    const float er = __expf(are * st), ang = aim * st;
    const float kf = rintf(ang * 0.15915494309f); float rr = fmaf(-kf, 6.2831855f, ang); rr = fmaf(-kf, -1.7484555e-7f, rr);
    float sn, cs; __sincosf(rr, &sn, &cs);
    q.lbr = er * cs; q.lbi = er * sn;
    const float nr = q.lbr - 1.f, ni = q.lbi, den = __builtin_amdgcn_rcpf(are * are + aim * aim);
    const float zr = (nr * are + ni * aim) * den, zi = (ni * are - nr * aim) * den;
    const float* br = PIN(23) + ((size_t)(l * 16 + g) * 64 + pp) * 16; const float* bi = PIN(24) + ((size_t)(l * 16 + g) * 64 + pp) * 16;
#pragma unroll
    for (int c = 0; c < 16; ++c) { const float x = br[c], y = bi[c]; q.b2[c] = (f32x2_){zr * x - zi * y, zr * y + zi * x}; }
}
__device__ __forceinline__ void s5_stage_u(const Ctx& p, int b, int c, int gq, LAS float* uf) {
    const bf16_t* z = (const bf16_t*)(PWS + WS_BIG);
#pragma unroll
    for (int i = 0; i < 2; ++i) {
        const int e = TIDX + 512 * i, t = e >> 3, part = e & 7;
        const bf16x8 v = *(const bf16x8*)(z + (size_t)(b * SEQ + c * 128 + t) * 2816 + 2560 + gq * 64 + part * 8);
#pragma unroll
        for (int k = 0; k < 8; ++k) uf[t * 64 + part * 8 + k] = bf2f((unsigned short)v[k]);
    }
}
__device__ __forceinline__ void s5_step(const S5Lane& q, const LAS float* urow, float& hr, float& hi) {
    f32x2_ bu0 = {0.f, 0.f}, bu1 = {0.f, 0.f};
#pragma unroll
    for (int c4 = 0; c4 < 4; ++c4) { const f32x4 u = *(const LAS f32x4*)(urow + c4 * 4);
        bu0 += q.b2[c4 * 4 + 0] * (f32x2_){u[0], u[0]}; bu1 += q.b2[c4 * 4 + 1] * (f32x2_){u[1], u[1]};
        bu0 += q.b2[c4 * 4 + 2] * (f32x2_){u[2], u[2]}; bu1 += q.b2[c4 * 4 + 3] * (f32x2_){u[3], u[3]}; }
    const f32x2_ bu = bu0 + bu1;
    const float nr = q.lbr * hr - q.lbi * hi + bu[0], ni = q.lbr * hi + q.lbi * hr + bu[1]; hr = nr; hi = ni;
}
__device__ __forceinline__ void s5_passA_item(const Ctx& p, int l, int item, LAS unsigned char* lds) {
    const int gq = item & 3, c = (item >> 2) & 63, b = item >> 8;
    const int wid = TIDX >> 6, lane = TIDX & 63, gi = wid >> 1, d = wid & 1, g = gq * 4 + gi;
    LAS float* uf = (LAS float*)lds;
    __syncthreads();
    s5_stage_u(p, b, c, gq, uf);
    S5Lane q; s5_lane_params(p, l, d, g, lane, q);
    __syncthreads();
    float hr = 0.f, hi = 0.f;
    for (int s = 0; s < 128; ++s) { const int ti = d ? 127 - s : s; s5_step(q, uf + ti * 64 + gi * 16, hr, hi); }
    float2* E = (float2*)(PWS + WS_S5E);
    wt8(&E[((size_t)((b * 16 + g) * 2 + d) * 64 + c) * 64 + lane], ((unsigned long long)__float_as_uint(hi) << 32) | __float_as_uint(hr));
}
__device__ __forceinline__ void s5_passC_item(const Ctx& p, int l, int item, LAS unsigned char* lds) {
    const int gq = item & 3, c = (item >> 2) & 63, b = item >> 8;
    const int tid = TIDX, wid = tid >> 6, lane = tid & 63, gi = wid >> 1, d = wid & 1, g = gq * 4 + gi, fr = lane & 15, fq = lane >> 4;
    LAS float* uf = (LAS float*)lds;
    LAS bf16_t* hs = (LAS bf16_t*)(lds + 32768) + wid * 16 * 136;
    LAS float* yl = (LAS float*)(lds + 32768 + 34816);
    __syncthreads();
    s5_stage_u(p, b, c, gq, uf);
    S5Lane q; s5_lane_params(p, l, d, g, lane, q);
    bf16x8 Cf[4];
    {
        const float* cre = PIN(25) + ((size_t)((l * 2 + d) * 16 + g) * 16 + fr) * 64; const float* cim = PIN(26) + ((size_t)((l * 2 + d) * 16 + g) * 16 + fr) * 64;
#pragma unroll
        for (int ks = 0; ks < 4; ++ks) { const int q0 = ks * 32 + fq * 8; float r[8];
#pragma unroll
            for (int e = 0; e < 8; ++e) r[e] = (q0 < 64) ? cre[q0 + e] : -cim[q0 - 64 + e];
            union { uint4 u; bf16x8 v; } cv; cv.u.x = pk2(r[0], r[1]); cv.u.y = pk2(r[2], r[3]); cv.u.z = pk2(r[4], r[5]); cv.u.w = pk2(r[6], r[7]); Cf[ks] = cv.v; }
    }
    float hr = 0.f, hi = 0.f;
    {
        float tr = q.lbr, ti = q.lbi;
#pragma unroll
        for (int k = 0; k < 7; ++k) { const float a = tr * tr - ti * ti, bq = 2.f * tr * ti; tr = a; ti = bq; }
        const float2* E = (const float2*)(PWS + WS_S5E) + ((size_t)((b * 16 + g) * 2 + d) * 64) * 64 + lane;
        const int n = d ? 63 - c : c;
        int i = 0;
        for (; i + 8 <= n; i += 8) {
            float2 e[8];
#pragma unroll
            for (int u = 0; u < 8; ++u) { const int cc = d ? 63 - (i + u) : (i + u); e[u] = E[(size_t)cc * 64]; }
#pragma unroll
            for (int u = 0; u < 8; ++u) { const float nr = tr * hr - ti * hi + e[u].x, ni = tr * hi + ti * hr + e[u].y; hr = nr; hi = ni; }
        }
        for (; i < n; ++i) { const int cc = d ? 63 - i : i; const float2 e = E[(size_t)cc * 64]; const float nr = tr * hr - ti * hi + e.x, ni = tr * hi + ti * hr + e.y; hr = nr; hi = ni; }
    }
    __syncthreads();
    {
        const float* dsk = PIN(27) + l * 256 + gq * 64;
        for (int e = tid; e < 128 * 64; e += 512) { const int t = e >> 6, ch = e & 63; yl[((ch >> 4) * 128 + t) * 17 + (ch & 15)] = dsk[ch] * uf[e]; }
    }
    for (int sub = 0; sub < 8; ++sub) {
        for (int s16 = 0; s16 < 16; ++s16) {
            const int s = sub * 16 + s16, ti = d ? 127 - s : s;
            s5_step(q, uf + ti * 64 + gi * 16, hr, hi);
            const unsigned pk = pk2(hr, hi);
            hs[(ti & 15) * 136 + lane] = (bf16_t)(pk & 0xffffu); hs[(ti & 15) * 136 + 64 + lane] = (bf16_t)(pk >> 16);
        }
        __syncthreads();
        {
            f32x4 acc = {0.f, 0.f, 0.f, 0.f};
#pragma unroll
            for (int ks = 0; ks < 4; ++ks) { const bf16x8 af = *(const LAS bf16x8*)(hs + fr * 136 + ks * 32 + fq * 8); acc = mfma16(Cf[ks], af, acc); }
            const int tile = d ? 7 - sub : sub;
            LAS float* yp = yl + (gi * 128 + tile * 16 + fr) * 17 + fq * 4;
#pragma unroll
            for (int j = 0; j < 4; ++j) yp[j] += acc[j];
        }
        __syncthreads();
    }
    {
        bf16_t* yo = (bf16_t*)(PWS + WS_YPRE);
        const int t = tid >> 2, g4 = tid & 3;
        float r[16];
#pragma unroll
        for (int k = 0; k < 16; ++k) { const float x = yl[(g4 * 128 + t) * 17 + k]; r[k] = 0.5f * x * (1.f + tanhf_(0.7978845608f * (x + 0.044715f * x * x * x))); }
        uint4 o0, o1; o0.x = pk2(r[0], r[1]); o0.y = pk2(r[2], r[3]); o0.z = pk2(r[4], r[5]); o0.w = pk2(r[6], r[7]); o1.x = pk2(r[8], r[9]); o1.y = pk2(r[10], r[11]); o1.z = pk2(r[12], r[13]); o1.w = pk2(r[14], r[15]);
        bf16_t* dst = yo + (size_t)(b * SEQ + c * 128 + t) * 256 + gq * 64 + g4 * 16;
        wt16(dst, o0); wt16(dst + 8, o1);
    }
}

constexpr int SC_T = 32, SC_ROW = 352;
struct ScanRaw { unsigned zr[10], zk[10], zv[10], ar[8], lr[8]; };
__device__ __forceinline__ void scan_load_raw(ScanRaw& R, const bf16_t* zb, const unsigned short* ab, const unsigned short* lb, int tlo, int h, int hf, int d, int lane) {
#pragma unroll
    for (int r = 0; r < 10; ++r) {
        int tok = tlo - 1 + r; tok = tok < 0 ? 0 : (tok > SEQ - 1 ? SEQ - 1 : tok);
        const bf16_t* zp = zb + (size_t)tok * 2816 + h * 64;
        R.zr[r] = zp[lane]; R.zk[r] = zp[384 + lane]; R.zv[r] = zp[768 + hf * 32 + (lane & 31)];
    }
#pragma unroll
    for (int i = 0; i < 8; ++i) { const size_t o = (size_t)(tlo + i) * 768 + d * 384 + h * 64 + lane; R.ar[i] = ab[o]; R.lr[i] = lb[o]; }
}
__device__ __forceinline__ float row16_sum_asm(float x) {
    asm volatile("s_nop 1\n\tv_add_f32_dpp %0, %0, %0 row_ror:8 row_mask:0xf bank_mask:0xf\n\ts_nop 1\n\tv_add_f32_dpp %0, %0, %0 row_ror:4 row_mask:0xf bank_mask:0xf\n\ts_nop 1\n\tv_add_f32_dpp %0, %0, %0 row_ror:2 row_mask:0xf bank_mask:0xf\n\ts_nop 1\n\tv_add_f32_dpp %0, %0, %0 row_ror:1 row_mask:0xf bank_mask:0xf" : "+v"(x));
    return x; }
#define DPP_ADD(x, CTRL) ((x) + __builtin_bit_cast(float, __builtin_amdgcn_update_dpp(0, __builtin_bit_cast(int, (x)), (CTRL), 0xf, 0xf, false)))
__device__ __forceinline__ float red8(float x) {
    x = DPP_ADD(x, 0x141); x = DPP_ADD(x, 0x1B); x = DPP_ADD(x, 0xB1); return x;
}
__device__ __forceinline__ float dot4(f32x4 a, f32x4 b) { return a[0] * b[0] + a[1] * b[1] + a[2] * b[2] + a[3] * b[3]; }
typedef float f32p __attribute__((ext_vector_type(2)));
__device__ __forceinline__ float dot8(f32x4 sa, f32x4 sb, f32x4 a, f32x4 b) {
    f32p acc = __builtin_shufflevector(sa, sa, 0, 1) * __builtin_shufflevector(a, a, 0, 1);
    acc += __builtin_shufflevector(sa, sa, 2, 3) * __builtin_shufflevector(a, a, 2, 3);
    acc += __builtin_shufflevector(sb, sb, 0, 1) * __builtin_shufflevector(b, b, 0, 1);
    acc += __builtin_shufflevector(sb, sb, 2, 3) * __builtin_shufflevector(b, b, 2, 3);
    return acc[0] + acc[1];
}
__device__ __forceinline__ float f16bits2f(unsigned u) { union { unsigned short s; f16_t h; } c; c.s = (unsigned short)u; return (float)c.h; }
__device__ __forceinline__ void rwkv_scan_item(const Ctx& p, int l, int item, LAS unsigned char* lds) {
    const int chain = item >> 1, hf = item & 1, d = chain & 1, h = (chain >> 1) % 6, b = chain / 12;
    const int tid = TIDX, wid = __builtin_amdgcn_readfirstlane(tid >> 6), lane = tid & 63;
    LAS float* buf = (LAS float*)lds;
    const bf16_t* zb = (const bf16_t*)(PWS + WS_BIG) + (size_t)b * SEQ * 2816;
    __syncthreads();
    if (wid < 4) {
        const int j = lane & 7, rg = lane >> 3, row = wid * 8 + rg;
        bf16_t* yy = (bf16_t*)(PWS + WS_YY) + ((size_t)(((d * 8 + b) * 6 + h) * 2 + hf) * SEQ) * 32 + row;
        f32x4 Sa = {0.f, 0.f, 0.f, 0.f}, Sb = Sa; float ys = 0.f;
        __builtin_amdgcn_s_setprio(3);
        for (int c = 0; c < SEQ / SC_T; ++c) {
            __syncthreads();
            const LAS float* bb = buf + (c & 1) * SC_T * SC_ROW + 8 * j;
            const LAS float* vb = buf + (c & 1) * SC_T * SC_ROW + 320 + row;
            struct Ops { f32x4 wa, wb, na, nb, aa, ab, da, db, ra, rb; float v; };
            auto ld = [&](Ops& o, int s) {
                const LAS float* st = bb + s * SC_ROW;
                o.wa = *(const LAS f32x4*)(st); o.wb = *(const LAS f32x4*)(st + 4); o.na = *(const LAS f32x4*)(st + 64); o.nb = *(const LAS f32x4*)(st + 68); o.aa = *(const LAS f32x4*)(st + 128); o.ab = *(const LAS f32x4*)(st + 132);
                o.da = *(const LAS f32x4*)(st + 192); o.db = *(const LAS f32x4*)(st + 196); o.ra = *(const LAS f32x4*)(st + 256); o.rb = *(const LAS f32x4*)(st + 260);
                o.v = vb[s * SC_ROW];
            };
            auto stepf = [&](const Ops& o, int s) {
                float sa = dot8(Sa, Sb, o.na, o.nb);
                const f32x4 ta = Sa * o.wa + o.v * o.da, tb = Sb * o.wb + o.v * o.db;
                sa = red8(sa);
                Sa = ta + sa * o.aa; Sb = tb + sa * o.ab;
                float y = dot8(Sa, Sb, o.ra, o.rb);
                y = red8(y);
                if (j == (s & 7)) ys = y;
                if ((s & 7) == 7) {
                    const int sidx = c * SC_T + (s & ~7) + j, t = d ? SEQ - 1 - sidx : sidx;
                    wt2(&yy[(size_t)t * 32], (unsigned short)(pk2(ys, 0.f) & 0xffffu));
                }
            };
            Ops A, B;
            ld(A, 0);
#pragma unroll 4
            for (int s = 0; s < SC_T; s += 2) {
                ld(B, s + 1);
                stepf(A, s);
                if (s + 2 < SC_T) ld(A, s + 2);
                stepf(B, s + 1);
            }
        }
        __builtin_amdgcn_s_setprio(0);
    } else {
        const int lw = wid - 4;
        const unsigned short* ab = (const unsigned short*)(PWS + WS_AA) + (size_t)b * SEQ * 768;
        const unsigned short* lb = (const unsigned short*)(PWS + WS_LAM) + (size_t)b * SEQ * 768;
        float* cb = (float*)(PWS + WS_CB);
        const float* mup = PIN(8) + l * 1408; const float* mun = PIN(9) + l * 1408;
        const int cr = h * 64 + lane, cv = 768 + h * 64 + hf * 32 + (lane & 31);
        const float mpr = mup[cr], mnr = mun[cr], mpk = mup[384 + cr], mnk = mun[384 + cr], mpv = mup[cv], mnv = mun[cv];
        const float kkc = PIN(15)[l * 384 + cr], kac = PIN(16)[l * 384 + cr], rkc = PIN(17)[l * 384 + cr];
        ScanRaw Rc, Rn;
        auto tlo_of = [&](int c) { const int s0 = c * SC_T + lw * 8; return d ? SEQ - 1 - (s0 + 7) : s0; };
        auto process = [&](const ScanRaw& R, int c) {
            const int tlo = tlo_of(c);
            LAS float* nb = buf + (c & 1) * SC_T * SC_ROW;
            float fr_[10], fk_[10], fv_[10];
#pragma unroll
            for (int r = 0; r < 10; ++r) { const int tok = tlo - 1 + r; const float ok = (tok >= 0 && tok < SEQ) ? 1.f : 0.f;
                fr_[r] = ok * bf2f((unsigned short)R.zr[r]); fk_[r] = ok * bf2f((unsigned short)R.zk[r]); fv_[r] = ok * bf2f((unsigned short)R.zv[r]); }
            float r_[8], k_[8], v_[8], a_[8], w_[8], kk_[8], kd_[8], ss_[8], cb_[8];
#pragma unroll
            for (int i = 0; i < 8; ++i) {
                r_[i] = fr_[i + 1] + mpr * (fr_[i] - fr_[i + 1]) + mnr * (fr_[i + 2] - fr_[i + 1]);
                k_[i] = fk_[i + 1] + mpk * (fk_[i] - fk_[i + 1]) + mnk * (fk_[i + 2] - fk_[i + 1]);
                v_[i] = fv_[i + 1] + mpv * (fv_[i] - fv_[i + 1]) + mnv * (fv_[i + 2] - fv_[i + 1]);
                a_[i] = f16bits2f(R.ar[i]); w_[i] = __expf(-f16bits2f(R.lr[i]));
                kk_[i] = k_[i] * kkc; kd_[i] = k_[i] * (1.f + (a_[i] - 1.f) * kac);
                ss_[i] = row16_sum(kk_[i] * kk_[i]); cb_[i] = (hf == 0) ? row16_sum(r_[i] * kd_[i] * rkc) : 0.f;
            }
            {
                float t1[8], t2[8];
#pragma unroll
                for (int i = 0; i < 8; ++i) { t1[i] = shx(ss_[i], 16, lane); if (hf == 0) t2[i] = shx(cb_[i], 16, lane); }
#pragma unroll
                for (int i = 0; i < 8; ++i) { ss_[i] += t1[i]; if (hf == 0) cb_[i] += t2[i]; }
#pragma unroll
                for (int i = 0; i < 8; ++i) { t1[i] = shx(ss_[i], 32, lane); if (hf == 0) t2[i] = shx(cb_[i], 32, lane); }
#pragma unroll
                for (int i = 0; i < 8; ++i) { ss_[i] += t1[i]; if (hf == 0) cb_[i] += t2[i]; }
            }
#pragma unroll
            for (int i = 0; i < 8; ++i) {
                const float kh = kk_[i] * rsqrtf(ss_[i] + 1e-12f);
                const int slot = lw * 8 + (d ? 7 - i : i);
                LAS float* st = nb + slot * SC_ROW;
                st[lane] = w_[i]; st[64 + lane] = -kh; st[128 + lane] = kh * a_[i]; st[192 + lane] = kd_[i]; st[256 + lane] = r_[i]; if (lane < 32) st[320 + lane] = v_[i];
                if (hf == 0 && lane == 0) wt4(&cb[(size_t)((d * 8 + b) * 6 + h) * SEQ + tlo + i], __float_as_uint(cb_[i]));
            }
        };
        scan_load_raw(Rc, zb, ab, lb, tlo_of(0), h, hf, d, lane);
        scan_load_raw(Rn, zb, ab, lb, tlo_of(1), h, hf, d, lane);
        process(Rc, 0);
        for (int c = 0; c < SEQ / SC_T; ++c) {
            __syncthreads();
            if (c + 1 < SEQ / SC_T) {
                Rc = Rn;
                if (c + 2 < SEQ / SC_T) scan_load_raw(Rn, zb, ab, lb, tlo_of(c + 2), h, hf, d, lane);
                process(Rc, c + 1);
            }
        }
    }
}

__device__ __forceinline__ void rwkv_post_phase(const Ctx& p, int l) {
    const bf16_t* z = (const bf16_t*)(PWS + WS_BIG); const bf16_t* yy = (const bf16_t*)(PWS + WS_YY);
    const unsigned short* gg = (const unsigned short*)(PWS + WS_GG); const float* cb = (const float*)(PWS + WS_CB);
    bf16_t* O = (bf16_t*)(PWS + WS_XN);
    const float* mup = PIN(8) + l * 1408 + 768; const float* mun = PIN(9) + l * 1408 + 768;
    const float* lw_ = PIN(18) + l * 384; const float* lb_ = PIN(19) + l * 384;
    const int lane = TIDX & 63, gw = BIDX * 8 + (TIDX >> 6), nw = GDIM * 8;
    const int sub = lane >> 5, c2 = (lane & 31) * 2;
    float mp_[3][2], mn_[3][2], lwv[3][2], lbv[3][2];
#pragma unroll
    for (int k = 0; k < 3; ++k)
#pragma unroll
        for (int e = 0; e < 2; ++e) { const int col = (2 * k + sub) * 64 + c2 + e; mp_[k][e] = mup[col]; mn_[k][e] = mun[col]; lwv[k][e] = lw_[col]; lbv[k][e] = lb_[col]; }
    for (int tok = gw; tok < MTOK; tok += nw) {
        const int t = tok & (SEQ - 1), bb_ = tok >> 13;
        float y[3][2], vc[3][2], vp[3][2], vn[3][2], c0[3], c1[3], gv[3][2];
#pragma unroll
        for (int k = 0; k < 3; ++k) {
            const int h = 2 * k + sub, col = h * 64 + c2;
            const size_t yo = ((size_t)((bb_ * 6 + h) * 2 + (c2 >> 5)) * SEQ + t) * 32 + (c2 & 31);
            const unsigned u0 = *(const unsigned*)(yy + yo), u1 = *(const unsigned*)(yy + yo + (size_t)8 * 6 * 2 * SEQ * 32);
            y[k][0] = __uint_as_float(u0 << 16) + __uint_as_float(u1 << 16); y[k][1] = __uint_as_float(u0 & 0xffff0000u) + __uint_as_float(u1 & 0xffff0000u);
            const bf16_t* zc = z + (size_t)tok * 2816 + 768 + col;
            const unsigned uc = *(const unsigned*)zc, up = (t > 0) ? *(const unsigned*)(zc - 2816) : 0u, un = (t < SEQ - 1) ? *(const unsigned*)(zc + 2816) : 0u;
            vc[k][0] = __uint_as_float(uc << 16); vc[k][1] = __uint_as_float(uc & 0xffff0000u);
            vp[k][0] = __uint_as_float(up << 16); vp[k][1] = __uint_as_float(up & 0xffff0000u);
            vn[k][0] = __uint_as_float(un << 16); vn[k][1] = __uint_as_float(un & 0xffff0000u);
            c0[k] = cb[(size_t)(bb_ * 6 + h) * SEQ + t]; c1[k] = cb[(size_t)((8 + bb_) * 6 + h) * SEQ + t];
            const unsigned ug = *(const unsigned*)(gg + (size_t)tok * 384 + col);
            gv[k][0] = f16bits2f(ug & 0xffffu); gv[k][1] = f16bits2f(ug >> 16);
        }
        float m_[3], q_[3], t_[3];
#pragma unroll
        for (int k = 0; k < 3; ++k) m_[k] = row16_sum(y[k][0] + y[k][1]);
#pragma unroll
        for (int k = 0; k < 3; ++k) t_[k] = shx(m_[k], 16, lane);
#pragma unroll
        for (int k = 0; k < 3; ++k) { m_[k] = (m_[k] + t_[k]) * (1.f / 64.f); const float d0 = y[k][0] - m_[k], d1 = y[k][1] - m_[k]; q_[k] = row16_sum(d0 * d0 + d1 * d1); }
#pragma unroll
        for (int k = 0; k < 3; ++k) t_[k] = shx(q_[k], 16, lane);
#pragma unroll
        for (int k = 0; k < 3; ++k) {
            const float var = (q_[k] + t_[k]) * (1.f / 64.f), rs = rsqrtf(var + 64e-5f), cc = c0[k] + c1[k];
            float o[2];
#pragma unroll
            for (int e = 0; e < 2; ++e) {
                const float v = vc[k][e] + mp_[k][e] * (vp[k][e] - vc[k][e]) + mn_[k][e] * (vn[k][e] - vc[k][e]);
                o[e] = ((y[k][e] - m_[k]) * rs * lwv[k][e] + lbv[k][e] + cc * v) * gv[k][e];
            }
            wt4(&O[(size_t)tok * 1024 + (2 * k + sub) * 64 + c2], pk2(o[0], o[1]));
        }
    }
}

struct AttnPre { u32x4 k[6]; u32x4 v[6]; bf16x8 q[2]; };
__device__ __forceinline__ void attn_issue(AttnPre& P, const bf16_t* zb, int h, int sp, int step, int tid, int lane) {
    const int pi = step >> 3, rnd = step & 7, dsh = 2 * pi, dm1 = (1 << dsh) - 1, n = SEQ >> dsh;
    int tt = tid & 255; LAUNDER(tt);
    const int s = tid >> 8, uidx = rnd * 2 + s, r = uidx & dm1, lb = uidx >> dsh, i = sp * (16 >> dsh) + lb, jbase = 64 * (i - 1);
#pragma unroll
    for (int it = 0; it < 6; ++it) {
        const int cid = tt + 256 * it, row = cid >> 3, part = cid & 7, jj = jbase + row; const bool ok = (jj >= 0 && jj < n);
        u32x4 v = {0u, 0u, 0u, 0u};
        if (ok) v = *(const u32x4*)(zb + (size_t)(r + (jj << dsh)) * 2816 + 1792 + h * 64 + part * 8);
        P.k[it] = v;
    }
#pragma unroll
    for (int it = 0; it < 3; ++it) {
        const int cid = tt + 256 * it, rp = cid % 96, part = cid / 96;
#pragma unroll
        for (int hh = 0; hh < 2; ++hh) { const int jj = jbase + 2 * rp + hh; const bool ok = (jj >= 0 && jj < n);
            u32x4 v = {0u, 0u, 0u, 0u};
            if (ok) v = *(const u32x4*)(zb + (size_t)(r + (jj << dsh)) * 2816 + 2176 + h * 64 + part * 8);
            P.v[it * 2 + hh] = v; }
    }
    {
        const int wid = tid >> 6, sl = wid >> 2, wq = wid & 3, fr = lane & 15, fq = lane >> 4;
        const int u2 = rnd * 2 + sl, r2 = u2 & dm1, lb2 = u2 >> dsh, i2 = sp * (16 >> dsh) + lb2, posq = r2 + ((64 * i2 + wq * 16 + fr) << dsh);
#pragma unroll
        for (int ks = 0; ks < 2; ++ks) P.q[ks] = *(const bf16x8*)(zb + (size_t)posq * 2816 + 1408 + h * 64 + ks * 32 + fq * 8);
    }
}
__device__ __forceinline__ void attn_item(const Ctx& p, int item, LAS unsigned char* lds) {
    const int sp = item & 7, h = (item >> 3) % 6, b = item / 48;
    const int tid = TIDX, wid = tid >> 6, lane = tid & 63, sl = wid >> 2, wq = wid & 3;
    LAS bf16_t* Ks = (LAS bf16_t*)lds;
    LAS bf16_t* Vt = Ks + 2 * 192 * 80;
    const bf16_t* zb = (const bf16_t*)(PWS + WS_BIG) + (size_t)b * SEQ * 2816;
    bf16_t* O = (bf16_t*)(PWS + WS_XN); float* lsebuf = (float*)(PWS + WS_LSE);
    const float slope = (h == 0) ? 0.25f : (h == 1) ? 0.0625f : (h == 2) ? 0.015625f : (h == 3) ? 0.00390625f : (h == 4) ? 0.5f : 0.125f;
    AttnPre P;
    attn_issue(P, zb, h, sp, 0, tid, lane);
#pragma unroll 1
    for (int step = 0; step < 24; ++step) {
        const int pi = step >> 3, rnd = step & 7, dsh = 2 * pi, dm1 = (1 << dsh) - 1, n = SEQ >> dsh;
        __syncthreads();
        {
            int tt = tid & 255; LAUNDER(tt);
            const int s = tid >> 8;
#pragma unroll
            for (int it = 0; it < 6; ++it) { const int cid = tt + 256 * it, row = cid >> 3, part = cid & 7; *(LAS u32x4*)(Ks + (s * 192 + row) * 80 + part * 8) = P.k[it]; }
#pragma unroll
            for (int it = 0; it < 3; ++it) { const int cid = tt + 256 * it, rp = cid % 96, part = cid / 96; const u32x4 a = P.v[it * 2], c = P.v[it * 2 + 1];
#pragma unroll
                for (int e = 0; e < 4; ++e) {
                    *(LAS unsigned*)(Vt + (s * 64 + part * 8 + 2 * e) * 200 + 2 * rp) = (a[e] & 0xffffu) | (c[e] << 16);
                    *(LAS unsigned*)(Vt + (s * 64 + part * 8 + 2 * e + 1) * 200 + 2 * rp) = (a[e] >> 16) | (c[e] & 0xffff0000u);
                } }
        }
        const bf16x8 qf0 = P.q[0], qf1 = P.q[1];
        if (step + 1 < 24) attn_issue(P, zb, h, sp, step + 1, tid, lane);
        __syncthreads();
        {
            const int uidx = rnd * 2 + sl, r = uidx & dm1, lb = uidx >> dsh, i = sp * (16 >> dsh) + lb;
            int fr = lane & 15, fq = lane >> 4; LAUNDER(fr); LAUNDER(fq);
            const int qi = wq * 16 + fr, posq = r + ((64 * i + qi) << dsh); const size_t tokq = (size_t)b * SEQ + posq;
            bf16_t* op = O + tokq * 1024 + 384 + h * 64 + fq * 4; float* lp = lsebuf + (size_t)(b * 6 + h) * SEQ + posq;
            float lprev = 0.f; unsigned long long pq[4] = {0ull, 0ull, 0ull, 0ull};
            if (pi > 0) { lprev = __hip_atomic_load(lp, __ATOMIC_RELAXED, __HIP_MEMORY_SCOPE_AGENT);
#pragma unroll
                for (int dt = 0; dt < 4; ++dt) pq[dt] = __hip_atomic_load((const unsigned long long*)(op + dt * 16), __ATOMIC_RELAXED, __HIP_MEMORY_SCOPE_AGENT); }
            f32x4 sacc[12];
#pragma unroll
            for (int kt = 0; kt < 12; ++kt) { f32x4 acc = {0.f, 0.f, 0.f, 0.f};
                acc = mfma16(*(const LAS bf16x8*)(Ks + (sl * 192 + kt * 16 + fr) * 80 + fq * 8), qf0, acc);
                acc = mfma16(*(const LAS bf16x8*)(Ks + (sl * 192 + kt * 16 + fr) * 80 + 32 + fq * 8), qf1, acc);
                sacc[kt] = acc; }
            const float basef = (float)(fq * 4 - 64 - qi), sd2 = slope * (float)(1 << dsh) * 1.44269504f;
            const bool edge = (i == 0) || (64 * (i + 2) > n);
            float mx = -1e30f;
#pragma unroll
            for (int kt = 0; kt < 12; ++kt)
#pragma unroll
                for (int jj = 0; jj < 4; ++jj) { const float ar = fabsf((float)(kt * 16 + jj) + basef); bool ok = ar <= 64.f;
                    if (edge) { const int jk = 64 * (i - 1) + kt * 16 + fq * 4 + jj; ok = ok && (jk >= 0) && (jk < n); }
                    const float lg = ok ? fmaf(sacc[kt][jj], 0.125f * 1.44269504f, -sd2 * ar) : -1e30f; sacc[kt][jj] = lg; mx = fmaxf(mx, lg); }
            mx = fmaxf(mx, shx(mx, 16, lane)); mx = fmaxf(mx, shx(mx, 32, lane));
            float lsum = 0.f;
#pragma unroll
            for (int kt = 0; kt < 12; ++kt)
#pragma unroll
                for (int jj = 0; jj < 4; ++jj) { const float pv = __builtin_amdgcn_exp2f(sacc[kt][jj] - mx); sacc[kt][jj] = pv; lsum += pv; }
            lsum += shx(lsum, 16, lane); lsum += shx(lsum, 32, lane);
            f32x4 oacc[4];
#pragma unroll
            for (int dt = 0; dt < 4; ++dt) oacc[dt] = (f32x4){0.f, 0.f, 0.f, 0.f};
#pragma unroll
            for (int kk = 0; kk < 6; ++kk) {
                union { uint4 u; bf16x8 v; } pf; pf.u.x = pk2(sacc[2 * kk][0], sacc[2 * kk][1]); pf.u.y = pk2(sacc[2 * kk][2], sacc[2 * kk][3]); pf.u.z = pk2(sacc[2 * kk + 1][0], sacc[2 * kk + 1][1]); pf.u.w = pk2(sacc[2 * kk + 1][2], sacc[2 * kk + 1][3]);
#pragma unroll
                for (int dt = 0; dt < 4; ++dt) {
                    const LAS bf16_t* vp = Vt + (sl * 64 + dt * 16 + fr) * 200 + kk * 32 + fq * 4;
                    union { u32x2 h[2]; bf16x8 v; } vf; vf.h[0] = *(const LAS u32x2*)vp; vf.h[1] = *(const LAS u32x2*)(vp + 16);
                    oacc[dt] = mfma16(vf.v, pf.v, oacc[dt]);
                }
            }
            const float inv = __builtin_amdgcn_rcpf(lsum); float lse = mx * 0.69314718f + __logf(lsum);
            float wn = inv, wp = 0.f;
            if (pi > 0) { const float L = fmaxf(lprev, lse); const float ep = __expf(lprev - L), en = __expf(lse - L); const float den = __builtin_amdgcn_rcpf(ep + en);
                wp = ep * den; wn = en * den * inv; lse = L + __logf(ep + en); }
#pragma unroll
            for (int dt = 0; dt < 4; ++dt) {
                float o0 = oacc[dt][0] * wn, o1 = oacc[dt][1] * wn, o2 = oacc[dt][2] * wn, o3 = oacc[dt][3] * wn;
                if (pi > 0) { const unsigned px = (unsigned)pq[dt], py = (unsigned)(pq[dt] >> 32);
                    o0 += wp * __uint_as_float(px << 16); o1 += wp * __uint_as_float(px & 0xffff0000u); o2 += wp * __uint_as_float(py << 16); o3 += wp * __uint_as_float(py & 0xffff0000u); }
                uint2 ov; ov.x = pk2(o0, o1); ov.y = pk2(o2, o3); wt8u(op + dt * 16, ov);
            }
            if (fq == 0) wt4(lp, __float_as_uint(lse));
        }
    }
}
#ifndef DUP_MASK
#define DUP_MASK 7
#endif

__device__ __forceinline__ void zero_cols(const Ctx& p, bf16_t* O, int c0, int ncols) {
    const int per = ncols >> 3; const size_t total = (size_t)MTOK * per;
    for (size_t i = (size_t)BIDX * 512 + TIDX; i < total; i += (size_t)GDIM * 512) { const size_t row = i / per; const int pc = (int)(i % per); *(uint4*)(O + row * 1024 + c0 + pc * 8) = make_uint4(0u, 0u, 0u, 0u); }
}
__device__ __forceinline__ void mixer_phase(const Ctx& p, int l, LAS unsigned char* lds, int rep = 0) {
    unsigned* ctr = (unsigned*)(PWS + WS_CTR) + l + 2 * rep;
    LAS int* sitem = (LAS int*)(lds + 131072);
    for (;;) {
        __syncthreads();
        if (TIDX == 0) *sitem = (int)atomicAdd(ctr, 1u);
        __syncthreads();
        const int item = __builtin_amdgcn_readfirstlane(*sitem);
        if (item >= 192 + 384 + 2048) break;
        if (item < 192) {
#if EN_RWKV
            if (!rep || (DUP_MASK & 1)) rwkv_scan_item(p, l, item, lds);
#endif
        } else if (item < 576) {
#if EN_ATTN
            if (!rep || (DUP_MASK & 2)) attn_item(p, item - 192, lds);
#endif
        } else {
#if EN_S5
            if (!rep || (DUP_MASK & 4)) s5_passC_item(p, l, item - 576, lds);
#endif
        }
    }
}
constexpr int NPH = 25;
__device__ __forceinline__ void run_phase(const Ctx& p, int ph, LAS unsigned char* lds) {
    bf16_t* XN = (bf16_t*)(PWS + WS_XN); bf16_t* BIG = (bf16_t*)(PWS + WS_BIG);
    if (ph == 0) {
#ifdef DUP_W
        weights_phase(p, lds);
#endif
        weights_phase(p, lds);
        if (BIDX == 0 && TIDX < 128) ((unsigned*)(PWS + WS_CTR))[TIDX] = 0u;
        norm_phase(p, PIN(0), PIN(1), XN, nullptr);
        return;
    }
    const int l = (ph - 1) / 12, k = (ph - 1) % 12;
    const unsigned char* wl = PWS + WS_WB + (size_t)l * WL_SIZE;
    switch (k) {
    case 0: case 9: {
#if EN_FFN
        EpiSwiGLU E; E.wv = p.wv; E.O = BIG;
#ifdef DUP_GU
        for (int rep = 0; rep < 2; ++rep)
#endif
        gemm_run(p, lds, XN, (const bf16_t*)(wl + (k == 0 ? WL_GU1 : WL_GU2)), 5632, 1024, E);
#endif
    } break;
    case 1: case 10: {
        const float* hin = (l == 0 && k == 1) ? PIN(0) : POUT;
#if EN_FFN
        EpiResid E; E.wv = p.wv; E.hin = hin; E.hout = POUT; E.alpha = 0.5f; gemm_run(p, lds, BIG, (const bf16_t*)(wl + (k == 1 ? WL_D1 : WL_D2)), 1024, 2816, E);
#else
        if (l == 0 && k == 1) { for (size_t i = (size_t)BIDX * 512 + TIDX; i < (size_t)MTOK * 256; i += (size_t)GDIM * 512) ((float4*)POUT)[i] = ((const float4*)hin)[i]; }
#endif
    } break;
    case 2: norm_phase(p, POUT, PIN(5) + l * 1024, XN, nullptr);
#ifdef DUP_NORM
        norm_phase(p, POUT, PIN(5) + l * 1024, XN, nullptr); norm_phase(p, POUT, PIN(5) + l * 1024, XN, nullptr); norm_phase(p, POUT, PIN(5) + l * 1024, XN, nullptr);
#endif
        break;
    case 3: { EpiZ E; E.wv = p.wv; E.O = BIG; gemm_run(p, lds, XN, (const bf16_t*)(wl + WL_IN), 2816, 1024, E); } break;
    case 4: {
#if EN_RWKV
        rwkv_prep_phase(p, l);
#ifdef DUP_PREP
        rwkv_prep_phase(p, l);
#endif
#endif
#if EN_S5
        for (int item = BIDX; item < 2048; item += GDIM) s5_passA_item(p, l, item, lds);
#ifdef DUP_PASSA
        for (int item = BIDX; item < 2048; item += GDIM) s5_passA_item(p, l, item, lds);
#endif
#endif
    } break;
    case 5: mixer_phase(p, l, lds); break;
    case 6: {
#if EN_S5
        { EpiGLU E; E.wv = p.wv; E.O = XN; E.bias = PIN(29) + l * 512; gemm_run(p, lds, (const bf16_t*)(PWS + WS_YPRE), (const bf16_t*)(wl + WL_GLU), 512, 256, E); }
#else
        zero_cols(p, XN, 768, 256);
#endif
#if EN_RWKV
        rwkv_post_phase(p, l);
#ifdef DUP_POST
        rwkv_post_phase(p, l);
#endif
#else
        zero_cols(p, XN, 0, 384);
#endif
#if !EN_ATTN
        zero_cols(p, XN, 384, 384);
#endif
    } break;
    case 7: { EpiResid E; E.wv = p.wv; E.hin = POUT; E.hout = POUT; E.alpha = 1.0f; gemm_run(p, lds, XN, (const bf16_t*)(wl + WL_OUT), 1024, 1024, E); } break;
    case 8: norm_phase(p, POUT, PIN(30) + l * 1024, XN, nullptr); break;
    case 11: if (l == 0) norm_phase(p, POUT, PIN(1) + 1024, XN, nullptr); else norm_phase(p, POUT, PIN(34), nullptr, POUT); break;
    }
}

__global__ void __launch_bounds__(512, 2) mega(Params kp, int ph_lo, int ph_hi) {
    extern __shared__ __attribute__((aligned(16))) unsigned char shm[];
    LAS unsigned char* lds = (LAS unsigned char*)shm;
    cg::grid_group grid = cg::this_grid();
    LAS unsigned long long* tab = (LAS unsigned long long*)(lds + 131072 + 64);
    if (threadIdx.x == 0) {
#pragma unroll
        for (int i = 0; i < 35; ++i) tab[i] = (unsigned long long)kp.in[i];
        tab[35] = (unsigned long long)kp.out; tab[36] = (unsigned long long)kp.ws;
    }
    __syncthreads();
    Ctx p; p.tab = tab; p.wv = __builtin_amdgcn_readfirstlane((int)(threadIdx.x >> 6));
    unsigned* bar = (unsigned*)(PWS + WS_BAR);
    unsigned nbar = 0;
    for (int ph = ph_lo; ph < ph_hi; ++ph) {
        run_phase(p, ph, lds);
        if (ph + 1 < ph_hi) {
#ifdef CG_ONLY
#ifdef HARDEN
            __builtin_amdgcn_fence(__ATOMIC_RELEASE, "agent");
#endif
            asm volatile("s_waitcnt vmcnt(0) lgkmcnt(0)" ::: "memory");
            grid.sync();
#ifdef HARDEN
            __builtin_amdgcn_fence(__ATOMIC_ACQUIRE, "agent");
            asm volatile("s_waitcnt vmcnt(0)" ::: "memory");
            __syncthreads();
#endif
#ifdef DUP_MIX
            if (ph > 0 && (ph - 1) % 12 == 5) { mixer_phase(p, (ph - 1) / 12, lds, 1); grid.sync(); }
#endif
#else
            if (ph == ph_lo) {
                grid.sync();
            } else {
                ++nbar;
                asm volatile("s_waitcnt vmcnt(0) lgkmcnt(0)" ::: "memory");
                __syncthreads();
                if (threadIdx.x == 0) {
                    const unsigned target = nbar * (unsigned)gridDim.x;
                    __builtin_amdgcn_fence(__ATOMIC_RELEASE, "agent");
                    asm volatile("s_waitcnt vmcnt(0)" ::: "memory");
                    __hip_atomic_fetch_add(bar, 1u, __ATOMIC_RELAXED, __HIP_MEMORY_SCOPE_AGENT);
                    while (__hip_atomic_load(bar, __ATOMIC_RELAXED, __HIP_MEMORY_SCOPE_AGENT) < target) __builtin_amdgcn_s_sleep(1);
                    __builtin_amdgcn_fence(__ATOMIC_ACQUIRE, "agent");
                    asm volatile("s_waitcnt vmcnt(0)" ::: "memory");
                    __hip_atomic_fetch_add(bar + 64, 1u, __ATOMIC_RELAXED, __HIP_MEMORY_SCOPE_AGENT);
                    while (__hip_atomic_load(bar + 64, __ATOMIC_RELAXED, __HIP_MEMORY_SCOPE_AGENT) < target) __builtin_amdgcn_s_sleep(1);
                }
                __syncthreads();
            }
#endif
        }
    }
}

#ifndef SPLIT_LAUNCH
#define SPLIT_LAUNCH 0
#endif
extern "C" void kernel_launch(void* const* d_in, const int* in_sizes, int n_in, void* d_out, int out_size, void* d_ws, size_t ws_size, hipStream_t stream) {
    static int grid = 0;
    if (grid == 0) {
        if (n_in != 35 || out_size != MTOK * 1024 || ws_size < WS_END) { fprintf(stderr, "kernel_launch: unexpected shapes (n_in %d out %d ws %zu need %zu)\n", n_in, out_size, ws_size, (size_t)WS_END); grid = -1; return; }
        int dev = 0, cus = 0, per_cu = 0;
        if (hipGetDevice(&dev) != hipSuccess || hipDeviceGetAttribute(&cus, hipDeviceAttributeMultiprocessorCount, dev) != hipSuccess) { grid = -1; return; }
        if (hipFuncSetAttribute((const void*)mega, hipFuncAttributeMaxDynamicSharedMemorySize, LDS_BYTES) != hipSuccess) { fprintf(stderr, "kernel_launch: hipFuncSetAttribute failed\n"); grid = -1; return; }
        if (hipOccupancyMaxActiveBlocksPerMultiprocessor(&per_cu, (const void*)mega, 512, LDS_BYTES) != hipSuccess || per_cu < 1) { fprintf(stderr, "kernel_launch: occupancy query says %d\n", per_cu); per_cu = 1; }
        (void)hipGetLastError();
        grid = cus;
    }
    if (grid < 0) return;
    Params p{};
    for (int i = 0; i < 35; ++i) p.in[i] = (const float*)d_in[i];
    p.out = (float*)d_out; p.ws = (unsigned char*)d_ws;
#if SPLIT_LAUNCH
    for (int ph = 0; ph < NPH; ++ph) { int lo = ph, hi = ph + 1; void* args[] = {&p, &lo, &hi};
        hipError_t e = hipLaunchCooperativeKernel((const void*)mega, dim3(grid), dim3(512), args, LDS_BYTES, stream);
        if (e != hipSuccess) { fprintf(stderr, "launch failed: %s\n", hipGetErrorString(e)); return; } }
#else
    int lo = 0, hi = NPH; void* args[] = {&p, &lo, &hi};
    hipError_t e = hipLaunchCooperativeKernel((const void*)mega, dim3(grid), dim3(512), args, LDS_BYTES, stream);
    if (e != hipSuccess) fprintf(stderr, "cooperative launch failed: %s (grid %d)\n", hipGetErrorString(e), grid);
#endif
}
```
